# Optimizing an MI355X kernel written in HIP

```python
import jax
import jax.numpy as jnp
from jax import lax
import numpy as np

D_MODEL = 1024
BATCH = 4
SEQ = 4096
DEPTH = 2

N_BRANCH = 4
BRANCH_WIDTH = 256
HEAD_DIM = 64
N_HEADS = BRANCH_WIDTH // HEAD_DIM
MLA_Q_RANK = 256
MLA_KV_RANK = 128
MLA_NOPE_DIM = 64
MLA_ROPE_DIM = 32
MLA_V_DIM = BRANCH_WIDTH // N_HEADS
ROPE_BASE = 10000.0
CONV_CH = BRANCH_WIDTH
CONV_WIDTH = 31
FORGET_BIAS_INIT = 3.0
Q_BLOCK = 128
N_GROUPS = 4
EXPERTS_PER_GROUP = 8
N_EXPERTS = N_GROUPS * EXPERTS_PER_GROUP
TOP_K = 2
EXPERT_FF = 256
ROW_BLOCK = 128
NORM_EPS = 1e-5
IN_SPLITS = (MLA_Q_RANK, MLA_KV_RANK, MLA_ROPE_DIM, 3 * BRANCH_WIDTH, 2 * CONV_CH, 3 * BRANCH_WIDTH, N_HEADS, N_BRANCH * D_MODEL)
N_IN = sum(IN_SPLITS)

kernel_name = 'hybrid_mla_stickbreak_conformer_fox_hiermoe'


def _layernorm(x, g, b):
    xf = x.astype(jnp.float32)
    mu = jnp.mean(xf, axis=-1, keepdims=True)
    var = jnp.mean(jnp.square(xf - mu), axis=-1, keepdims=True)
    y = (xf - mu) * lax.rsqrt(var + NORM_EPS) * g.astype(jnp.float32) + b.astype(jnp.float32)
    return y.astype(x.dtype)


def _rmsnorm(x, g):
    xf = x.astype(jnp.float32)
    y = xf * lax.rsqrt(jnp.mean(xf * xf, axis=-1, keepdims=True) + NORM_EPS) * g.astype(jnp.float32)
    return y.astype(x.dtype)


def _rope(x, positions):
    half = x.shape[-1] // 2
    inv = ROPE_BASE ** (-jnp.arange(half, dtype=jnp.float32) / half)
    ang = (positions.astype(jnp.float32)[..., None] * inv)[:, :, None, :]
    cos, sin = jnp.cos(ang), jnp.sin(ang)
    x1 = x[..., :half].astype(jnp.float32)
    x2 = x[..., half:].astype(jnp.float32)
    out = jnp.concatenate([x1 * cos - x2 * sin, x2 * cos + x1 * sin], axis=-1)
    return out.astype(x.dtype)


def _split_cols(z):
    idx = [int(i) for i in np.cumsum(IN_SPLITS)[:-1]]
    return jnp.split(z, idx, axis=-1)


def _split_heads(qkv):
    b, s, _ = qkv.shape
    qkv = qkv.reshape(b, s, 3, N_HEADS, HEAD_DIM).transpose(2, 0, 3, 1, 4)
    return qkv[0], qkv[1], qkv[2]


def _merge_heads(o):
    b, h, s, d = o.shape
    return o.transpose(0, 2, 1, 3).reshape(b, s, h * d)


def _sweep_query_blocks(block_fn, q_side):
    b, h, s = q_side[0].shape[:3]
    nb = s // Q_BLOCK
    blocks = tuple(jnp.moveaxis(a.reshape((b, h, nb, Q_BLOCK) + a.shape[3:]), 2, 0) for a in q_side)
    t_pos = jnp.arange(s, dtype=jnp.int32).reshape(nb, Q_BLOCK)
    out = lax.map(lambda args: block_fn(*args), (t_pos,) + blocks)
    return jnp.moveaxis(out, 0, 2).reshape(b, h, s, out.shape[-1])


def _mla(c_q, c_kv, k_rope_raw, positions, q_norm, kv_norm, w_uq, w_ukv):
    b, s, _ = c_q.shape
    q = (_rmsnorm(c_q, q_norm) @ w_uq).reshape(b, s, N_HEADS, MLA_NOPE_DIM + MLA_ROPE_DIM)
    q_nope = q[..., :MLA_NOPE_DIM].transpose(0, 2, 1, 3)
    q_rope = _rope(q[..., MLA_NOPE_DIM:], positions).transpose(0, 2, 1, 3)
    kv = (_rmsnorm(c_kv, kv_norm) @ w_ukv).reshape(b, s, N_HEADS, MLA_NOPE_DIM + MLA_V_DIM)
    k_nope = kv[..., :MLA_NOPE_DIM].transpose(0, 2, 1, 3)
    v = kv[..., MLA_NOPE_DIM:].transpose(0, 2, 1, 3)
    k_rope = _rope(k_rope_raw[:, :, None, :], positions)[:, :, 0, :]
    scale = (MLA_NOPE_DIM + MLA_ROPE_DIM) ** -0.5
    key_pos = jnp.arange(s, dtype=jnp.int32)

    def block(t_pos, qn, qr):
        logits = jnp.einsum('bhqd,bhkd->bhqk', qn, k_nope) + jnp.einsum('bhqr,bkr->bhqk', qr, k_rope)
        logits = logits.astype(jnp.float32) * scale
        logits = jnp.where(key_pos[None, :] <= t_pos[:, None], logits, -jnp.inf)
        p = jax.nn.softmax(logits, axis=-1).astype(v.dtype)
        return jnp.einsum('bhqk,bhkd->bhqd', p, v)

    return _merge_heads(_sweep_query_blocks(block, (q_nope, q_rope)))


def _stick_breaking(q, k, v):
    s = k.shape[2]
    scale = HEAD_DIM ** -0.5
    key_pos = jnp.arange(s, dtype=jnp.int32)

    def block(t_pos, qb):
        z = jnp.einsum('bhqd,bhkd->bhqk', qb, k).astype(jnp.float32) * scale
        strict = key_pos[None, :] < t_pos[:, None]
        log_stay = jnp.where(strict, jax.nn.log_sigmoid(-z), 0.0)
        after = lax.cumsum(log_stay, axis=3, reverse=True) - log_stay
        a = jnp.where(strict, jnp.exp(jax.nn.log_sigmoid(z) + after), 0.0).astype(v.dtype)
        return jnp.einsum('bhqk,bhkd->bhqd', a, v)

    return _merge_heads(_sweep_query_blocks(block, (q,)))


def _conformer_conv(u, conv_w, conv_b, ln_g, ln_b):
    a, g = jnp.split(u, 2, axis=-1)
    h = a * jax.nn.sigmoid(g)
    hp = jnp.pad(h, ((0, 0), (CONV_WIDTH - 1, 0), (0, 0)))
    y = lax.conv_general_dilated(hp, conv_w[:, None, :], window_strides=(1,), padding='VALID',
                                 dimension_numbers=('NWC', 'WIO', 'NWC'), feature_group_count=CONV_CH)
    y = _layernorm(y + conv_b, ln_g, ln_b)
    return jax.nn.silu(y)


def _forgetting_attention(q, k, v, forget_logit, b_forget):
    s = k.shape[2]
    scale = HEAD_DIM ** -0.5
    log_f = jax.nn.log_sigmoid((forget_logit + b_forget).astype(jnp.float32))
    c = jnp.cumsum(log_f, axis=1).transpose(0, 2, 1)
    key_pos = jnp.arange(s, dtype=jnp.int32)

    def block(t_pos, qb, cb):
        logits = jnp.einsum('bhqd,bhkd->bhqk', qb, k).astype(jnp.float32) * scale
        logits = logits + cb[..., None] - c[:, :, None, :]
        logits = jnp.where(key_pos[None, :] <= t_pos[:, None], logits, -jnp.inf)
        p = jax.nn.softmax(logits, axis=-1).astype(v.dtype)
        return jnp.einsum('bhqk,bhkd->bhqd', p, v)

    return _merge_heads(_sweep_query_blocks(block, (q, c)))


def _token_mixer(x, positions, w_in, b_gate, b_forget, mla_q_norm, mla_kv_norm, mla_w_uq, mla_w_ukv,
                 conv_w, conv_b, conv_ln_g, conv_ln_b, w_branch, w_o):
    b, s, d = x.shape
    z = x @ w_in
    c_q, c_kv, k_rope, sb_qkv, conv_in, fox_qkv, fox_f, gate_logits = _split_cols(z)
    y_a = _mla(c_q, c_kv, k_rope, positions, mla_q_norm, mla_kv_norm, mla_w_uq, mla_w_ukv)
    y_b = _stick_breaking(*_split_heads(sb_qkv))
    y_c = _conformer_conv(conv_in, conv_w, conv_b, conv_ln_g, conv_ln_b)
    y_d = _forgetting_attention(*_split_heads(fox_qkv), fox_f, b_forget)
    ys = jnp.stack([y_a, y_b, y_c, y_d], axis=2)
    gates = jax.nn.sigmoid(gate_logits + b_gate).reshape(b, s, N_BRANCH, d)
    proj = jnp.einsum('bsnc,ncd->bsnd', ys, w_branch)
    merged = jnp.sum(proj * gates, axis=2)
    return merged @ w_o


def _hier_moe(h, w_rg, b_rg, w_re, b_re, w_gate, w_up, w_down):
    b, s, d = h.shape
    xt = h.reshape(-1, d)
    n_tok = xt.shape[0]
    grp_prob = jax.nn.softmax((xt @ w_rg + b_rg).astype(jnp.float32), axis=-1)
    grp_p, grp_idx = lax.top_k(grp_prob, 1)
    exp_logits = (xt @ w_re + b_re).astype(jnp.float32).reshape(n_tok, N_GROUPS, EXPERTS_PER_GROUP)
    in_grp = jnp.take_along_axis(exp_logits, grp_idx[:, :, None], axis=1)[:, 0]
    top_p, top_i = lax.top_k(jax.nn.softmax(in_grp, axis=-1), TOP_K)
    weights = grp_p * top_p / jnp.sum(top_p, axis=-1, keepdims=True)
    expert_id = (grp_idx * EXPERTS_PER_GROUP + top_i).reshape(-1)
    n_assign = expert_id.shape[0]
    order = jnp.argsort(expert_id).astype(jnp.int32)
    sorted_e = expert_id[order]
    counts = jnp.bincount(expert_id, length=N_EXPERTS).astype(jnp.int32)
    padded = (counts + ROW_BLOCK - 1) // ROW_BLOCK * ROW_BLOCK
    pad_end = jnp.cumsum(padded)
    pad_start = pad_end - padded
    start = jnp.cumsum(counts) - counts
    slot = pad_start[sorted_e] + jnp.arange(n_assign, dtype=jnp.int32) - start[sorted_e]
    n_blocks = (n_assign + ROW_BLOCK - 1) // ROW_BLOCK + N_EXPERTS
    slot_token = jnp.full((n_blocks * ROW_BLOCK,), n_tok, dtype=jnp.int32).at[slot].set(order // TOP_K)
    block_start = jnp.arange(n_blocks, dtype=jnp.int32) * ROW_BLOCK
    block_expert = jnp.minimum(jnp.searchsorted(pad_end, block_start, side='right'), N_EXPERTS - 1)
    x_pad = jnp.concatenate([xt, jnp.zeros((1, d), xt.dtype)], axis=0)
    xb = x_pad[slot_token].reshape(n_blocks, ROW_BLOCK, d)

    def expert_block(args):
        xe, e = args
        hid = jax.nn.silu(xe @ w_gate[e]) * (xe @ w_up[e])
        return hid @ w_down[e]

    yb = lax.map(expert_block, (xb, block_expert)).reshape(-1, d)
    y_assign = jnp.zeros((n_assign, d), yb.dtype).at[order].set(yb[slot])
    y = jnp.einsum('tkd,tk->td', y_assign.reshape(n_tok, TOP_K, d), weights.astype(yb.dtype))
    return y.reshape(b, s, d)


def setup_inputs(seed: int = 0) -> dict:
    key = jax.random.key(seed)
    ks = jax.random.split(key, 28)
    L, D = DEPTH, D_MODEL
    beta = (8.0 * DEPTH) ** -0.25

    def nrm(k, shape, scale):
        return jax.random.normal(k, shape, jnp.float32) * scale

    def gain(k, shape):
        return 1.0 + 0.02 * jax.random.normal(k, shape, jnp.float32)

    offset = jax.random.randint(ks[1], (BATCH, 1), 0, 1024, dtype=jnp.int32)
    positions = offset + jnp.arange(SEQ, dtype=jnp.int32)[None, :]
    return {
        'x': nrm(ks[0], (BATCH, SEQ, D), 1.0),
        'positions': positions,
        'w_in': nrm(ks[2], (L, D, N_IN), D ** -0.5),
        'b_gate': nrm(ks[3], (L, N_BRANCH * D), 0.02),
        'b_forget': FORGET_BIAS_INIT + nrm(ks[4], (L, N_HEADS), 0.1),
        'mla_q_norm': gain(ks[5], (L, MLA_Q_RANK)),
        'mla_kv_norm': gain(ks[6], (L, MLA_KV_RANK)),
        'mla_w_uq': nrm(ks[7], (L, MLA_Q_RANK, N_HEADS * (MLA_NOPE_DIM + MLA_ROPE_DIM)), MLA_Q_RANK ** -0.5),
        'mla_w_ukv': nrm(ks[8], (L, MLA_KV_RANK, N_HEADS * (MLA_NOPE_DIM + MLA_V_DIM)), MLA_KV_RANK ** -0.5),
        'conv_w': nrm(ks[9], (L, CONV_WIDTH, CONV_CH), CONV_WIDTH ** -0.5),
        'conv_b': nrm(ks[10], (L, CONV_CH), 0.02),
        'conv_ln_g': gain(ks[11], (L, CONV_CH)),
        'conv_ln_b': nrm(ks[12], (L, CONV_CH), 0.02),
        'w_branch': nrm(ks[13], (L, N_BRANCH, BRANCH_WIDTH, D), BRANCH_WIDTH ** -0.5),
        'w_o': nrm(ks[14], (L, D, D), beta * D ** -0.5),
        'ln1_g': gain(ks[15], (L, D)),
        'ln1_b': nrm(ks[16], (L, D), 0.02),
        'w_router_group': nrm(ks[17], (L, D, N_GROUPS), D ** -0.5),
        'b_router_group': nrm(ks[18], (L, N_GROUPS), 0.01),
        'w_router_expert': nrm(ks[19], (L, D, N_EXPERTS), D ** -0.5),
        'b_router_expert': nrm(ks[20], (L, N_EXPERTS), 0.01),
        'w_exp_gate': nrm(ks[21], (L, N_EXPERTS, D, EXPERT_FF), D ** -0.5),
        'w_exp_up': nrm(ks[22], (L, N_EXPERTS, D, EXPERT_FF), D ** -0.5),
        'w_exp_down': nrm(ks[23], (L, N_EXPERTS, EXPERT_FF, D), beta * EXPERT_FF ** -0.5),
        'ln2_g': gain(ks[24], (L, D)),
        'ln2_b': nrm(ks[25], (L, D), 0.02),
    }


def reference(x, positions, w_in, b_gate, b_forget, mla_q_norm, mla_kv_norm, mla_w_uq, mla_w_ukv,
              conv_w, conv_b, conv_ln_g, conv_ln_b, w_branch, w_o, ln1_g, ln1_b,
              w_router_group, b_router_group, w_router_expert, b_router_expert,
              w_exp_gate, w_exp_up, w_exp_down, ln2_g, ln2_b):
    alpha = (2.0 * DEPTH) ** 0.25
    for l in range(DEPTH):
        mix = _token_mixer(x, positions, w_in[l], b_gate[l], b_forget[l], mla_q_norm[l], mla_kv_norm[l],
                           mla_w_uq[l], mla_w_ukv[l], conv_w[l], conv_b[l], conv_ln_g[l], conv_ln_b[l],
                           w_branch[l], w_o[l])
        x = _layernorm(alpha * x + mix, ln1_g[l], ln1_b[l])
        ffn = _hier_moe(x, w_router_group[l], b_router_group[l], w_router_expert[l], b_router_expert[l],
                        w_exp_gate[l], w_exp_up[l], w_exp_down[l])
        x = _layernorm(alpha * x + ffn, ln2_g[l], ln2_b[l])
    return x
```

```cpp
#include <hip/hip_runtime.h>
#include <hip/hip_cooperative_groups.h>
#include <cstdio>
#include <cstdint>
namespace cg = cooperative_groups;

typedef unsigned short bf16_t;
typedef float f32x4 __attribute__((ext_vector_type(4)));
typedef unsigned u32x4 __attribute__((ext_vector_type(4)));
typedef unsigned u32x2 __attribute__((ext_vector_type(2)));

constexpr int NB = 4, SEQ = 4096, T = NB * SEQ, D = 1024, NIN = 6564, ZSW = 2560;
constexpr int NEXP = 32, EFF = 256, MAXSLOT = 40960;
constexpr int C_CQ = 0, C_CKV = 256, C_KR = 384, C_SBQ = 416, C_SBK = 672, C_SBV = 928, C_CVA = 1184, C_CVG = 1440,
              C_FXQ = 1696, C_FXK = 1952, C_FXV = 2208, C_FXF = 2464, C_GATE = 2468;
constexpr float LOG2E = 1.4426950408889634f;
constexpr float C2_64 = 0.125f * LOG2E;
constexpr float C2_M = 0.10206207261596575f * LOG2E;
constexpr float ALPHA = 1.4142135623730951f;
constexpr float EPS = 1e-5f;
constexpr int NTHREADS = 512, NWAVES = 8;
constexpr int LDS_BYTES = 147456;

constexpr size_t MiB = 1u << 20;
constexpr size_t WS_CTL = 0;
constexpr size_t WS_ROUTE = 1 * MiB;
constexpr size_t RT_TOKE = 0, RT_TOKW = 131072, RT_TOKP = 262144, RT_TOKS = 393216, RT_SLOTW = 524288, RT_FXF = 786432, RT_CF = 1048576;
constexpr size_t WS_W = 3 * MiB;
constexpr size_t W_BT1 = 0, W_GATE = 5 * MiB, W_UQ = 13 * MiB, W_UKV = W_UQ + 262144, W_BR = W_UKV + 131072, W_O = W_BR + 2 * MiB, W_GU = W_O + 2 * MiB, W_D = W_GU + 32 * MiB;
static_assert(W_D + 16 * MiB <= 66 * MiB, "weights");
constexpr size_t WS_XB = 69 * MiB;
constexpr size_t WS_R1 = 101 * MiB;
constexpr size_t R1_ZS = 0, R1_QR = 80 * MiB, R1_KVR = 96 * MiB, R1_PB = 0, R1_XG = 0, R1_HID = 80 * MiB, R1_YSL = 0;
constexpr size_t WS_C = 229 * MiB;
constexpr size_t C_QM = 0, C_KM = 12 * MiB, C_VM = 24 * MiB;
constexpr size_t WS_D = 261 * MiB;
constexpr size_t WS_END = 293 * MiB;

struct Params {
    const float* x; const int* pos; const float* w_in; const float* b_gate; const float* b_forget;
    const float* q_norm; const float* kv_norm; const float* w_uq; const float* w_ukv;
    const float* conv_w; const float* conv_b; const float* conv_g; const float* conv_bb;
    const float* w_branch; const float* w_o; const float* ln1_g; const float* ln1_b;
    const float* w_rg; const float* b_rg; const float* w_re; const float* b_re;
    const float* w_eg; const float* w_eu; const float* w_ed; const float* ln2_g; const float* ln2_b;
    float* out; unsigned char* ws; int phase; int layer;
};

__device__ __forceinline__ unsigned f2bf(float f) { unsigned u = __float_as_uint(f); return (u + 0x7fffu + ((u >> 16) & 1u)) >> 16; }
__device__ __forceinline__ float bf2f(unsigned b) { return __uint_as_float(b << 16); }
__device__ __forceinline__ unsigned pk2(float lo, float hi) { return f2bf(lo) | (f2bf(hi) << 16); }
__device__ __forceinline__ float wave_sum(float v) {
#pragma unroll
    for (int o = 1; o < 64; o <<= 1) v += __shfl_xor(v, o);
    return v;
}
__device__ __forceinline__ float wave_max(float v) {
#pragma unroll
    for (int o = 1; o < 64; o <<= 1) v = fmaxf(v, __shfl_xor(v, o));
    return v;
}
__device__ __forceinline__ float sigmoidf_(float x) { return 1.f / (1.f + __expf(-x)); }
#define LDS_FENCE() asm volatile("s_waitcnt lgkmcnt(0)" ::: "memory")

template <class F>
__device__ __forceinline__ void tr_item(const float* W, int ldw, bf16_t* out, int Kd, int r0, int k0, const float* ks, F f, float* scr, int lane) {
    const int rl = lane & 31, r = r0 + rl, c = f.col(r); const float s = f.rs(r);
#pragma unroll 8
    for (int i = 0; i < 32; ++i) {
        const int kk = 2 * i + (lane >> 5); float v = 0.f;
        if (c >= 0) { v = W[(size_t)(k0 + kk) * ldw + c] * s; if (ks) v *= ks[k0 + kk]; }
        scr[kk * 33 + rl] = v;
    }
    LDS_FENCE();
    const int cc = lane & 7;
#pragma unroll
    for (int j = 0; j < 4; ++j) {
        const int n = (lane >> 3) + 8 * j; const float* s8 = scr + (8 * cc) * 33 + n;
        u32x4 o; o.x = pk2(s8[0], s8[33]); o.y = pk2(s8[66], s8[99]); o.z = pk2(s8[132], s8[165]); o.w = pk2(s8[198], s8[231]);
        *(u32x4*)(out + (size_t)(r0 + n) * Kd + k0 + 8 * cc) = o;
    }
    LDS_FENCE();
}
struct MapBt1 { __device__ int col(int r) const { return r < C_GATE ? r : -1; } __device__ float rs(int r) const { return ((r >= C_SBQ && r < C_SBK) || (r >= C_FXQ && r < C_FXK)) ? C2_64 : 1.f; } };
struct MapGate { __device__ int col(int r) const { return C_GATE + r; } __device__ float rs(int) const { return 1.f; } };
struct MapLim { int lim; __device__ int col(int r) const { return r < lim ? r : -1; } __device__ float rs(int) const { return 1.f; } };
struct MapGU { __device__ int col(int r) const { return ((r >> 8) << 7) + (r & 127); } __device__ float rs(int) const { return 1.f; } };

__device__ __forceinline__ void phase_convw(const Params& p, int l, float* lds) {
    const int tid = threadIdx.x, lane = tid & 63, wave = tid >> 6;
    float* scr = lds + wave * (64 * 33);
    unsigned char* W = p.ws + WS_W;
    const int gw = blockIdx.x * NWAVES + wave, NGW = gridDim.x * NWAVES;
    constexpr int I_A = 80 * 16, I_B = 128 * 16, I_C = 16 * 4, I_Dd = 16 * 2, I_E = 4 * 128, I_F = 32 * 16, I_G = 32 * 256, I_H = 32 * 128;
    constexpr int NIT = I_A + I_B + I_C + I_Dd + I_E + I_F + I_G + I_H;
    for (int it = gw; it < NIT; it += NGW) {
        int r = it;
        if (r < I_A) { tr_item(p.w_in + (size_t)l * D * NIN, NIN, (bf16_t*)(W + W_BT1), 1024, (r >> 4) * 32, (r & 15) * 64, nullptr, MapBt1{}, scr, lane); continue; } r -= I_A;
        if (r < I_B) { tr_item(p.w_in + (size_t)l * D * NIN, NIN, (bf16_t*)(W + W_GATE), 1024, (r >> 4) * 32, (r & 15) * 64, nullptr, MapGate{}, scr, lane); continue; } r -= I_B;
        if (r < I_C) { tr_item(p.w_uq + (size_t)l * 256 * 384, 384, (bf16_t*)(W + W_UQ), 256, (r >> 2) * 32, (r & 3) * 64, p.q_norm + l * 256, MapLim{384}, scr, lane); continue; } r -= I_C;
        if (r < I_Dd) { tr_item(p.w_ukv + (size_t)l * 128 * 512, 512, (bf16_t*)(W + W_UKV), 128, (r >> 1) * 32, (r & 1) * 64, p.kv_norm + l * 128, MapLim{512}, scr, lane); continue; } r -= I_Dd;
        if (r < I_E) { const int n = r >> 7, q = r & 127; tr_item(p.w_branch + ((size_t)l * 4 + n) * 256 * 1024, 1024, (bf16_t*)(W + W_BR) + (size_t)n * 1024 * 256, 256, (q >> 2) * 32, (q & 3) * 64, nullptr, MapLim{1024}, scr, lane); continue; } r -= I_E;
        if (r < I_F) { tr_item(p.w_o + (size_t)l * 1024 * 1024, 1024, (bf16_t*)(W + W_O), 1024, (r >> 4) * 32, (r & 15) * 64, nullptr, MapLim{1024}, scr, lane); continue; } r -= I_F;
        if (r < I_G) { const int e = r >> 8, q = r & 255, rb = q >> 4, kb = q & 15; const int r0 = rb * 32; const bool up = (r0 >> 7) & 1;
            const float* src = (up ? p.w_eu : p.w_eg) + ((size_t)l * NEXP + e) * 1024 * 256;
            tr_item(src, 256, (bf16_t*)(W + W_GU) + (size_t)e * 512 * 1024, 1024, r0, kb * 64, nullptr, MapGU{}, scr, lane); continue; } r -= I_G;
        { const int e = r >> 7, q = r & 127; tr_item(p.w_ed + ((size_t)l * NEXP + e) * 256 * 1024, 1024, (bf16_t*)(W + W_D) + (size_t)e * 1024 * 256, 256, (q >> 2) * 32, (q & 3) * 64, nullptr, MapLim{1024}, scr, lane); }
    }
}

__device__ __forceinline__ void emit_xrow(const Params& p, const f32x4 (&v)[4], int m, int l, int lane) {
    u32x2* o8 = (u32x2*)((bf16_t*)(p.ws + WS_XB) + (size_t)m * D) + lane;
    f32x4 acc = {0.f, 0.f, 0.f, 0.f};
    const float* wf = p.w_in + (size_t)l * D * NIN + C_FXF;
#pragma unroll
    for (int j = 0; j < 4; ++j) {
        u32x2 w; w.x = pk2(v[j].x, v[j].y); w.y = pk2(v[j].z, v[j].w); o8[64 * j] = w;
        const int k = 256 * j + 4 * lane;
        acc += v[j].x * *(const f32x4*)(wf + (size_t)(k + 0) * NIN);
        acc += v[j].y * *(const f32x4*)(wf + (size_t)(k + 1) * NIN);
        acc += v[j].z * *(const f32x4*)(wf + (size_t)(k + 2) * NIN);
        acc += v[j].w * *(const f32x4*)(wf + (size_t)(k + 3) * NIN);
    }
    acc.x = wave_sum(acc.x); acc.y = wave_sum(acc.y); acc.z = wave_sum(acc.z); acc.w = wave_sum(acc.w);
    if (lane == 0) *(f32x4*)((float*)(p.ws + WS_ROUTE + RT_FXF) + (size_t)m * 4) = acc;
}
__device__ __forceinline__ void phase_convx(const Params& p) {
    const int tid = threadIdx.x, lane = tid & 63, wave = tid >> 6;
    const int gw = blockIdx.x * NWAVES + wave, NGW = gridDim.x * NWAVES;
    for (int m = gw; m < T; m += NGW) {
        const f32x4* xr = (const f32x4*)(p.x + (size_t)m * D) + lane; f32x4 v[4];
#pragma unroll
        for (int j = 0; j < 4; ++j) v[j] = xr[64 * j];
        emit_xrow(p, v, m, 0, lane);
    }
}

template <class AP, class BP, class Epi>
__device__ __forceinline__ void ngemm(int M, int N, int K, int lda, int ldb, AP ap, BP bp, Epi epi, float* lds) {
    const int tid = threadIdx.x, ty = tid >> 4, tx = tid & 15;
    float* As = lds; float* Bs = lds + 32 * 128;
    const int ntm = M / 128, ntn = N / 128;
    const int lrow = tid >> 2, lkc = (tid & 3) * 8;
    for (int tile = blockIdx.x; tile < ntm * ntn; tile += gridDim.x) {
        const int tm = tile / ntn, tn = tile % ntn, m0 = tm * 128, n0 = tn * 128;
        const bf16_t* Ab = ap(m0, n0) + (size_t)lrow * lda + lkc; const bf16_t* Bb = bp(m0, n0) + (size_t)lrow * ldb + lkc;
        float acc[4][8];
#pragma unroll
        for (int i = 0; i < 4; ++i)
#pragma unroll
            for (int j = 0; j < 8; ++j) acc[i][j] = 0.f;
        for (int k0 = 0; k0 < K; k0 += 32) {
            const u32x4 va = *(const u32x4*)(Ab + k0); const u32x4 vb = *(const u32x4*)(Bb + k0);
            __syncthreads();
#pragma unroll
            for (int i = 0; i < 4; ++i) {
                As[(lkc + 2 * i) * 128 + lrow] = bf2f(va[i] & 0xffffu); As[(lkc + 2 * i + 1) * 128 + lrow] = bf2f(va[i] >> 16);
                Bs[(lkc + 2 * i) * 128 + lrow] = bf2f(vb[i] & 0xffffu); Bs[(lkc + 2 * i + 1) * 128 + lrow] = bf2f(vb[i] >> 16);
            }
            __syncthreads();
#pragma unroll 8
            for (int kk = 0; kk < 32; ++kk) {
                const f32x4 a = *(const f32x4*)(As + kk * 128 + ty * 4);
                const f32x4 b0 = *(const f32x4*)(Bs + kk * 128 + tx * 8), b1 = *(const f32x4*)(Bs + kk * 128 + tx * 8 + 4);
#pragma unroll
                for (int i = 0; i < 4; ++i) {
                    acc[i][0] += a[i] * b0.x; acc[i][1] += a[i] * b0.y; acc[i][2] += a[i] * b0.z; acc[i][3] += a[i] * b0.w;
                    acc[i][4] += a[i] * b1.x; acc[i][5] += a[i] * b1.y; acc[i][6] += a[i] * b1.z; acc[i][7] += a[i] * b1.w;
                }
            }
        }
#pragma unroll
        for (int i = 0; i < 4; ++i)
#pragma unroll
            for (int j = 0; j < 8; ++j) epi(m0 + ty * 4 + i, n0 + tx * 8 + j, acc[i][j]);
    }
    __syncthreads();
}

__device__ __forceinline__ void expert_offsets(const Params& p, int tb, int* Li) {
    const int tid = threadIdx.x; const int* hist = (const int*)(p.ws + WS_CTL);
    int* tmp = Li + 128;
    const int e = tid & 31, part = tid >> 5;
    int s = 0, pre = 0;
    for (int i = 0; i < 16; ++i) { const int b = part * 16 + i; const int h = hist[b * 32 + e]; s += h; if (b < tb) pre += h; }
    tmp[part * 32 + e] = s; tmp[512 + part * 32 + e] = pre;
    __syncthreads();
    if (tid < 32) { int a = 0, b = 0; for (int i = 0; i < 16; ++i) { a += tmp[i * 32 + tid]; b += tmp[512 + i * 32 + tid]; } Li[tid] = a; Li[65 + tid] = b; }
    __syncthreads();
    if (tid == 0) { int ps = 0; for (int i = 0; i < 32; ++i) { Li[32 + i] = ps; ps += (Li[i] + 255) / 256 * 256; } Li[64] = ps; }
    __syncthreads();
}
__device__ __forceinline__ int tile_expert(const int* Li, int m0) { int e = 0; for (int i = 0; i < 32; ++i) if (m0 >= Li[32 + i] && m0 < Li[33 + i]) e = i; return e; }

__device__ __forceinline__ void phase_inproj(const Params& p, float* lds) {
    const bf16_t* XB = (const bf16_t*)(p.ws + WS_XB); const bf16_t* Bt = (const bf16_t*)(p.ws + WS_W + W_BT1); bf16_t* ZS = (bf16_t*)(p.ws + WS_R1 + R1_ZS);
    ngemm(T, ZSW, 1024, 1024, 1024, [=](int m0, int) { return XB + (size_t)m0 * 1024; }, [=](int, int n0) { return Bt + (size_t)n0 * 1024; },
          [=](int m, int n, float v) { ZS[(size_t)m * ZSW + n] = (bf16_t)f2bf(v); }, lds);
}
__device__ __forceinline__ float logsigmoid_(float x) { return -(fmaxf(-x, 0.f) + log1pf(expf(-fabsf(x)))); }
__device__ __forceinline__ void phase_upproj(const Params& p, int l, float* lds) {
    const int tid = threadIdx.x, lane = tid & 63, wave = tid >> 6;
    for (int bh = blockIdx.x; bh < 16; bh += gridDim.x) if (wave == 0) {
        const int b = bh >> 2, h = bh & 3; const float* F = (const float*)(p.ws + WS_ROUTE + RT_FXF); float* CF = (float*)(p.ws + WS_ROUTE + RT_CF);
        const float bf = p.b_forget[l * 4 + h];
        float run = 0.f;
        for (int j = 0; j < 64; ++j) run += logsigmoid_(F[((size_t)b * SEQ + lane * 64 + j) * 4 + h] + bf);
        float inc = run;
#pragma unroll
        for (int o = 1; o < 64; o <<= 1) { const float y = __shfl_up(inc, o); if (lane >= o) inc += y; }
        float c = inc - run;
        for (int j = 0; j < 64; ++j) { const size_t idx = ((size_t)b * SEQ + lane * 64 + j) * 4 + h; c += logsigmoid_(F[idx] + bf); CF[idx] = c; }
    }
    const bf16_t* ZS = (const bf16_t*)(p.ws + WS_R1 + R1_ZS);
    const bf16_t* Buq = (const bf16_t*)(p.ws + WS_W + W_UQ); const bf16_t* Bukv = (const bf16_t*)(p.ws + WS_W + W_UKV);
    bf16_t* QR = (bf16_t*)(p.ws + WS_R1 + R1_QR); bf16_t* KVR = (bf16_t*)(p.ws + WS_R1 + R1_KVR);
    ngemm(T, 512, 256, ZSW, 256, [=](int m0, int) { return ZS + (size_t)m0 * ZSW + C_CQ; }, [=](int, int n0) { return Buq + (size_t)n0 * 256; },
          [=](int m, int n, float v) { QR[(size_t)m * 512 + n] = (bf16_t)f2bf(v); }, lds);
    ngemm(T, 512, 128, ZSW, 128, [=](int m0, int) { return ZS + (size_t)m0 * ZSW + C_CKV; }, [=](int, int n0) { return Bukv + (size_t)n0 * 128; },
          [=](int m, int n, float v) { KVR[(size_t)m * 512 + n] = (bf16_t)f2bf(v); }, lds);
}

__device__ __forceinline__ void phase_prep(const Params& p, int l, float* lds) {
    const int tid = threadIdx.x, lane = tid & 63, wave = tid >> 6;
    const int gw = blockIdx.x * NWAVES + wave, NGW = gridDim.x * NWAVES;
    const bf16_t* ZS = (const bf16_t*)(p.ws + WS_R1 + R1_ZS); const bf16_t* QR = (const bf16_t*)(p.ws + WS_R1 + R1_QR); const bf16_t* KVR = (const bf16_t*)(p.ws + WS_R1 + R1_KVR);
    bf16_t* Qm = (bf16_t*)(p.ws + WS_C + C_QM); bf16_t* Km = (bf16_t*)(p.ws + WS_C + C_KM); bf16_t* Vm = (bf16_t*)(p.ws + WS_C + C_VM);
    for (int m = gw; m < T; m += NGW) {
        const bf16_t* zr = ZS + (size_t)m * ZSW;
        float sq = 0.f, skv = 0.f;
#pragma unroll
        for (int j = 0; j < 4; ++j) { const float v = bf2f(zr[C_CQ + lane + 64 * j]); sq += v * v; }
#pragma unroll
        for (int j = 0; j < 2; ++j) { const float v = bf2f(zr[C_CKV + lane + 64 * j]); skv += v * v; }
        const float rq = rsqrtf(wave_sum(sq) * (1.f / 256.f) + EPS), rkv = rsqrtf(wave_sum(skv) * (1.f / 128.f) + EPS);
        const float posf = (float)p.pos[m];
        float cs = 1.f, sn = 0.f;
        { const float inv = exp2f(-(float)(lane & 15) * (13.287712379549449f / 16.f)); sincosf(posf * inv, &sn, &cs); }
        const bf16_t* qr = QR + (size_t)m * 512; const bf16_t* kvr = KVR + (size_t)m * 512;
#pragma unroll
        for (int j = 0; j < 6; ++j) {
            const int idx = lane + 64 * j, h = idx / 96, d = idx % 96;
            float q, k;
            const int i = (d - 64) & 15, hf = (d - 64) >> 4;
            const float c = __shfl(cs, i), s = __shfl(sn, i);
            if (d < 64) { q = bf2f(qr[h * 96 + d]); k = bf2f(kvr[h * 128 + d]) * rkv; }
            else {
                const float q1 = bf2f(qr[h * 96 + 64 + i]), q2 = bf2f(qr[h * 96 + 80 + i]);
                const float k1 = bf2f(zr[C_KR + i]), k2 = bf2f(zr[C_KR + 16 + i]);
                q = hf == 0 ? q1 * c - q2 * s : q2 * c + q1 * s;
                k = hf == 0 ? k1 * c - k2 * s : k2 * c + k1 * s;
            }
            Qm[(size_t)m * 384 + idx] = (bf16_t)f2bf(q * rq * C2_M);
            Km[(size_t)m * 384 + idx] = (bf16_t)f2bf(k);
        }
#pragma unroll
        for (int j = 0; j < 4; ++j) { const int idx = lane + 64 * j, h = idx >> 6, d = idx & 63; Vm[(size_t)m * 256 + idx] = (bf16_t)f2bf(bf2f(kvr[h * 128 + 64 + d]) * rkv); }
    }
    __syncthreads();
    float* hs = lds;
    float* ys = lds + 62 * 256;
    bf16_t* YS = (bf16_t*)(p.ws + WS_D);
    const float* cw = p.conv_w + (size_t)l * 31 * 256; const float* cb = p.conv_b + l * 256; const float* lg = p.conv_g + l * 256; const float* lb = p.conv_bb + l * 256;
    for (int ch = blockIdx.x; ch < T / 32; ch += gridDim.x) {
        const int m0 = ch * 32, t0 = m0 & (SEQ - 1);
        for (int idx = tid; idx < 62 * 256; idx += NTHREADS) {
            const int r = idx >> 8, c = idx & 255, tt = t0 - 30 + r; float v = 0.f;
            if (tt >= 0) { const bf16_t* zr = ZS + (size_t)(m0 - 30 + r) * ZSW; v = bf2f(zr[C_CVA + c]) * sigmoidf_(bf2f(zr[C_CVG + c])); }
            hs[idx] = v;
        }
        __syncthreads();
        { const int c = tid & 255, half = tid >> 8; float w[31];
#pragma unroll
            for (int i = 0; i < 31; ++i) w[i] = cw[i * 256 + c];
            const float bias = cb[c];
            for (int i = half * 16; i < half * 16 + 16; ++i) { float a = bias;
#pragma unroll
                for (int k = 0; k < 31; ++k) a += hs[(i + k) * 256 + c] * w[k];
                ys[i * 256 + c] = a; } }
        __syncthreads();
#pragma unroll
        for (int q = 0; q < 4; ++q) {
            const int i = wave * 4 + q; const f32x4 v = *(const f32x4*)(ys + i * 256 + lane * 4);
            const float mean = wave_sum((v.x + v.y) + (v.z + v.w)) * (1.f / 256.f);
            const f32x4 dv = v - mean; const float var = wave_sum((dv.x * dv.x + dv.y * dv.y) + (dv.z * dv.z + dv.w * dv.w)) * (1.f / 256.f);
            const float rstd = rsqrtf(var + EPS);
            const f32x4 g = *(const f32x4*)(lg + lane * 4), bb = *(const f32x4*)(lb + lane * 4);
            f32x4 y = dv * rstd * g + bb;
            y.x = y.x * sigmoidf_(y.x); y.y = y.y * sigmoidf_(y.y); y.z = y.z * sigmoidf_(y.z); y.w = y.w * sigmoidf_(y.w);
            u32x2 o; o.x = pk2(y.x, y.y); o.y = pk2(y.z, y.w);
            *(u32x2*)(YS + (size_t)(m0 + i) * 1024 + 512 + lane * 4) = o;
        }
        __syncthreads();
    }
}

template <int MODE, int DQ>
__device__ __forceinline__ void attn_naive(const bf16_t* Q, int qp, const bf16_t* K, int kp, const bf16_t* V, int vp, const float* CF, bf16_t* Y, float* lds) {
    const int tid = threadIdx.x, lane = tid & 63, wave = tid >> 6;
    const int gw = blockIdx.x * NWAVES + wave, NGW = gridDim.x * NWAVES;
    float* qs = lds + wave * 128;
    for (int row = gw; row < T * 4; row += NGW) {
        const int m = row >> 2, h = row & 3, b = m >> 12, t = m & (SEQ - 1);
        LDS_FENCE();
        for (int d = lane; d < DQ; d += 64) qs[d] = bf2f(Q[(size_t)m * qp + h * DQ + d]);
        LDS_FENCE();
        float acc = 0.f, mx = -INFINITY, l = 0.f, R = 0.f;
        const int last = MODE == 1 ? t - 1 : t;
        const int nch = last < 0 ? 0 : (last >> 6) + 1;
        for (int ci = 0; ci < nch; ++ci) {
            const int j0 = (MODE == 1 ? (nch - 1 - ci) : ci) * 64, j = j0 + lane;
            const bool valid = j <= last;
            const int jc = valid ? j : last;
            const bf16_t* kr = K + ((size_t)b * SEQ + jc) * kp + h * DQ;
            float s = 0.f;
#pragma unroll
            for (int c = 0; c < DQ / 8; ++c) { const u32x4 kv = *(const u32x4*)(kr + c * 8);
#pragma unroll
                for (int i = 0; i < 4; ++i) s += qs[c * 8 + 2 * i] * bf2f(kv[i] & 0xffffu) + qs[c * 8 + 2 * i + 1] * bf2f(kv[i] >> 16); }
            float pj;
            if (MODE == 1) {
                float L2 = valid ? -(fmaxf(s, 0.f) + log2f(1.f + exp2f(-fabsf(s)))) : 0.f;
                float suf = L2;
#pragma unroll
                for (int o = 1; o < 64; o <<= 1) { const float y = __shfl_down(suf, o); if (lane + o < 64) suf += y; }
                const float after = R + (suf - L2);
                pj = valid ? exp2f(s + L2 + after) : 0.f;
                R += __shfl(suf, 0);
            } else {
                if (MODE == 2) s -= CF[((size_t)b * SEQ + jc) * 4 + h] * LOG2E;
                if (!valid) s = -INFINITY;
                const float mn = fmaxf(mx, wave_max(s));
                const float f = exp2f(mx - mn);
                pj = exp2f(s - mn);
                l = l * f + wave_sum(pj); acc *= f; mx = mn;
            }
            const bf16_t* vb = V + ((size_t)b * SEQ + j0) * vp + h * 64 + lane;
            const int nv = last - j0 + 1 < 64 ? last - j0 + 1 : 64;
            for (int jj = 0; jj < nv; ++jj) acc += __shfl(pj, jj) * bf2f(vb[(size_t)jj * vp]);
        }
        if (MODE != 1) acc = nch ? acc / l : 0.f;
        Y[(size_t)m * 1024 + h * 64 + lane] = (bf16_t)f2bf(acc);
    }
}
__device__ __forceinline__ void phase_attn(const Params& p, float* lds) {
    const bf16_t* ZS = (const bf16_t*)(p.ws + WS_R1 + R1_ZS); bf16_t* YS = (bf16_t*)(p.ws + WS_D);
    const bf16_t* Qm = (const bf16_t*)(p.ws + WS_C + C_QM); const bf16_t* Km = (const bf16_t*)(p.ws + WS_C + C_KM); const bf16_t* Vm = (const bf16_t*)(p.ws + WS_C + C_VM);
    const float* CF = (const float*)(p.ws + WS_ROUTE + RT_CF);
    attn_naive<0, 96>(Qm, 384, Km, 384, Vm, 256, nullptr, YS, lds);
    attn_naive<1, 64>(ZS + C_SBQ, ZSW, ZS + C_SBK, ZSW, ZS + C_SBV, ZSW, nullptr, YS + 256, lds);
    attn_naive<2, 64>(ZS + C_FXQ, ZSW, ZS + C_FXK, ZSW, ZS + C_FXV, ZSW, CF, YS + 768, lds);
}

__device__ __forceinline__ void phase_pgemm(const Params& p, float* lds) {
    const bf16_t* YS = (const bf16_t*)(p.ws + WS_D); const bf16_t* Bt = (const bf16_t*)(p.ws + WS_W + W_BR); bf16_t* PB = (bf16_t*)(p.ws + WS_R1 + R1_PB);
    ngemm(T, 4096, 256, 1024, 256, [=](int m0, int n0) { return YS + (size_t)m0 * 1024 + (n0 >> 10) * 256; }, [=](int, int n0) { return Bt + (size_t)n0 * 256; },
          [=](int m, int n, float v) { PB[(size_t)m * 4096 + n] = (bf16_t)f2bf(v); }, lds);
}
__device__ __forceinline__ void phase_gate(const Params& p, int l, float* lds) {
    const bf16_t* XB = (const bf16_t*)(p.ws + WS_XB); const bf16_t* Bt = (const bf16_t*)(p.ws + WS_W + W_GATE); bf16_t* PB = (bf16_t*)(p.ws + WS_R1 + R1_PB);
    const float* bg = p.b_gate + (size_t)l * 4096;
    ngemm(T, 4096, 1024, 1024, 1024, [=](int m0, int) { return XB + (size_t)m0 * 1024; }, [=](int, int n0) { return Bt + (size_t)n0 * 1024; },
          [=](int m, int n, float v) { const size_t i = (size_t)m * 4096 + n; PB[i] = (bf16_t)f2bf(sigmoidf_(v + bg[n]) * bf2f(PB[i])); }, lds);
}
__device__ __forceinline__ void phase_combine(const Params& p) {
    const bf16_t* PB = (const bf16_t*)(p.ws + WS_R1 + R1_PB); bf16_t* MG = (bf16_t*)(p.ws + WS_C);
    for (size_t i = (size_t)blockIdx.x * NTHREADS + threadIdx.x; i < (size_t)T * 1024; i += (size_t)gridDim.x * NTHREADS) {
        const size_t m = i >> 10, d = i & 1023; const bf16_t* r = PB + m * 4096 + d;
        MG[i] = (bf16_t)f2bf((bf2f(r[0]) + bf2f(r[1024])) + (bf2f(r[2048]) + bf2f(r[3072])));
    }
}
__device__ __forceinline__ void phase_wo(const Params& p, int l, float* lds) {
    const bf16_t* MG = (const bf16_t*)(p.ws + WS_C); const bf16_t* Bt = (const bf16_t*)(p.ws + WS_W + W_O);
    const float* xf = l == 0 ? p.x : p.out; float* out = p.out;
    ngemm(T, 1024, 1024, 1024, 1024, [=](int m0, int) { return MG + (size_t)m0 * 1024; }, [=](int, int n0) { return Bt + (size_t)n0 * 1024; },
          [=](int m, int n, float v) { const size_t i = (size_t)m * 1024 + n; out[i] = ALPHA * xf[i] + v; }, lds);
}

__device__ __forceinline__ void ln_row(f32x4 (&v)[4], const float* g, const float* b, int lane) {
    float s = 0.f;
#pragma unroll
    for (int j = 0; j < 4; ++j) s += (v[j].x + v[j].y) + (v[j].z + v[j].w);
    const float mean = wave_sum(s) * (1.f / 1024.f); float s2 = 0.f;
#pragma unroll
    for (int j = 0; j < 4; ++j) { v[j] = v[j] - mean; s2 += (v[j].x * v[j].x + v[j].y * v[j].y) + (v[j].z * v[j].z + v[j].w * v[j].w); }
    const float rstd = rsqrtf(wave_sum(s2) * (1.f / 1024.f) + EPS);
#pragma unroll
    for (int j = 0; j < 4; ++j) { const f32x4 gg = *(const f32x4*)(g + 256 * j + 4 * lane), bb = *(const f32x4*)(b + 256 * j + 4 * lane); v[j] = v[j] * rstd * gg + bb; }
}

__device__ __forceinline__ void phase_ln1route(const Params& p, int l, float* lds) {
    const int tid = threadIdx.x, lane = tid & 63, wave = tid >> 6;
    int* cnt = (int*)lds; float* sl = lds + 64 + wave * 64; float* hrow = lds + 1024 + wave * 1024;
    int* tok_e = (int*)(p.ws + WS_ROUTE + RT_TOKE); float* tok_w = (float*)(p.ws + WS_ROUTE + RT_TOKW); int* tok_p = (int*)(p.ws + WS_ROUTE + RT_TOKP);
    int* hist = (int*)(p.ws + WS_CTL); bf16_t* HB = (bf16_t*)(p.ws + WS_C);
    const float* wrg = p.w_rg + (size_t)l * 1024 * 4; const float* wre = p.w_re + (size_t)l * 1024 * 32;
    for (int tb = blockIdx.x; tb < 256; tb += gridDim.x) {
        if (tid < 32) cnt[tid] = 0;
        __syncthreads();
        for (int q = 0; q < 8; ++q) {
            const int m = tb * 64 + wave * 8 + q;
            f32x4* orow = (f32x4*)(p.out + (size_t)m * D) + lane; f32x4 v[4];
#pragma unroll
            for (int j = 0; j < 4; ++j) v[j] = orow[64 * j];
            ln_row(v, p.ln1_g + l * D, p.ln1_b + l * D, lane);
            u32x2* hb = (u32x2*)(HB + (size_t)m * D) + lane;
#pragma unroll
            for (int j = 0; j < 4; ++j) { orow[64 * j] = v[j]; u32x2 w; w.x = pk2(v[j].x, v[j].y); w.y = pk2(v[j].z, v[j].w); hb[64 * j] = w; }
            float ag[4] = {0.f, 0.f, 0.f, 0.f}; float ae[32];
#pragma unroll
            for (int i = 0; i < 32; ++i) ae[i] = 0.f;
#pragma unroll
            for (int j = 0; j < 4; ++j) *(f32x4*)(hrow + 256 * j + 4 * lane) = v[j];
            LDS_FENCE();
#pragma unroll 2
            for (int kk = 0; kk < 16; ++kk) {
                const int k = kk * 64 + lane; const float hv = hrow[k];
                const f32x4 g4 = *(const f32x4*)(wrg + (size_t)k * 4);
                ag[0] += hv * g4.x; ag[1] += hv * g4.y; ag[2] += hv * g4.z; ag[3] += hv * g4.w;
#pragma unroll
                for (int e4 = 0; e4 < 8; ++e4) { const f32x4 w4 = *(const f32x4*)(wre + (size_t)k * 32 + e4 * 4);
                    ae[e4 * 4 + 0] += hv * w4.x; ae[e4 * 4 + 1] += hv * w4.y; ae[e4 * 4 + 2] += hv * w4.z; ae[e4 * 4 + 3] += hv * w4.w; }
            }
#pragma unroll
            for (int i = 0; i < 4; ++i) { const float r = wave_sum(ag[i]); if (lane == 0) sl[i] = r + p.b_rg[l * 4 + i]; }
#pragma unroll
            for (int i = 0; i < 32; ++i) { const float r = wave_sum(ae[i]); if (lane == 0) sl[4 + i] = r + p.b_re[l * 32 + i]; }
            LDS_FENCE();
            if (lane == 0) {
                int g = 0; float gm = sl[0];
                for (int i = 1; i < 4; ++i) if (sl[i] > gm) { gm = sl[i]; g = i; }
                float gs = 0.f; for (int i = 0; i < 4; ++i) gs += expf(sl[i] - gm);
                const float grp_p = 1.f / gs;
                const float* le = sl + 4 + g * 8;
                int i0 = 0; float m0 = le[0];
                for (int i = 1; i < 8; ++i) if (le[i] > m0) { m0 = le[i]; i0 = i; }
                int i1 = -1; float m1 = -INFINITY;
                for (int i = 0; i < 8; ++i) if (i != i0 && le[i] > m1) { m1 = le[i]; i1 = i; }
                const float e1 = expf(m1 - m0), den = 1.f + e1;
                const int x0 = g * 8 + i0, x1 = g * 8 + i1;
                tok_e[m * 2] = x0; tok_e[m * 2 + 1] = x1;
                tok_w[m * 2] = grp_p / den; tok_w[m * 2 + 1] = grp_p * e1 / den;
                tok_p[m * 2] = atomicAdd(&cnt[x0], 1); tok_p[m * 2 + 1] = atomicAdd(&cnt[x1], 1);
            }
            LDS_FENCE();
        }
        __syncthreads();
        if (tid < 32) hist[tb * 32 + tid] = cnt[tid];
        __syncthreads();
    }
}

__device__ __forceinline__ void phase_gather(const Params& p, float* lds) {
    const int tid = threadIdx.x, lane = tid & 63, wave = tid >> 6;
    int* Li = (int*)lds;
    const int* tok_e = (const int*)(p.ws + WS_ROUTE + RT_TOKE); const float* tok_w = (const float*)(p.ws + WS_ROUTE + RT_TOKW); const int* tok_p = (const int*)(p.ws + WS_ROUTE + RT_TOKP);
    int* tok_s = (int*)(p.ws + WS_ROUTE + RT_TOKS); float* slot_w = (float*)(p.ws + WS_ROUTE + RT_SLOTW);
    const bf16_t* HB = (const bf16_t*)(p.ws + WS_C); bf16_t* XG = (bf16_t*)(p.ws + WS_R1 + R1_XG);
    for (int tb = blockIdx.x; tb < 256; tb += gridDim.x) {
        expert_offsets(p, tb, Li);
        for (int q = 0; q < 16; ++q) {
            const int a = tb * 128 + wave * 16 + q, m = a >> 1;
            const int e = tok_e[a]; const int slot = Li[32 + e] + Li[65 + e] + tok_p[a];
            const u32x4* src = (const u32x4*)(HB + (size_t)m * D) + lane; u32x4* dst = (u32x4*)(XG + (size_t)slot * D) + lane;
            dst[0] = src[0]; dst[64] = src[64];
            if (lane == 0) { tok_s[a] = slot; slot_w[slot] = tok_w[a]; }
        }
        __syncthreads();
    }
}
__device__ __forceinline__ void phase_moeup(const Params& p, float* lds) {
    int* Li = (int*)(lds + 16384);
    expert_offsets(p, 0, Li);
    const bf16_t* XG = (const bf16_t*)(p.ws + WS_R1 + R1_XG); const bf16_t* Bt = (const bf16_t*)(p.ws + WS_W + W_GU); bf16_t* GU = (bf16_t*)(p.ws + WS_C);
    ngemm(Li[64], 512, 1024, 1024, 1024, [=](int m0, int) { return XG + (size_t)m0 * 1024; }, [=](int m0, int n0) { return Bt + ((size_t)tile_expert(Li, m0) * 512 + n0) * 1024; },
          [=](int m, int n, float v) { GU[(size_t)m * 512 + n] = (bf16_t)f2bf(v); }, lds);
}
__device__ __forceinline__ void phase_swiglu(const Params& p, float* lds) {
    int* Li = (int*)(lds + 16384);
    expert_offsets(p, 0, Li);
    const size_t n = (size_t)Li[64] * 256;
    const bf16_t* GU = (const bf16_t*)(p.ws + WS_C); bf16_t* HID = (bf16_t*)(p.ws + WS_R1 + R1_HID);
    for (size_t i = (size_t)blockIdx.x * NTHREADS + threadIdx.x; i < n; i += (size_t)gridDim.x * NTHREADS) {
        const size_t s = i >> 8; const int f = (int)(i & 255), j = f >> 7, rr = f & 127;
        const float g = bf2f(GU[s * 512 + j * 256 + rr]), u = bf2f(GU[s * 512 + j * 256 + 128 + rr]);
        HID[i] = (bf16_t)f2bf(g * sigmoidf_(g) * u);
    }
    __syncthreads();
}
__device__ __forceinline__ void phase_moedown(const Params& p, float* lds) {
    int* Li = (int*)(lds + 16384);
    expert_offsets(p, 0, Li);
    const bf16_t* HID = (const bf16_t*)(p.ws + WS_R1 + R1_HID); const bf16_t* Bt = (const bf16_t*)(p.ws + WS_W + W_D); bf16_t* YSL = (bf16_t*)(p.ws + WS_R1 + R1_YSL);
    const float* slot_w = (const float*)(p.ws + WS_ROUTE + RT_SLOTW);
    ngemm(Li[64], 1024, 256, 256, 256, [=](int m0, int) { return HID + (size_t)m0 * 256; }, [=](int m0, int n0) { return Bt + ((size_t)tile_expert(Li, m0) * 1024 + n0) * 256; },
          [=](int m, int n, float v) { YSL[(size_t)m * 1024 + n] = (bf16_t)f2bf(v * slot_w[m]); }, lds);
}
__device__ __forceinline__ void phase_ln2(const Params& p, int l) {
    const int tid = threadIdx.x, lane = tid & 63, wave = tid >> 6;
    const int gw = blockIdx.x * NWAVES + wave, NGW = gridDim.x * NWAVES;
    const int* tok_s = (const int*)(p.ws + WS_ROUTE + RT_TOKS); const bf16_t* YSL = (const bf16_t*)(p.ws + WS_R1 + R1_YSL);
    for (int m = gw; m < T; m += NGW) {
        f32x4* orow = (f32x4*)(p.out + (size_t)m * D) + lane; f32x4 v[4];
        const u32x2* y0 = (const u32x2*)(YSL + (size_t)tok_s[m * 2] * D) + lane; const u32x2* y1 = (const u32x2*)(YSL + (size_t)tok_s[m * 2 + 1] * D) + lane;
#pragma unroll
        for (int j = 0; j < 4; ++j) {
            const u32x2 a = y0[64 * j], b = y1[64 * j]; const f32x4 hv = orow[64 * j];
            v[j].x = ALPHA * hv.x + (bf2f(a.x & 0xffffu) + bf2f(b.x & 0xffffu)); v[j].y = ALPHA * hv.y + (bf2f(a.x >> 16) + bf2f(b.x >> 16));
            v[j].z = ALPHA * hv.z + (bf2f(a.y & 0xffffu) + bf2f(b.y & 0xffffu)); v[j].w = ALPHA * hv.w + (bf2f(a.y >> 16) + bf2f(b.y >> 16));
        }
        ln_row(v, p.ln2_g + l * D, p.ln2_b + l * D, lane);
#pragma unroll
        for (int j = 0; j < 4; ++j) orow[64 * j] = v[j];
        if (l == 0) emit_xrow(p, v, m, 1, lane);
    }
}

enum { PH_CONVW = 0, PH_INPROJ, PH_UPPROJ, PH_PREP, PH_ATTN, PH_PGEMM, PH_GATE, PH_COMBINE, PH_WO, PH_LN1, PH_GATHER, PH_MOEUP, PH_SWIGLU, PH_MOEDOWN, PH_LN2, PH_N };
__device__ __forceinline__ void run_phase(const Params& p, int ph, int l, float* lds) {
    switch (ph) {
        case PH_CONVW: phase_convw(p, l, lds); if (l == 0) phase_convx(p); break;
        case PH_INPROJ: phase_inproj(p, lds); break;
        case PH_UPPROJ: phase_upproj(p, l, lds); break;
        case PH_PREP: phase_prep(p, l, lds); break;
        case PH_ATTN: phase_attn(p, lds); break;
        case PH_PGEMM: phase_pgemm(p, lds); break;
        case PH_GATE: phase_gate(p, l, lds); break;
        case PH_COMBINE: phase_combine(p); break;
        case PH_WO: phase_wo(p, l, lds); break;
        case PH_LN1: phase_ln1route(p, l, lds); break;
        case PH_GATHER: phase_gather(p, lds); break;
        case PH_MOEUP: phase_moeup(p, lds); break;
        case PH_SWIGLU: phase_swiglu(p, lds); break;
        case PH_MOEDOWN: phase_moedown(p, lds); break;
        case PH_LN2: phase_ln2(p, l); break;
    }
}
template <int PH> __global__ void __launch_bounds__(NTHREADS, 2) k_phase(Params p) {
    extern __shared__ __attribute__((aligned(16))) unsigned char lds_raw[];
    run_phase(p, PH, p.layer, (float*)lds_raw);
}
typedef void (*kfn_t)(Params);
template <int... I> struct KTab { static kfn_t get(int i) { static kfn_t t[] = {k_phase<I>...}; return t[i]; } };
typedef KTab<0, 1, 2, 3, 4, 5, 6, 7, 8, 9, 10, 11, 12, 13, 14> KT;

extern "C" void kernel_launch(void* const* d_in, const int* in_sizes, int n_in, void* d_out, int out_size, void* d_ws, size_t ws_size, hipStream_t stream) {
    static int grid = 0;
    if (grid == 0) {
        if (n_in != 26 || out_size != T * D || ws_size < WS_END) { fprintf(stderr, "kernel_launch: unexpected shapes (n_in %d out %d ws %zu, need %zu)\n", n_in, out_size, ws_size, (size_t)WS_END); grid = -1; return; }
        int dev = 0, cus = 0;
        (void)hipGetDevice(&dev); (void)hipDeviceGetAttribute(&cus, hipDeviceAttributeMultiprocessorCount, dev);
        for (int i = 0; i < PH_N; ++i) (void)hipFuncSetAttribute((const void*)KT::get(i), hipFuncAttributeMaxDynamicSharedMemorySize, LDS_BYTES);
        grid = cus > 0 ? cus : 256;
    }
    if (grid < 0) return;
    Params p{};
    const float** pf = (const float**)&p;
    p.x = (const float*)d_in[0]; p.pos = (const int*)d_in[1];
    for (int i = 2; i < 26; ++i) pf[i] = (const float*)d_in[i];
    p.out = (float*)d_out; p.ws = (unsigned char*)d_ws;
    for (int l = 0; l < 2; ++l)
        for (int ph = 0; ph < PH_N; ++ph) { p.phase = ph; p.layer = l; hipLaunchKernelGGL(KT::get(ph), dim3(grid), dim3(NTHREADS), LDS_BYTES, stream, p); }
}
```

```cpp
#include <hip/hip_runtime.h>
#include <hip/hip_cooperative_groups.h>
#include <cstdio>
#include <cstdint>
namespace cg = cooperative_groups;

typedef unsigned short bf16_t;
typedef float f32x4 __attribute__((ext_vector_type(4)));
typedef unsigned u32x4 __attribute__((ext_vector_type(4)));
typedef unsigned u32x2 __attribute__((ext_vector_type(2)));

constexpr int NB = 4, SEQ = 4096, T = NB * SEQ, D = 1024, NIN = 6564, ZSW = 2560;
constexpr int NEXP = 32, EFF = 256, MAXSLOT = 40960;
constexpr int C_CQ = 0, C_CKV = 256, C_KR = 384, C_SBQ = 416, C_SBK = 672, C_SBV = 928, C_CVA = 1184, C_CVG = 1440,
              C_FXQ = 1696, C_FXK = 1952, C_FXV = 2208, C_FXF = 2464, C_GATE = 2468;
constexpr float LOG2E = 1.4426950408889634f;
constexpr float C2_64 = 0.125f * LOG2E;
constexpr float C2_M = 0.10206207261596575f * LOG2E;
constexpr float ALPHA = 1.4142135623730951f;
constexpr float EPS = 1e-5f;
constexpr int NTHREADS = 512, NWAVES = 8;
constexpr int LDS_BYTES = 147456;

constexpr size_t MiB = 1u << 20;
constexpr size_t WS_CTL = 0;
constexpr size_t WS_ROUTE = 1 * MiB;
constexpr size_t RT_TOKE = 0, RT_TOKW = 131072, RT_TOKP = 262144, RT_TOKS = 393216, RT_SLOTW = 524288, RT_FXF = 786432, RT_CF = 1048576;
constexpr size_t WS_W = 3 * MiB;
constexpr size_t W_BT1 = 0, W_GATE = 5 * MiB, W_UQ = 13 * MiB, W_UKV = W_UQ + 262144, W_BR = W_UKV + 131072, W_O = W_BR + 2 * MiB, W_GU = W_O + 2 * MiB, W_D = W_GU + 32 * MiB;
static_assert(W_D + 16 * MiB <= 66 * MiB, "weights");
constexpr size_t WS_XB = 69 * MiB;
constexpr size_t WS_R1 = 101 * MiB;
constexpr size_t R1_ZS = 0, R1_QR = 80 * MiB, R1_KVR = 96 * MiB, R1_PB = 0, R1_XG = 0, R1_HID = 80 * MiB, R1_YSL = 0;
constexpr size_t WS_C = 229 * MiB;
constexpr size_t C_QM = 0, C_KM = 12 * MiB, C_VM = 24 * MiB;
constexpr size_t WS_D = 261 * MiB;
constexpr size_t WS_END = 293 * MiB;

struct Params {
    const float* x; const int* pos; const float* w_in; const float* b_gate; const float* b_forget;
    const float* q_norm; const float* kv_norm; const float* w_uq; const float* w_ukv;
    const float* conv_w; const float* conv_b; const float* conv_g; const float* conv_bb;
    const float* w_branch; const float* w_o; const float* ln1_g; const float* ln1_b;
    const float* w_rg; const float* b_rg; const float* w_re; const float* b_re;
    const float* w_eg; const float* w_eu; const float* w_ed; const float* ln2_g; const float* ln2_b;
    float* out; unsigned char* ws; int phase; int layer;
};

__device__ __forceinline__ unsigned f2bf(float f) { unsigned u = __float_as_uint(f); return (u + 0x7fffu + ((u >> 16) & 1u)) >> 16; }
__device__ __forceinline__ float bf2f(unsigned b) { return __uint_as_float(b << 16); }
__device__ __forceinline__ unsigned pk2(float lo, float hi) { return f2bf(lo) | (f2bf(hi) << 16); }
__device__ __forceinline__ float wave_sum(float v) {
#pragma unroll
    for (int o = 1; o < 64; o <<= 1) v += __shfl_xor(v, o);
    return v;
}
__device__ __forceinline__ float wave_max(float v) {
#pragma unroll
    for (int o = 1; o < 64; o <<= 1) v = fmaxf(v, __shfl_xor(v, o));
    return v;
}
__device__ __forceinline__ float sigmoidf_(float x) { return 1.f / (1.f + __expf(-x)); }
#define LDS_FENCE() asm volatile("s_waitcnt lgkmcnt(0)" ::: "memory")
__device__ __forceinline__ int tid_() { int t = threadIdx.x; asm volatile("" : "+v"(t)); return t; }
__device__ __forceinline__ int bid_() { int t = blockIdx.x; asm volatile("" : "+s"(t)); return t; }
__device__ __forceinline__ int nblk_() { int t = gridDim.x; asm volatile("" : "+s"(t)); return t; }

template <class F>
__device__ __forceinline__ void tr_item(const float* W, int ldw, bf16_t* out, int Kd, int r0, int k0, const float* ks, F f, float* scr, int lane) {
    const int rl = lane & 31, r = r0 + rl, c = f.col(r); const float s = f.rs(r);
#pragma unroll 8
    for (int i = 0; i < 32; ++i) {
        const int kk = 2 * i + (lane >> 5); float v = 0.f;
        if (c >= 0) { v = W[(size_t)(k0 + kk) * ldw + c] * s; if (ks) v *= ks[k0 + kk]; }
        scr[kk * 33 + rl] = v;
    }
    LDS_FENCE();
    const int cc = lane & 7;
#pragma unroll
    for (int j = 0; j < 4; ++j) {
        const int n = (lane >> 3) + 8 * j; const float* s8 = scr + (8 * cc) * 33 + n;
        u32x4 o; o.x = pk2(s8[0], s8[33]); o.y = pk2(s8[66], s8[99]); o.z = pk2(s8[132], s8[165]); o.w = pk2(s8[198], s8[231]);
        *(u32x4*)(out + (size_t)(r0 + n) * Kd + k0 + 8 * cc) = o;
    }
    LDS_FENCE();
}
struct MapBt1 { __device__ int col(int r) const { return r < C_GATE ? r : -1; } __device__ float rs(int r) const { return ((r >= C_SBQ && r < C_SBK) || (r >= C_FXQ && r < C_FXK)) ? C2_64 : 1.f; } };
struct MapGate { __device__ int col(int r) const { return C_GATE + r; } __device__ float rs(int) const { return 1.f; } };
struct MapLim { int lim; __device__ int col(int r) const { return r < lim ? r : -1; } __device__ float rs(int) const { return 1.f; } };
struct MapGU { __device__ int col(int r) const { return ((r >> 8) << 7) + (r & 127); } __device__ float rs(int) const { return 1.f; } };

__device__ __forceinline__ void phase_convw(const Params& p, int l, float* lds) {
    const int tid = tid_(), lane = tid & 63, wave = tid >> 6;
    float* scr = lds + wave * (64 * 33);
    unsigned char* W = p.ws + WS_W;
    const int gw = bid_() * NWAVES + wave, NGW = nblk_() * NWAVES;
    constexpr int I_A = 80 * 16, I_B = 128 * 16, I_C = 16 * 4, I_Dd = 16 * 2, I_E = 4 * 128, I_F = 32 * 16, I_G = 32 * 256, I_H = 32 * 128;
    constexpr int NIT = I_A + I_B + I_C + I_Dd + I_E + I_F + I_G + I_H;
    for (int it = gw; it < NIT; it += NGW) {
        int r = it;
        if (r < I_A) { tr_item(p.w_in + (size_t)l * D * NIN, NIN, (bf16_t*)(W + W_BT1), 1024, (r >> 4) * 32, (r & 15) * 64, nullptr, MapBt1{}, scr, lane); continue; } r -= I_A;
        if (r < I_B) { tr_item(p.w_in + (size_t)l * D * NIN, NIN, (bf16_t*)(W + W_GATE), 1024, (r >> 4) * 32, (r & 15) * 64, nullptr, MapGate{}, scr, lane); continue; } r -= I_B;
        if (r < I_C) { tr_item(p.w_uq + (size_t)l * 256 * 384, 384, (bf16_t*)(W + W_UQ), 256, (r >> 2) * 32, (r & 3) * 64, p.q_norm + l * 256, MapLim{384}, scr, lane); continue; } r -= I_C;
        if (r < I_Dd) { tr_item(p.w_ukv + (size_t)l * 128 * 512, 512, (bf16_t*)(W + W_UKV), 128, (r >> 1) * 32, (r & 1) * 64, p.kv_norm + l * 128, MapLim{512}, scr, lane); continue; } r -= I_Dd;
        if (r < I_E) { const int n = r >> 7, q = r & 127; tr_item(p.w_branch + ((size_t)l * 4 + n) * 256 * 1024, 1024, (bf16_t*)(W + W_BR) + (size_t)n * 1024 * 256, 256, (q >> 2) * 32, (q & 3) * 64, nullptr, MapLim{1024}, scr, lane); continue; } r -= I_E;
        if (r < I_F) { tr_item(p.w_o + (size_t)l * 1024 * 1024, 1024, (bf16_t*)(W + W_O), 1024, (r >> 4) * 32, (r & 15) * 64, nullptr, MapLim{1024}, scr, lane); continue; } r -= I_F;
        if (r < I_G) { const int e = r >> 8, q = r & 255, rb = q >> 4, kb = q & 15; const int r0 = rb * 32; const bool up = (r0 >> 7) & 1;
            const float* src = (up ? p.w_eu : p.w_eg) + ((size_t)l * NEXP + e) * 1024 * 256;
            tr_item(src, 256, (bf16_t*)(W + W_GU) + (size_t)e * 512 * 1024, 1024, r0, kb * 64, nullptr, MapGU{}, scr, lane); continue; } r -= I_G;
        { const int e = r >> 7, q = r & 127; tr_item(p.w_ed + ((size_t)l * NEXP + e) * 256 * 1024, 1024, (bf16_t*)(W + W_D) + (size_t)e * 1024 * 256, 256, (q >> 2) * 32, (q & 3) * 64, nullptr, MapLim{1024}, scr, lane); }
    }
}

__device__ __forceinline__ void emit_xrow(const Params& p, const f32x4 (&v)[4], int m, int l, int lane) {
    u32x2* o8 = (u32x2*)((bf16_t*)(p.ws + WS_XB) + (size_t)m * D) + lane;
    f32x4 acc = {0.f, 0.f, 0.f, 0.f};
    const float* wf = p.w_in + (size_t)l * D * NIN + C_FXF;
#pragma unroll
    for (int j = 0; j < 4; ++j) {
        u32x2 w; w.x = pk2(v[j].x, v[j].y); w.y = pk2(v[j].z, v[j].w); o8[64 * j] = w;
        const int k = 256 * j + 4 * lane;
        acc += v[j].x * *(const f32x4*)(wf + (size_t)(k + 0) * NIN);
        acc += v[j].y * *(const f32x4*)(wf + (size_t)(k + 1) * NIN);
        acc += v[j].z * *(const f32x4*)(wf + (size_t)(k + 2) * NIN);
        acc += v[j].w * *(const f32x4*)(wf + (size_t)(k + 3) * NIN);
    }
    acc.x = wave_sum(acc.x); acc.y = wave_sum(acc.y); acc.z = wave_sum(acc.z); acc.w = wave_sum(acc.w);
    if (lane == 0) *(f32x4*)((float*)(p.ws + WS_ROUTE + RT_FXF) + (size_t)m * 4) = acc;
}
__device__ __forceinline__ void phase_convx(const Params& p) {
    const int tid = tid_(), lane = tid & 63, wave = tid >> 6;
    const int gw = bid_() * NWAVES + wave, NGW = nblk_() * NWAVES;
    for (int m = gw; m < T; m += NGW) {
        const f32x4* xr = (const f32x4*)(p.x + (size_t)m * D) + lane; f32x4 v[4];
#pragma unroll
        for (int j = 0; j < 4; ++j) v[j] = xr[64 * j];
        emit_xrow(p, v, m, 0, lane);
    }
}

template <class AP, class BP, class Epi>
__device__ __forceinline__ void ngemm(int M, int N, int K, int lda, int ldb, AP ap, BP bp, Epi epi, float* lds) {
    const int tid = tid_(), ty = tid >> 4, tx = tid & 15;
    float* As = lds; float* Bs = lds + 32 * 128;
    const int ntm = M / 128, ntn = N / 128;
    const int lrow = tid >> 2, lkc = (tid & 3) * 8;
    for (int tile = bid_(); tile < ntm * ntn; tile += nblk_()) {
        const int tm = tile / ntn, tn = tile % ntn, m0 = tm * 128, n0 = tn * 128;
        const bf16_t* Ab = ap(m0, n0) + (size_t)lrow * lda + lkc; const bf16_t* Bb = bp(m0, n0) + (size_t)lrow * ldb + lkc;
        float acc[4][8];
#pragma unroll
        for (int i = 0; i < 4; ++i)
#pragma unroll
            for (int j = 0; j < 8; ++j) acc[i][j] = 0.f;
        for (int k0 = 0; k0 < K; k0 += 32) {
            const u32x4 va = *(const u32x4*)(Ab + k0); const u32x4 vb = *(const u32x4*)(Bb + k0);
            __syncthreads();
#pragma unroll
            for (int i = 0; i < 4; ++i) {
                As[(lkc + 2 * i) * 128 + lrow] = bf2f(va[i] & 0xffffu); As[(lkc + 2 * i + 1) * 128 + lrow] = bf2f(va[i] >> 16);
                Bs[(lkc + 2 * i) * 128 + lrow] = bf2f(vb[i] & 0xffffu); Bs[(lkc + 2 * i + 1) * 128 + lrow] = bf2f(vb[i] >> 16);
            }
            __syncthreads();
#pragma unroll 8
            for (int kk = 0; kk < 32; ++kk) {
                const f32x4 a = *(const f32x4*)(As + kk * 128 + ty * 4);
                const f32x4 b0 = *(const f32x4*)(Bs + kk * 128 + tx * 8), b1 = *(const f32x4*)(Bs + kk * 128 + tx * 8 + 4);
#pragma unroll
                for (int i = 0; i < 4; ++i) {
                    acc[i][0] += a[i] * b0.x; acc[i][1] += a[i] * b0.y; acc[i][2] += a[i] * b0.z; acc[i][3] += a[i] * b0.w;
                    acc[i][4] += a[i] * b1.x; acc[i][5] += a[i] * b1.y; acc[i][6] += a[i] * b1.z; acc[i][7] += a[i] * b1.w;
                }
            }
        }
#pragma unroll
        for (int i = 0; i < 4; ++i)
#pragma unroll
            for (int j = 0; j < 8; ++j) epi(m0 + ty * 4 + i, n0 + tx * 8 + j, acc[i][j]);
    }
    __syncthreads();
}

__device__ __forceinline__ void expert_offsets(const Params& p, int tb, int* Li) {
    const int tid = tid_(); const int* hist = (const int*)(p.ws + WS_CTL);
    int* tmp = Li + 128;
    const int e = tid & 31, part = tid >> 5;
    int s = 0, pre = 0;
    for (int i = 0; i < 16; ++i) { const int b = part * 16 + i; const int h = hist[b * 32 + e]; s += h; if (b < tb) pre += h; }
    tmp[part * 32 + e] = s; tmp[512 + part * 32 + e] = pre;
    __syncthreads();
    if (tid < 32) { int a = 0, b = 0; for (int i = 0; i < 16; ++i) { a += tmp[i * 32 + tid]; b += tmp[512 + i * 32 + tid]; } Li[tid] = a; Li[65 + tid] = b; }
    __syncthreads();
    if (tid == 0) { int ps = 0; for (int i = 0; i < 32; ++i) { Li[32 + i] = ps; ps += (Li[i] + 255) / 256 * 256; } Li[64] = ps; }
    __syncthreads();
}
__device__ __forceinline__ int tile_expert(const int* Li, int m0) { int e = 0; for (int i = 0; i < 32; ++i) if (m0 >= Li[32 + i] && m0 < Li[33 + i]) e = i; return e; }

__device__ __forceinline__ void phase_inproj(const Params& p, float* lds) {
    const bf16_t* XB = (const bf16_t*)(p.ws + WS_XB); const bf16_t* Bt = (const bf16_t*)(p.ws + WS_W + W_BT1); bf16_t* ZS = (bf16_t*)(p.ws + WS_R1 + R1_ZS);
    ngemm(T, ZSW, 1024, 1024, 1024, [=](int m0, int) { return XB + (size_t)m0 * 1024; }, [=](int, int n0) { return Bt + (size_t)n0 * 1024; },
          [=](int m, int n, float v) { ZS[(size_t)m * ZSW + n] = (bf16_t)f2bf(v); }, lds);
}
__device__ __forceinline__ float logsigmoid_(float x) { return -(fmaxf(-x, 0.f) + log1pf(expf(-fabsf(x)))); }
__device__ __forceinline__ void phase_upproj(const Params& p, int l, float* lds) {
    const int tid = tid_(), lane = tid & 63, wave = tid >> 6;
    for (int bh = bid_(); bh < 16; bh += nblk_()) if (wave == 0) {
        const int b = bh >> 2, h = bh & 3; const float* F = (const float*)(p.ws + WS_ROUTE + RT_FXF); float* CF = (float*)(p.ws + WS_ROUTE + RT_CF);
        const float bf = p.b_forget[l * 4 + h];
        float run = 0.f;
        for (int j = 0; j < 64; ++j) run += logsigmoid_(F[((size_t)b * SEQ + lane * 64 + j) * 4 + h] + bf);
        float inc = run;
#pragma unroll
        for (int o = 1; o < 64; o <<= 1) { const float y = __shfl_up(inc, o); if (lane >= o) inc += y; }
        float c = inc - run;
        for (int j = 0; j < 64; ++j) { const size_t idx = ((size_t)b * SEQ + lane * 64 + j) * 4 + h; c += logsigmoid_(F[idx] + bf); CF[idx] = c; }
    }
    const bf16_t* ZS = (const bf16_t*)(p.ws + WS_R1 + R1_ZS);
    const bf16_t* Buq = (const bf16_t*)(p.ws + WS_W + W_UQ); const bf16_t* Bukv = (const bf16_t*)(p.ws + WS_W + W_UKV);
    bf16_t* QR = (bf16_t*)(p.ws + WS_R1 + R1_QR); bf16_t* KVR = (bf16_t*)(p.ws + WS_R1 + R1_KVR);
    ngemm(T, 512, 256, ZSW, 256, [=](int m0, int) { return ZS + (size_t)m0 * ZSW + C_CQ; }, [=](int, int n0) { return Buq + (size_t)n0 * 256; },
          [=](int m, int n, float v) { QR[(size_t)m * 512 + n] = (bf16_t)f2bf(v); }, lds);
    ngemm(T, 512, 128, ZSW, 128, [=](int m0, int) { return ZS + (size_t)m0 * ZSW + C_CKV; }, [=](int, int n0) { return Bukv + (size_t)n0 * 128; },
          [=](int m, int n, float v) { KVR[(size_t)m * 512 + n] = (bf16_t)f2bf(v); }, lds);
}

__device__ __forceinline__ void phase_prep(const Params& p, int l, float* lds) {
    const int tid = tid_(), lane = tid & 63, wave = tid >> 6;
    const int gw = bid_() * NWAVES + wave, NGW = nblk_() * NWAVES;
    const bf16_t* ZS = (const bf16_t*)(p.ws + WS_R1 + R1_ZS); const bf16_t* QR = (const bf16_t*)(p.ws + WS_R1 + R1_QR); const bf16_t* KVR = (const bf16_t*)(p.ws + WS_R1 + R1_KVR);
    bf16_t* Qm = (bf16_t*)(p.ws + WS_C + C_QM); bf16_t* Km = (bf16_t*)(p.ws + WS_C + C_KM); bf16_t* Vm = (bf16_t*)(p.ws + WS_C + C_VM);
    for (int m = gw; m < T; m += NGW) {
        const bf16_t* zr = ZS + (size_t)m * ZSW;
        float sq = 0.f, skv = 0.f;
#pragma unroll
        for (int j = 0; j < 4; ++j) { const float v = bf2f(zr[C_CQ + lane + 64 * j]); sq += v * v; }
#pragma unroll
        for (int j = 0; j < 2; ++j) { const float v = bf2f(zr[C_CKV + lane + 64 * j]); skv += v * v; }
        const float rq = rsqrtf(wave_sum(sq) * (1.f / 256.f) + EPS), rkv = rsqrtf(wave_sum(skv) * (1.f / 128.f) + EPS);
        const float posf = (float)p.pos[m];
        float cs = 1.f, sn = 0.f;
        { const float inv = exp2f(-(float)(lane & 15) * (13.287712379549449f / 16.f)); sincosf(posf * inv, &sn, &cs); }
        const bf16_t* qr = QR + (size_t)m * 512; const bf16_t* kvr = KVR + (size_t)m * 512;
#pragma unroll
        for (int j = 0; j < 6; ++j) {
            const int idx = lane + 64 * j, h = idx / 96, d = idx % 96;
            float q, k;
            const int i = (d - 64) & 15, hf = (d - 64) >> 4;
            const float c = __shfl(cs, i), s = __shfl(sn, i);
            if (d < 64) { q = bf2f(qr[h * 96 + d]); k = bf2f(kvr[h * 128 + d]) * rkv; }
            else {
                const float q1 = bf2f(qr[h * 96 + 64 + i]), q2 = bf2f(qr[h * 96 + 80 + i]);
                const float k1 = bf2f(zr[C_KR + i]), k2 = bf2f(zr[C_KR + 16 + i]);
                q = hf == 0 ? q1 * c - q2 * s : q2 * c + q1 * s;
                k = hf == 0 ? k1 * c - k2 * s : k2 * c + k1 * s;
            }
            Qm[(size_t)m * 384 + idx] = (bf16_t)f2bf(q * rq * C2_M);
            Km[(size_t)m * 384 + idx] = (bf16_t)f2bf(k);
        }
#pragma unroll
        for (int j = 0; j < 4; ++j) { const int idx = lane + 64 * j, h = idx >> 6, d = idx & 63; Vm[(size_t)m * 256 + idx] = (bf16_t)f2bf(bf2f(kvr[h * 128 + 64 + d]) * rkv); }
    }
    __syncthreads();
    float* hs = lds;
    float* ys = lds + 62 * 256;
    bf16_t* YS = (bf16_t*)(p.ws + WS_D);
    const float* cw = p.conv_w + (size_t)l * 31 * 256; const float* cb = p.conv_b + l * 256; const float* lg = p.conv_g + l * 256; const float* lb = p.conv_bb + l * 256;
    for (int ch = bid_(); ch < T / 32; ch += nblk_()) {
        const int m0 = ch * 32, t0 = m0 & (SEQ - 1);
        for (int idx = tid; idx < 62 * 256; idx += NTHREADS) {
            const int r = idx >> 8, c = idx & 255, tt = t0 - 30 + r; float v = 0.f;
            if (tt >= 0) { const bf16_t* zr = ZS + (size_t)(m0 - 30 + r) * ZSW; v = bf2f(zr[C_CVA + c]) * sigmoidf_(bf2f(zr[C_CVG + c])); }
            hs[idx] = v;
        }
        __syncthreads();
        { const int c = tid & 255, half = tid >> 8; float w[31];
#pragma unroll
            for (int i = 0; i < 31; ++i) w[i] = cw[i * 256 + c];
            const float bias = cb[c];
            for (int i = half * 16; i < half * 16 + 16; ++i) { float a = bias;
#pragma unroll
                for (int k = 0; k < 31; ++k) a += hs[(i + k) * 256 + c] * w[k];
                ys[i * 256 + c] = a; } }
        __syncthreads();
#pragma unroll
        for (int q = 0; q < 4; ++q) {
            const int i = wave * 4 + q; const f32x4 v = *(const f32x4*)(ys + i * 256 + lane * 4);
            const float mean = wave_sum((v.x + v.y) + (v.z + v.w)) * (1.f / 256.f);
            const f32x4 dv = v - mean; const float var = wave_sum((dv.x * dv.x + dv.y * dv.y) + (dv.z * dv.z + dv.w * dv.w)) * (1.f / 256.f);
            const float rstd = rsqrtf(var + EPS);
            const f32x4 g = *(const f32x4*)(lg + lane * 4), bb = *(const f32x4*)(lb + lane * 4);
            f32x4 y = dv * rstd * g + bb;
            y.x = y.x * sigmoidf_(y.x); y.y = y.y * sigmoidf_(y.y); y.z = y.z * sigmoidf_(y.z); y.w = y.w * sigmoidf_(y.w);
            u32x2 o; o.x = pk2(y.x, y.y); o.y = pk2(y.z, y.w);
            *(u32x2*)(YS + (size_t)(m0 + i) * 1024 + 512 + lane * 4) = o;
        }
        __syncthreads();
    }
}

template <int MODE, int DQ>
__device__ __forceinline__ void attn_naive(const bf16_t* Q, int qp, const bf16_t* K, int kp, const bf16_t* V, int vp, const float* CF, bf16_t* Y, float* lds) {
    const int tid = tid_(), lane = tid & 63, wave = tid >> 6;
    const int gw = bid_() * NWAVES + wave, NGW = nblk_() * NWAVES;
    float* qs = lds + wave * 128;
    for (int row = gw; row < T * 4; row += NGW) {
        const int m = row >> 2, h = row & 3, b = m >> 12, t = m & (SEQ - 1);
        LDS_FENCE();
        for (int d = lane; d < DQ; d += 64) qs[d] = bf2f(Q[(size_t)m * qp + h * DQ + d]);
        LDS_FENCE();
        float acc = 0.f, mx = -INFINITY, l = 0.f, R = 0.f;
        const int last = MODE == 1 ? t - 1 : t;
        const int nch = last < 0 ? 0 : (last >> 6) + 1;
        for (int ci = 0; ci < nch; ++ci) {
            const int j0 = (MODE == 1 ? (nch - 1 - ci) : ci) * 64, j = j0 + lane;
            const bool valid = j <= last;
            const int jc = valid ? j : last;
            const bf16_t* kr = K + ((size_t)b * SEQ + jc) * kp + h * DQ;
            float s = 0.f;
#pragma unroll
            for (int c = 0; c < DQ / 8; ++c) { const u32x4 kv = *(const u32x4*)(kr + c * 8);
#pragma unroll
                for (int i = 0; i < 4; ++i) s += qs[c * 8 + 2 * i] * bf2f(kv[i] & 0xffffu) + qs[c * 8 + 2 * i + 1] * bf2f(kv[i] >> 16); }
            float pj;
            if (MODE == 1) {
                float L2 = valid ? -(fmaxf(s, 0.f) + log2f(1.f + exp2f(-fabsf(s)))) : 0.f;
                float suf = L2;
#pragma unroll
                for (int o = 1; o < 64; o <<= 1) { const float y = __shfl_down(suf, o); if (lane + o < 64) suf += y; }
                const float after = R + (suf - L2);
                pj = valid ? exp2f(s + L2 + after) : 0.f;
                R += __shfl(suf, 0);
            } else {
                if (MODE == 2) s -= CF[((size_t)b * SEQ + jc) * 4 + h] * LOG2E;
                if (!valid) s = -INFINITY;
                const float mn = fmaxf(mx, wave_max(s));
                const float f = exp2f(mx - mn);
                pj = exp2f(s - mn);
                l = l * f + wave_sum(pj); acc *= f; mx = mn;
            }
            const bf16_t* vb = V + ((size_t)b * SEQ + j0) * vp + h * 64 + lane;
            const int nv = last - j0 + 1 < 64 ? last - j0 + 1 : 64;
            for (int jj = 0; jj < nv; ++jj) acc += __shfl(pj, jj) * bf2f(vb[(size_t)jj * vp]);
        }
        if (MODE != 1) acc = nch ? acc / l : 0.f;
        Y[(size_t)m * 1024 + h * 64 + lane] = (bf16_t)f2bf(acc);
    }
}
__device__ __forceinline__ void phase_attn(const Params& p, float* lds) {
    const bf16_t* ZS = (const bf16_t*)(p.ws + WS_R1 + R1_ZS); bf16_t* YS = (bf16_t*)(p.ws + WS_D);
    const bf16_t* Qm = (const bf16_t*)(p.ws + WS_C + C_QM); const bf16_t* Km = (const bf16_t*)(p.ws + WS_C + C_KM); const bf16_t* Vm = (const bf16_t*)(p.ws + WS_C + C_VM);
    const float* CF = (const float*)(p.ws + WS_ROUTE + RT_CF);
    attn_naive<0, 96>(Qm, 384, Km, 384, Vm, 256, nullptr, YS, lds);
    attn_naive<1, 64>(ZS + C_SBQ, ZSW, ZS + C_SBK, ZSW, ZS + C_SBV, ZSW, nullptr, YS + 256, lds);
    attn_naive<2, 64>(ZS + C_FXQ, ZSW, ZS + C_FXK, ZSW, ZS + C_FXV, ZSW, CF, YS + 768, lds);
}

__device__ __forceinline__ void phase_pgemm(const Params& p, float* lds) {
    const bf16_t* YS = (const bf16_t*)(p.ws + WS_D); const bf16_t* Bt = (const bf16_t*)(p.ws + WS_W + W_BR); bf16_t* PB = (bf16_t*)(p.ws + WS_R1 + R1_PB);
    ngemm(T, 4096, 256, 1024, 256, [=](int m0, int n0) { return YS + (size_t)m0 * 1024 + (n0 >> 10) * 256; }, [=](int, int n0) { return Bt + (size_t)n0 * 256; },
          [=](int m, int n, float v) { PB[(size_t)m * 4096 + n] = (bf16_t)f2bf(v); }, lds);
}
__device__ __forceinline__ void phase_gate(const Params& p, int l, float* lds) {
    const bf16_t* XB = (const bf16_t*)(p.ws + WS_XB); const bf16_t* Bt = (const bf16_t*)(p.ws + WS_W + W_GATE); bf16_t* PB = (bf16_t*)(p.ws + WS_R1 + R1_PB);
    const float* bg = p.b_gate + (size_t)l * 4096;
    ngemm(T, 4096, 1024, 1024, 1024, [=](int m0, int) { return XB + (size_t)m0 * 1024; }, [=](int, int n0) { return Bt + (size_t)n0 * 1024; },
          [=](int m, int n, float v) { const size_t i = (size_t)m * 4096 + n; PB[i] = (bf16_t)f2bf(sigmoidf_(v + bg[n]) * bf2f(PB[i])); }, lds);
}
__device__ __forceinline__ void phase_combine(const Params& p) {
    const bf16_t* PB = (const bf16_t*)(p.ws + WS_R1 + R1_PB); bf16_t* MG = (bf16_t*)(p.ws + WS_C);
    for (size_t i = (size_t)bid_() * NTHREADS + tid_(); i < (size_t)T * 1024; i += (size_t)nblk_() * NTHREADS) {
        const size_t m = i >> 10, d = i & 1023; const bf16_t* r = PB + m * 4096 + d;
        MG[i] = (bf16_t)f2bf((bf2f(r[0]) + bf2f(r[1024])) + (bf2f(r[2048]) + bf2f(r[3072])));
    }
}
__device__ __forceinline__ void phase_wo(const Params& p, int l, float* lds) {
    const bf16_t* MG = (const bf16_t*)(p.ws + WS_C); const bf16_t* Bt = (const bf16_t*)(p.ws + WS_W + W_O);
    const float* xf = l == 0 ? p.x : p.out; float* out = p.out;
    ngemm(T, 1024, 1024, 1024, 1024, [=](int m0, int) { return MG + (size_t)m0 * 1024; }, [=](int, int n0) { return Bt + (size_t)n0 * 1024; },
          [=](int m, int n, float v) { const size_t i = (size_t)m * 1024 + n; out[i] = ALPHA * xf[i] + v; }, lds);
}

__device__ __forceinline__ void ln_row(f32x4 (&v)[4], const float* g, const float* b, int lane) {
    float s = 0.f;
#pragma unroll
    for (int j = 0; j < 4; ++j) s += (v[j].x + v[j].y) + (v[j].z + v[j].w);
    const float mean = wave_sum(s) * (1.f / 1024.f); float s2 = 0.f;
#pragma unroll
    for (int j = 0; j < 4; ++j) { v[j] = v[j] - mean; s2 += (v[j].x * v[j].x + v[j].y * v[j].y) + (v[j].z * v[j].z + v[j].w * v[j].w); }
    const float rstd = rsqrtf(wave_sum(s2) * (1.f / 1024.f) + EPS);
#pragma unroll
    for (int j = 0; j < 4; ++j) { const f32x4 gg = *(const f32x4*)(g + 256 * j + 4 * lane), bb = *(const f32x4*)(b + 256 * j + 4 * lane); v[j] = v[j] * rstd * gg + bb; }
}

__device__ __forceinline__ void phase_ln1route(const Params& p, int l, float* lds) {
    const int tid = tid_(), lane = tid & 63, wave = tid >> 6;
    int* cnt = (int*)lds; float* sl = lds + 64 + wave * 64; float* hrow = lds + 1024 + wave * 1024;
    int* tok_e = (int*)(p.ws + WS_ROUTE + RT_TOKE); float* tok_w = (float*)(p.ws + WS_ROUTE + RT_TOKW); int* tok_p = (int*)(p.ws + WS_ROUTE + RT_TOKP);
    int* hist = (int*)(p.ws + WS_CTL); bf16_t* HB = (bf16_t*)(p.ws + WS_C);
    const float* wrg = p.w_rg + (size_t)l * 1024 * 4; const float* wre = p.w_re + (size_t)l * 1024 * 32;
    for (int tb = bid_(); tb < 256; tb += nblk_()) {
        if (tid < 32) cnt[tid] = 0;
        __syncthreads();
        for (int q = 0; q < 8; ++q) {
            const int m = tb * 64 + wave * 8 + q;
            f32x4* orow = (f32x4*)(p.out + (size_t)m * D) + lane; f32x4 v[4];
#pragma unroll
            for (int j = 0; j < 4; ++j) v[j] = orow[64 * j];
            ln_row(v, p.ln1_g + l * D, p.ln1_b + l * D, lane);
            u32x2* hb = (u32x2*)(HB + (size_t)m * D) + lane;
#pragma unroll
            for (int j = 0; j < 4; ++j) { orow[64 * j] = v[j]; u32x2 w; w.x = pk2(v[j].x, v[j].y); w.y = pk2(v[j].z, v[j].w); hb[64 * j] = w; }
            float ag[4] = {0.f, 0.f, 0.f, 0.f}; float ae[32];
#pragma unroll
            for (int i = 0; i < 32; ++i) ae[i] = 0.f;
#pragma unroll
            for (int j = 0; j < 4; ++j) *(f32x4*)(hrow + 256 * j + 4 * lane) = v[j];
            LDS_FENCE();
#pragma unroll 2
            for (int kk = 0; kk < 16; ++kk) {
                const int k = kk * 64 + lane; const float hv = hrow[k];
                const f32x4 g4 = *(const f32x4*)(wrg + (size_t)k * 4);
                ag[0] += hv * g4.x; ag[1] += hv * g4.y; ag[2] += hv * g4.z; ag[3] += hv * g4.w;
#pragma unroll
                for (int e4 = 0; e4 < 8; ++e4) { const f32x4 w4 = *(const f32x4*)(wre + (size_t)k * 32 + e4 * 4);
                    ae[e4 * 4 + 0] += hv * w4.x; ae[e4 * 4 + 1] += hv * w4.y; ae[e4 * 4 + 2] += hv * w4.z; ae[e4 * 4 + 3] += hv * w4.w; }
            }
#pragma unroll
            for (int i = 0; i < 4; ++i) { const float r = wave_sum(ag[i]); if (lane == 0) sl[i] = r + p.b_rg[l * 4 + i]; }
#pragma unroll
            for (int i = 0; i < 32; ++i) { const float r = wave_sum(ae[i]); if (lane == 0) sl[4 + i] = r + p.b_re[l * 32 + i]; }
            LDS_FENCE();
            if (lane == 0) {
                int g = 0; float gm = sl[0];
                for (int i = 1; i < 4; ++i) if (sl[i] > gm) { gm = sl[i]; g = i; }
                float gs = 0.f; for (int i = 0; i < 4; ++i) gs += expf(sl[i] - gm);
                const float grp_p = 1.f / gs;
                const float* le = sl + 4 + g * 8;
                int i0 = 0; float m0 = le[0];
                for (int i = 1; i < 8; ++i) if (le[i] > m0) { m0 = le[i]; i0 = i; }
                int i1 = -1; float m1 = -INFINITY;
                for (int i = 0; i < 8; ++i) if (i != i0 && le[i] > m1) { m1 = le[i]; i1 = i; }
                const float e1 = expf(m1 - m0), den = 1.f + e1;
                const int x0 = g * 8 + i0, x1 = g * 8 + i1;
                tok_e[m * 2] = x0; tok_e[m * 2 + 1] = x1;
                tok_w[m * 2] = grp_p / den; tok_w[m * 2 + 1] = grp_p * e1 / den;
                tok_p[m * 2] = atomicAdd(&cnt[x0], 1); tok_p[m * 2 + 1] = atomicAdd(&cnt[x1], 1);
            }
            LDS_FENCE();
        }
        __syncthreads();
        if (tid < 32) hist[tb * 32 + tid] = cnt[tid];
        __syncthreads();
    }
}

__device__ __forceinline__ void phase_gather(const Params& p, float* lds) {
    const int tid = tid_(), lane = tid & 63, wave = tid >> 6;
    int* Li = (int*)lds;
    const int* tok_e = (const int*)(p.ws + WS_ROUTE + RT_TOKE); const float* tok_w = (const float*)(p.ws + WS_ROUTE + RT_TOKW); const int* tok_p = (const int*)(p.ws + WS_ROUTE + RT_TOKP);
    int* tok_s = (int*)(p.ws + WS_ROUTE + RT_TOKS); float* slot_w = (float*)(p.ws + WS_ROUTE + RT_SLOTW);
    const bf16_t* HB = (const bf16_t*)(p.ws + WS_C); bf16_t* XG = (bf16_t*)(p.ws + WS_R1 + R1_XG);
    for (int tb = bid_(); tb < 256; tb += nblk_()) {
        expert_offsets(p, tb, Li);
        for (int q = 0; q < 16; ++q) {
            const int a = tb * 128 + wave * 16 + q, m = a >> 1;
            const int e = tok_e[a]; const int slot = Li[32 + e] + Li[65 + e] + tok_p[a];
            const u32x4* src = (const u32x4*)(HB + (size_t)m * D) + lane; u32x4* dst = (u32x4*)(XG + (size_t)slot * D) + lane;
            dst[0] = src[0]; dst[64] = src[64];
            if (lane == 0) { tok_s[a] = slot; slot_w[slot] = tok_w[a]; }
        }
        __syncthreads();
    }
}
__device__ __forceinline__ void phase_moeup(const Params& p, float* lds) {
    int* Li = (int*)(lds + 16384);
    expert_offsets(p, 0, Li);
    const bf16_t* XG = (const bf16_t*)(p.ws + WS_R1 + R1_XG); const bf16_t* Bt = (const bf16_t*)(p.ws + WS_W + W_GU); bf16_t* GU = (bf16_t*)(p.ws + WS_C);
    ngemm(Li[64], 512, 1024, 1024, 1024, [=](int m0, int) { return XG + (size_t)m0 * 1024; }, [=](int m0, int n0) { return Bt + ((size_t)tile_expert(Li, m0) * 512 + n0) * 1024; },
          [=](int m, int n, float v) { GU[(size_t)m * 512 + n] = (bf16_t)f2bf(v); }, lds);
}
__device__ __forceinline__ void phase_swiglu(const Params& p, float* lds) {
    int* Li = (int*)(lds + 16384);
    expert_offsets(p, 0, Li);
    const size_t n = (size_t)Li[64] * 256;
    const bf16_t* GU = (const bf16_t*)(p.ws + WS_C); bf16_t* HID = (bf16_t*)(p.ws + WS_R1 + R1_HID);
    for (size_t i = (size_t)bid_() * NTHREADS + tid_(); i < n; i += (size_t)nblk_() * NTHREADS) {
        const size_t s = i >> 8; const int f = (int)(i & 255), j = f >> 7, rr = f & 127;
        const float g = bf2f(GU[s * 512 + j * 256 + rr]), u = bf2f(GU[s * 512 + j * 256 + 128 + rr]);
        HID[i] = (bf16_t)f2bf(g * sigmoidf_(g) * u);
    }
    __syncthreads();
}
__device__ __forceinline__ void phase_moedown(const Params& p, float* lds) {
    int* Li = (int*)(lds + 16384);
    expert_offsets(p, 0, Li);
    const bf16_t* HID = (const bf16_t*)(p.ws + WS_R1 + R1_HID); const bf16_t* Bt = (const bf16_t*)(p.ws + WS_W + W_D); bf16_t* YSL = (bf16_t*)(p.ws + WS_R1 + R1_YSL);
    const float* slot_w = (const float*)(p.ws + WS_ROUTE + RT_SLOTW);
    ngemm(Li[64], 1024, 256, 256, 256, [=](int m0, int) { return HID + (size_t)m0 * 256; }, [=](int m0, int n0) { return Bt + ((size_t)tile_expert(Li, m0) * 1024 + n0) * 256; },
          [=](int m, int n, float v) { YSL[(size_t)m * 1024 + n] = (bf16_t)f2bf(v * slot_w[m]); }, lds);
}
__device__ __forceinline__ void phase_ln2(const Params& p, int l) {
    const int tid = tid_(), lane = tid & 63, wave = tid >> 6;
    const int gw = bid_() * NWAVES + wave, NGW = nblk_() * NWAVES;
    const int* tok_s = (const int*)(p.ws + WS_ROUTE + RT_TOKS); const bf16_t* YSL = (const bf16_t*)(p.ws + WS_R1 + R1_YSL);
    for (int m = gw; m < T; m += NGW) {
        f32x4* orow = (f32x4*)(p.out + (size_t)m * D) + lane; f32x4 v[4];
        const u32x2* y0 = (const u32x2*)(YSL + (size_t)tok_s[m * 2] * D) + lane; const u32x2* y1 = (const u32x2*)(YSL + (size_t)tok_s[m * 2 + 1] * D) + lane;
#pragma unroll
        for (int j = 0; j < 4; ++j) {
            const u32x2 a = y0[64 * j], b = y1[64 * j]; const f32x4 hv = orow[64 * j];
            v[j].x = ALPHA * hv.x + (bf2f(a.x & 0xffffu) + bf2f(b.x & 0xffffu)); v[j].y = ALPHA * hv.y + (bf2f(a.x >> 16) + bf2f(b.x >> 16));
            v[j].z = ALPHA * hv.z + (bf2f(a.y & 0xffffu) + bf2f(b.y & 0xffffu)); v[j].w = ALPHA * hv.w + (bf2f(a.y >> 16) + bf2f(b.y >> 16));
        }
        ln_row(v, p.ln2_g + l * D, p.ln2_b + l * D, lane);
#pragma unroll
        for (int j = 0; j < 4; ++j) orow[64 * j] = v[j];
        if (l == 0) emit_xrow(p, v, m, 1, lane);
    }
}

enum { PH_CONVW = 0, PH_INPROJ, PH_UPPROJ, PH_PREP, PH_ATTN, PH_PGEMM, PH_GATE, PH_COMBINE, PH_WO, PH_LN1, PH_GATHER, PH_MOEUP, PH_SWIGLU, PH_MOEDOWN, PH_LN2, PH_N };
__device__ __forceinline__ void run_phase(const Params& p, int ph, int l, float* lds) {
    switch (ph) {
        case PH_CONVW: phase_convw(p, l, lds); if (l == 0) phase_convx(p); break;
        case PH_INPROJ: phase_inproj(p, lds); break;
        case PH_UPPROJ: phase_upproj(p, l, lds); break;
        case PH_PREP: phase_prep(p, l, lds); break;
        case PH_ATTN: phase_attn(p, lds); break;
        case PH_PGEMM: phase_pgemm(p, lds); break;
        case PH_GATE: phase_gate(p, l, lds); break;
        case PH_COMBINE: phase_combine(p); break;
        case PH_WO: phase_wo(p, l, lds); break;
        case PH_LN1: phase_ln1route(p, l, lds); break;
        case PH_GATHER: phase_gather(p, lds); break;
        case PH_MOEUP: phase_moeup(p, lds); break;
        case PH_SWIGLU: phase_swiglu(p, lds); break;
        case PH_MOEDOWN: phase_moedown(p, lds); break;
        case PH_LN2: phase_ln2(p, l); break;
    }
}
__global__ void __launch_bounds__(NTHREADS, 2) mega(Params p) {
    extern __shared__ __attribute__((aligned(16))) unsigned char lds_raw[];
    cg::grid_group grid = cg::this_grid();
#pragma unroll 1
    for (int l = 0; l < 2; ++l) {
#pragma unroll 1
        for (int ph = 0; ph < PH_N; ++ph) {
            run_phase(p, ph, l, (float*)lds_raw);
            if (!(l == 1 && ph == PH_N - 1)) grid.sync();
        }
    }
}

extern "C" void kernel_launch(void* const* d_in, const int* in_sizes, int n_in, void* d_out, int out_size, void* d_ws, size_t ws_size, hipStream_t stream) {
    static int grid = 0;
    if (grid == 0) {
        if (n_in != 26 || out_size != T * D || ws_size < WS_END) { fprintf(stderr, "kernel_launch: unexpected shapes (n_in %d out %d ws %zu, need %zu)\n", n_in, out_size, ws_size, (size_t)WS_END); grid = -1; return; }
        int dev = 0, cus = 0, per_cu = 0;
        (void)hipGetDevice(&dev); (void)hipDeviceGetAttribute(&cus, hipDeviceAttributeMultiprocessorCount, dev);
        (void)hipFuncSetAttribute((const void*)mega, hipFuncAttributeMaxDynamicSharedMemorySize, LDS_BYTES);
        if (hipOccupancyMaxActiveBlocksPerMultiprocessor(&per_cu, (const void*)mega, NTHREADS, LDS_BYTES) != hipSuccess || per_cu < 1) { fprintf(stderr, "kernel_launch: occupancy query says %d\n", per_cu); grid = -1; return; }
        grid = cus;
    }
    if (grid < 0) return;
    Params p{};
    const float** pf = (const float**)&p;
    p.x = (const float*)d_in[0]; p.pos = (const int*)d_in[1];
    for (int i = 2; i < 26; ++i) pf[i] = (const float*)d_in[i];
    p.out = (float*)d_out; p.ws = (unsigned char*)d_ws;
    void* args[] = {&p};
    hipError_t e = hipLaunchCooperativeKernel((const void*)mega, dim3(grid), dim3(NTHREADS), args, LDS_BYTES, stream);
    if (e != hipSuccess) fprintf(stderr, "cooperative launch failed: %s (grid %d)\n", hipGetErrorString(e), grid);
}
```

```cpp
#include <hip/hip_runtime.h>
#include <hip/hip_cooperative_groups.h>
#include <cstdio>
#include <cstdint>
namespace cg = cooperative_groups;

typedef unsigned short bf16_t;
typedef float f32x4 __attribute__((ext_vector_type(4)));
typedef unsigned u32x4 __attribute__((ext_vector_type(4)));
typedef unsigned u32x2 __attribute__((ext_vector_type(2)));

constexpr int NB = 4, SEQ = 4096, T = NB * SEQ, D = 1024, NIN = 6564, ZSW = 2560;
constexpr int NEXP = 32, EFF = 256, MAXSLOT = 40960;
constexpr int C_CQ = 0, C_CKV = 256, C_KR = 384, C_SBQ = 416, C_SBK = 672, C_SBV = 928, C_CVA = 1184, C_CVG = 1440,
              C_FXQ = 1696, C_FXK = 1952, C_FXV = 2208, C_FXF = 2464, C_GATE = 2468;
constexpr float LOG2E = 1.4426950408889634f;
constexpr float C2_64 = 0.125f * LOG2E;
constexpr float C2_M = 0.10206207261596575f * LOG2E;
constexpr float ALPHA = 1.4142135623730951f;
constexpr float EPS = 1e-5f;
constexpr int NTHREADS = 512, NWAVES = 8;
constexpr unsigned F_INPROJ = 1, F_UPPROJ = 2, F_PGEMM = 4, F_GATE = 8, F_WO = 16, F_MOEUP = 32, F_MOEDOWN = 64;
#ifndef FAST_MASK
#define FAST_MASK 127
#endif
constexpr unsigned FAST = FAST_MASK;
constexpr int LDS_BYTES = 147456;

constexpr size_t MiB = 1u << 20;
constexpr size_t WS_CTL = 0;
constexpr size_t WS_ROUTE = 1 * MiB;
constexpr size_t RT_TOKE = 0, RT_TOKW = 131072, RT_TOKP = 262144, RT_TOKS = 393216, RT_SLOTW = 524288, RT_FXF = 786432, RT_CF = 1048576;
constexpr size_t WS_W = 3 * MiB;
constexpr size_t W_BT1 = 0, W_GATE = 5 * MiB, W_UQ = 13 * MiB, W_UKV = W_UQ + 262144, W_BR = W_UKV + 262144, W_O = W_BR + 2 * MiB, W_GU = W_O + 2 * MiB, W_D = W_GU + 32 * MiB;
static_assert(W_D + 16 * MiB <= 66 * MiB, "weights");
constexpr size_t WS_XB = 69 * MiB;
constexpr size_t WS_R1 = 101 * MiB;
constexpr size_t R1_ZS = 0, R1_QKVR = 80 * MiB, R1_PB = 0, R1_XG = 0, R1_HID = 80 * MiB, R1_YSL = 0;
constexpr size_t WS_C = 229 * MiB;
constexpr size_t C_QM = 0, C_KM = 12 * MiB, C_VM = 24 * MiB;
constexpr size_t WS_D = 261 * MiB;
constexpr size_t WS_END = 293 * MiB;

struct Params {
    const float* x; const int* pos; const float* w_in; const float* b_gate; const float* b_forget;
    const float* q_norm; const float* kv_norm; const float* w_uq; const float* w_ukv;
    const float* conv_w; const float* conv_b; const float* conv_g; const float* conv_bb;
    const float* w_branch; const float* w_o; const float* ln1_g; const float* ln1_b;
    const float* w_rg; const float* b_rg; const float* w_re; const float* b_re;
    const float* w_eg; const float* w_eu; const float* w_ed; const float* ln2_g; const float* ln2_b;
    float* out; unsigned char* ws; int phase; int layer;
};
typedef const __attribute__((address_space(4))) Params CParams;

__device__ __forceinline__ unsigned f2bf(float f) { unsigned u = __float_as_uint(f); return (u + 0x7fffu + ((u >> 16) & 1u)) >> 16; }
__device__ __forceinline__ float bf2f(unsigned b) { return __uint_as_float(b << 16); }
__device__ __forceinline__ unsigned pk2(float lo, float hi) { return f2bf(lo) | (f2bf(hi) << 16); }
__device__ __forceinline__ float wave_sum(float v) {
#pragma unroll
    for (int o = 1; o < 64; o <<= 1) v += __shfl_xor(v, o);
    return v;
}
__device__ __forceinline__ float wave_max(float v) {
#pragma unroll
    for (int o = 1; o < 64; o <<= 1) v = fmaxf(v, __shfl_xor(v, o));
    return v;
}
__device__ __forceinline__ float sigmoidf_(float x) { return 1.f / (1.f + __expf(-x)); }
#define LDS_FENCE() asm volatile("s_waitcnt lgkmcnt(0)" ::: "memory")
__device__ __forceinline__ int tid_() { int t = threadIdx.x; asm volatile("" : "+v"(t)); return t; }
__device__ __forceinline__ int bid_() { int t = blockIdx.x; asm volatile("" : "+s"(t)); return t; }
__device__ __forceinline__ int nblk_() { int t = gridDim.x; asm volatile("" : "+s"(t)); return t; }

template <class F>
__device__ __forceinline__ void tr_item(const float* W, int ldw, bf16_t* out, int Kd, int r0, int k0, const float* ks, F f, float* scr, int lane) {
    const int rl = lane & 31, r = r0 + rl, c = f.col(r); const float s = f.rs(r);
#pragma unroll 8
    for (int i = 0; i < 32; ++i) {
        const int kk = 2 * i + (lane >> 5); float v = 0.f;
        if (c >= 0) { v = W[(size_t)(k0 + kk) * ldw + c] * s; if (ks) v *= ks[k0 + kk]; }
        scr[kk * 33 + rl] = v;
    }
    LDS_FENCE();
    const int cc = lane & 7;
#pragma unroll
    for (int j = 0; j < 4; ++j) {
        const int n = (lane >> 3) + 8 * j; const float* s8 = scr + (8 * cc) * 33 + n;
        u32x4 o; o.x = pk2(s8[0], s8[33]); o.y = pk2(s8[66], s8[99]); o.z = pk2(s8[132], s8[165]); o.w = pk2(s8[198], s8[231]);
        *(u32x4*)(out + (size_t)(r0 + n) * Kd + k0 + 8 * cc) = o;
    }
    LDS_FENCE();
}
struct MapBt1 { __device__ int col(int r) const { return r < C_GATE ? r : -1; } __device__ float rs(int r) const { return ((r >= C_SBQ && r < C_SBK) || (r >= C_FXQ && r < C_FXK)) ? C2_64 : 1.f; } };
struct MapGate { __device__ int col(int r) const { return C_GATE + r; } __device__ float rs(int) const { return 1.f; } };
struct MapGateP { __device__ int col(int r) const { const int pn = r >> 8, cl = r & 255; return C_GATE + (2 * (cl >> 7) + ((cl >> 4) & 1)) * 1024 + pn * 64 + 16 * ((cl >> 5) & 3) + (cl & 15); } __device__ float rs(int) const { return 1.f; } };
struct MapLim { int lim; __device__ int col(int r) const { return r < lim ? r : -1; } __device__ float rs(int) const { return 1.f; } };
struct MapGU { __device__ int col(int r) const { return ((r >> 8) << 7) + (r & 127); } __device__ float rs(int) const { return 1.f; } };

__device__ __forceinline__ void phase_convw(CParams& p, int l, float* lds) {
    const int tid = tid_(), lane = tid & 63, wave = tid >> 6;
    float* scr = lds + wave * (64 * 33);
    unsigned char* W = p.ws + WS_W;
    const int gw = bid_() * NWAVES + wave, NGW = nblk_() * NWAVES;
    constexpr int I_A = 80 * 16, I_B = 128 * 16, I_C = 16 * 4, I_Dd = 16 * 4, I_E = 4 * 128, I_F = 32 * 16, I_G = 32 * 256, I_H = 32 * 128;
    constexpr int NIT = I_A + I_B + I_C + I_Dd + I_E + I_F + I_G + I_H;
    for (int it = gw; it < NIT; it += NGW) {
        int r = it;
        if (r < I_A) { tr_item(p.w_in + (size_t)l * D * NIN, NIN, (bf16_t*)(W + W_BT1), 1024, (r >> 4) * 32, (r & 15) * 64, nullptr, MapBt1{}, scr, lane); continue; } r -= I_A;
        if (r < I_B) { if constexpr ((FAST & F_GATE) != 0) tr_item(p.w_in + (size_t)l * D * NIN, NIN, (bf16_t*)(W + W_GATE), 1024, (r >> 4) * 32, (r & 15) * 64, nullptr, MapGateP{}, scr, lane); else tr_item(p.w_in + (size_t)l * D * NIN, NIN, (bf16_t*)(W + W_GATE), 1024, (r >> 4) * 32, (r & 15) * 64, nullptr, MapGate{}, scr, lane); continue; } r -= I_B;
        if (r < I_C) { tr_item(p.w_uq + (size_t)l * 256 * 384, 384, (bf16_t*)(W + W_UQ), 256, (r >> 2) * 32, (r & 3) * 64, p.q_norm + l * 256, MapLim{384}, scr, lane); continue; } r -= I_C;
        if (r < I_Dd) { const int kb = r & 3; if (kb < 2) tr_item(p.w_ukv + (size_t)l * 128 * 512, 512, (bf16_t*)(W + W_UKV), 256, (r >> 2) * 32, kb * 64, p.kv_norm + l * 128, MapLim{512}, scr, lane);
            else tr_item(p.w_ukv, 512, (bf16_t*)(W + W_UKV), 256, (r >> 2) * 32, kb * 64, nullptr, MapLim{0}, scr, lane); continue; } r -= I_Dd;
        if (r < I_E) { const int n = r >> 7, q = r & 127; tr_item(p.w_branch + ((size_t)l * 4 + n) * 256 * 1024, 1024, (bf16_t*)(W + W_BR) + (size_t)n * 1024 * 256, 256, (q >> 2) * 32, (q & 3) * 64, nullptr, MapLim{1024}, scr, lane); continue; } r -= I_E;
        if (r < I_F) { tr_item(p.w_o + (size_t)l * 1024 * 1024, 1024, (bf16_t*)(W + W_O), 1024, (r >> 4) * 32, (r & 15) * 64, nullptr, MapLim{1024}, scr, lane); continue; } r -= I_F;
        if (r < I_G) { const int e = r >> 8, q = r & 255, rb = q >> 4, kb = q & 15; const int r0 = rb * 32; const bool up = (r0 >> 7) & 1;
            const float* src = (up ? p.w_eu : p.w_eg) + ((size_t)l * NEXP + e) * 1024 * 256;
            tr_item(src, 256, (bf16_t*)(W + W_GU) + (size_t)e * 512 * 1024, 1024, r0, kb * 64, nullptr, MapGU{}, scr, lane); continue; } r -= I_G;
        { const int e = r >> 7, q = r & 127; tr_item(p.w_ed + ((size_t)l * NEXP + e) * 256 * 1024, 1024, (bf16_t*)(W + W_D) + (size_t)e * 1024 * 256, 256, (q >> 2) * 32, (q & 3) * 64, nullptr, MapLim{1024}, scr, lane); }
    }
}

__device__ __forceinline__ void emit_xrow(CParams& p, const f32x4 (&v)[4], int m, int l, int lane) {
    u32x2* o8 = (u32x2*)((bf16_t*)(p.ws + WS_XB) + (size_t)m * D) + lane;
    f32x4 acc = {0.f, 0.f, 0.f, 0.f};
    const float* wf = p.w_in + (size_t)l * D * NIN + C_FXF;
#pragma unroll
    for (int j = 0; j < 4; ++j) {
        u32x2 w; w.x = pk2(v[j].x, v[j].y); w.y = pk2(v[j].z, v[j].w); o8[64 * j] = w;
        const int k = 256 * j + 4 * lane;
        acc += v[j].x * *(const f32x4*)(wf + (size_t)(k + 0) * NIN);
        acc += v[j].y * *(const f32x4*)(wf + (size_t)(k + 1) * NIN);
        acc += v[j].z * *(const f32x4*)(wf + (size_t)(k + 2) * NIN);
        acc += v[j].w * *(const f32x4*)(wf + (size_t)(k + 3) * NIN);
    }
    acc.x = wave_sum(acc.x); acc.y = wave_sum(acc.y); acc.z = wave_sum(acc.z); acc.w = wave_sum(acc.w);
    if (lane == 0) *(f32x4*)((float*)(p.ws + WS_ROUTE + RT_FXF) + (size_t)m * 4) = acc;
}
__device__ __forceinline__ void phase_convx(CParams& p) {
    const int tid = tid_(), lane = tid & 63, wave = tid >> 6;
    const int gw = bid_() * NWAVES + wave, NGW = nblk_() * NWAVES;
    for (int m = gw; m < T; m += NGW) {
        const f32x4* xr = (const f32x4*)(p.x + (size_t)m * D) + lane; f32x4 v[4];
#pragma unroll
        for (int j = 0; j < 4; ++j) v[j] = xr[64 * j];
        emit_xrow(p, v, m, 0, lane);
    }
}

namespace pg8 {
#define PG8_LAS __attribute__((address_space(3)))
typedef unsigned short bf16_t;
typedef short bf16x8 __attribute__((ext_vector_type(8)));
typedef float f32x4 __attribute__((ext_vector_type(4)));
typedef unsigned u32x4 __attribute__((ext_vector_type(4)));
constexpr int BM = 256, BK = 64, HALF = 128, HTB = HALF * BK * 2  , STAGE_BYTES = 8 * HTB, NXCD = 8, WGM = 8;

__host__ __device__ __forceinline__ int lds_byte(int r, int c) { const int st = (r >> 4) * 2 + (c >> 5), rr = r & 15, cc = c & 31, ob = rr * 64 + cc * 2; return st * 1024 + (ob ^ (((ob >> 9) & 1) << 5)); }
__host__ __device__ __forceinline__ void stage_rc(int b, int& R, int& C) { const int st = b / 1024, sb = b % 1024, swz = sb ^ (((sb >> 9) & 1) << 5); R = (st >> 1) * 16 + swz / 64; C = (st & 1) * 32 + (swz % 64) / 2; }
__host__ __device__ __forceinline__ int perm32(int rho) { const int n = rho >> 4, i = rho & 15; return 8 * (i >> 2) + 4 * n + (i & 3); }

struct Unit { int pm, pn; long aoff, boff; };
struct Gemm { const bf16_t* A; const bf16_t* Bt; int M, N, K, lda; };

struct StaticOrder {
    int nM, nN, nwg, G, c;
    __host__ __device__ void init(int M, int N, int G_, int c_) { nM = M / BM; nN = N / BM; nwg = nM * nN; G = G_; c = c_; }
    __host__ __device__ bool next(int i, Unit& u) const {
        const long L = (long)i * G + c; if (L >= nwg) return false;
        int wgid = (int)L; { const int q = nwg / NXCD, r = nwg % NXCD, xcd = wgid % NXCD, off = wgid / NXCD; wgid = (xcd < r ? xcd * (q + 1) : r * (q + 1) + (xcd - r) * q) + off; }
        const int nig = WGM * nN, gid = wgid / nig, fm = gid * WGM, gsz = (nM - fm) < WGM ? (nM - fm) : WGM;
        u.pm = fm + ((wgid % nig) % gsz); u.pn = (wgid % nig) / gsz; u.aoff = 0; u.boff = 0; return true;
    }
    __device__ __forceinline__ void a_ready(const Unit&) const {}
    __device__ __forceinline__ void done(const Unit&) const {}
};


__device__ __forceinline__ unsigned cvt_pk_bf16(float lo, float hi) { unsigned r; asm volatile("v_cvt_pk_bf16_f32 %0, %1, %2" : "=v"(r) : "v"(lo), "v"(hi)); return r; }
__device__ __forceinline__ float sig_(float x) { return __builtin_amdgcn_rcpf(1.f + __builtin_amdgcn_exp2f(-1.4426950408889634f * x)); }
struct EpiBf16 {
    static constexpr bool PERM = true, AFTER_DRAIN = false;
    bf16_t* O; int ldc;
    __device__ __forceinline__ void operator()(const f32x4 (&acc)[2][2][4][2], const Unit& u, int wr, int wc, int fr, int fq) const {
        const int row0 = u.pm * BM + wr * 64 + fr, col0 = u.pn * BM + wc * 32 + 8 * fq;
#pragma unroll
        for (int ai = 0; ai < 2; ++ai)
#pragma unroll
            for (int m = 0; m < 4; ++m) { const int row = row0 + ai * HALF + m * 16; bf16_t* rowp = O + (size_t)row * ldc + col0;
#pragma unroll
                for (int bj = 0; bj < 2; ++bj) { const f32x4 v0 = acc[ai][bj][m][0], v1 = acc[ai][bj][m][1];
                    u32x4 w; w.x = cvt_pk_bf16(v0[0], v0[1]); w.y = cvt_pk_bf16(v0[2], v0[3]); w.z = cvt_pk_bf16(v1[0], v1[1]); w.w = cvt_pk_bf16(v1[2], v1[3]);
                    *(u32x4*)(rowp + bj * HALF) = w; } }
    }
};
struct EpiGate {
    static constexpr bool PERM = false, AFTER_DRAIN = false;
    const bf16_t* PB; bf16_t* MG; const float* bg;
    __device__ __forceinline__ void operator()(const f32x4 (&acc)[2][2][4][2], const Unit& u, int wr, int wc, int fr, int fq) const {
        typedef unsigned u32x2_t __attribute__((ext_vector_type(2)));
        const int row0 = u.pm * BM + wr * 64 + fr, d0 = u.pn * 64 + wc * 16 + fq * 4;
        f32x4 bv[2][2];
#pragma unroll
        for (int bj = 0; bj < 2; ++bj)
#pragma unroll
            for (int n = 0; n < 2; ++n) bv[bj][n] = *(const f32x4*)(bg + (2 * bj + n) * 1024 + d0);
#pragma unroll
        for (int ai = 0; ai < 2; ++ai)
#pragma unroll
            for (int m = 0; m < 4; ++m) { const int row = row0 + ai * HALF + m * 16; const bf16_t* pr = PB + (size_t)row * 4096 + d0; f32x4 s = {0.f, 0.f, 0.f, 0.f};
#pragma unroll
                for (int bj = 0; bj < 2; ++bj)
#pragma unroll
                    for (int n = 0; n < 2; ++n) { const u32x2_t pv = *(const u32x2_t*)(pr + (2 * bj + n) * 1024); const f32x4 a = acc[ai][bj][m][n] + bv[bj][n];
                        s[0] += sig_(a[0]) * __uint_as_float(pv.x << 16); s[1] += sig_(a[1]) * __uint_as_float(pv.x & 0xffff0000u);
                        s[2] += sig_(a[2]) * __uint_as_float(pv.y << 16); s[3] += sig_(a[3]) * __uint_as_float(pv.y & 0xffff0000u); }
                u32x2_t w; w.x = cvt_pk_bf16(s[0], s[1]); w.y = cvt_pk_bf16(s[2], s[3]); *(u32x2_t*)(MG + (size_t)row * 1024 + d0) = w; }
    }
};
struct EpiRes {
    static constexpr bool PERM = false, AFTER_DRAIN = false;
    const float* base; float* out; float alpha;
    __device__ __forceinline__ void operator()(const f32x4 (&acc)[2][2][4][2], const Unit& u, int wr, int wc, int fr, int fq) const {
        const int row0 = u.pm * BM + wr * 64 + fr, col0 = u.pn * BM + wc * 32 + 4 * fq;
#pragma unroll
        for (int ai = 0; ai < 2; ++ai)
#pragma unroll
            for (int m = 0; m < 4; ++m) { const size_t off = (size_t)(row0 + ai * HALF + m * 16) * 1024 + col0;
#pragma unroll
                for (int bj = 0; bj < 2; ++bj)
#pragma unroll
                    for (int n = 0; n < 2; ++n) { const f32x4 b = *(const f32x4*)(base + off + bj * HALF + n * 16); *(f32x4*)(out + off + bj * HALF + n * 16) = b * alpha + acc[ai][bj][m][n]; } }
    }
};
struct EpiSwiglu {
    static constexpr bool PERM = true, AFTER_DRAIN = false;
    bf16_t* HID;
    __device__ __forceinline__ void operator()(const f32x4 (&acc)[2][2][4][2], const Unit& u, int wr, int wc, int fr, int fq) const {
        const int row0 = u.pm * BM + wr * 64 + fr, col0 = u.pn * HALF + wc * 32 + 8 * fq;
#pragma unroll
        for (int ai = 0; ai < 2; ++ai)
#pragma unroll
            for (int m = 0; m < 4; ++m) { const int row = row0 + ai * HALF + m * 16; float h[8];
#pragma unroll
                for (int n = 0; n < 2; ++n)
#pragma unroll
                    for (int i = 0; i < 4; ++i) { const float g = acc[ai][0][m][n][i], uu = acc[ai][1][m][n][i]; h[n * 4 + i] = g * sig_(g) * uu; }
                u32x4 w; w.x = cvt_pk_bf16(h[0], h[1]); w.y = cvt_pk_bf16(h[2], h[3]); w.z = cvt_pk_bf16(h[4], h[5]); w.w = cvt_pk_bf16(h[6], h[7]);
                *(u32x4*)(HID + (size_t)row * 256 + col0) = w; }
    }
};
struct BranchOrder {
    StaticOrder s; int shift;
    __device__ bool next(int i, Unit& u) const { if (!s.next(i, u)) return false; u.aoff = (long)(u.pn >> shift) * 512; return true; }
    __device__ __forceinline__ void a_ready(const Unit&) const {}
    __device__ __forceinline__ void done(const Unit&) const {}
};
struct MoeOrder {
    const int* Li; int nN, G, c; long bstride;
    __device__ bool next(int i, Unit& u) const {
        const int L = i * G + c, ntile = Li[64] >> 8; if (L >= ntile * nN) return false;
        u.pm = L / nN; u.pn = L % nN; const int m0 = u.pm << 8; int e = 0;
        for (int k = 0; k < 32; ++k) if (m0 >= Li[32 + k] && m0 < Li[33 + k]) e = k;
        u.aoff = 0; u.boff = (long)e * bstride; return true;
    }
    __device__ __forceinline__ void a_ready(const Unit&) const {}
    __device__ __forceinline__ void done(const Unit&) const {}
};
template <class Epi, class Sched, int KK, int LDA, bool ALIGN_EPI = false, bool SP2 = false>
__device__ __forceinline__ void gemm_phase(PG8_LAS unsigned char* lds, const Gemm g, const Sched& S, const Epi& E) {
    const int tid = tid_(), wid = __builtin_amdgcn_readfirstlane(tid >> 6), lane = tid & 63, wr = wid >> 2, wc = wid & 3, fr = lane & 15, fq = lane >> 4;
    constexpr int K = KK, nt = K / BK;
    unsigned voffA[2], voffB[2];
#pragma unroll
    for (int i = 0; i < 2; ++i) { int R, C; stage_rc(tid * 16 + i * 8192, R, C); const int Rb = Epi::PERM ? ((R & ~31) + perm32(R & 31)) : R;
        voffA[i] = (unsigned)(R * LDA + C) * 2u; voffB[i] = (unsigned)(Rb * K + C) * 2u; }
    constexpr size_t kstep = (size_t)(BK * 2);
    constexpr size_t hstepA = (size_t)HALF * LDA * 2, hstepB = (size_t)HALF * K * 2;
    constexpr size_t tstepA = 2 * hstepA, tstepB = 2 * hstepB;
    const unsigned ldsw = (unsigned)wid * 1024u;
    const int aoff = lds_byte(wr * 64 + fr, fq * 8), boff = lds_byte(wc * 32 + fr, fq * 8);
#define PG8_SA(b, h) (((b) * 2 + (h)) * HTB)
#define PG8_SB(b, h) ((4 + (b) * 2 + (h)) * HTB)
#define PG8_STAGE(bufoff, gbase, voff) do { _Pragma("unroll") for (int _i = 0; _i < 2; ++_i) \
        __builtin_amdgcn_global_load_lds((const unsigned*)((const char*)(gbase) + (voff)[_i]), (PG8_LAS unsigned*)(lds + (bufoff) + ldsw + _i * 8192), 16, 0, 0); } while (0)
#define PG8_LDA(dst, b, h) do { _Pragma("unroll") for (int m = 0; m < 4; ++m) _Pragma("unroll") for (int k = 0; k < 2; ++k) dst[m][k] = *(const PG8_LAS bf16x8*)(lds + PG8_SA(b, h) + aoff + m * 2048 + k * 1024); } while (0)
#define PG8_LDB(dst, b, h) do { _Pragma("unroll") for (int n = 0; n < 2; ++n) _Pragma("unroll") for (int k = 0; k < 2; ++k) dst[n][k] = *(const PG8_LAS bf16x8*)(lds + PG8_SB(b, h) + boff + n * 2048 + k * 1024); } while (0)
#define PG8_MMA(ai, bj, At, Bt) do { __builtin_amdgcn_s_setprio(1); _Pragma("unroll") for (int m = 0; m < 4; ++m) _Pragma("unroll") for (int n = 0; n < 2; ++n) _Pragma("unroll") for (int k = 0; k < 2; ++k) \
        acc[ai][bj][m][n] = __builtin_amdgcn_mfma_f32_16x16x32_bf16(Bt[n][k], At[m][k], acc[ai][bj][m][n], 0, 0, 0); __builtin_amdgcn_s_setprio(0); } while (0)
#define PG8_WAIT_V(n) asm volatile("s_waitcnt vmcnt(" #n ")" ::: "memory")
#define PG8_WAIT_L(n) asm volatile("s_waitcnt lgkmcnt(" #n ")" ::: "memory")
#define PG8_BAR __builtin_amdgcn_s_barrier()
#define PG8_SCHED __builtin_amdgcn_sched_barrier(0)
    Unit cur, nxt; int ui = 0;
    if (!S.next(0, cur)) return;
    f32x4 acc[2][2][4][2];
#pragma unroll
    for (int a = 0; a < 2; ++a)
#pragma unroll
        for (int b = 0; b < 2; ++b)
#pragma unroll
            for (int m = 0; m < 4; ++m)
#pragma unroll
                for (int n = 0; n < 2; ++n) acc[a][b][m][n] = (f32x4){0.f, 0.f, 0.f, 0.f};
    bf16x8 At[4][2], B0[2][2], B1[2][2];
    const char* cA = (const char*)g.A + (size_t)cur.pm * tstepA + cur.aoff; const char* cB = (const char*)g.Bt + (size_t)cur.pn * tstepB + cur.boff;
    S.a_ready(cur);
    if constexpr (SP2) {
        PG8_STAGE(PG8_SB(0, 0), cB, voffB); PG8_STAGE(PG8_SB(0, 1), cB + hstepB, voffB); PG8_STAGE(PG8_SA(0, 0), cA, voffA); PG8_STAGE(PG8_SA(0, 1), cA + hstepA, voffA);
        if (wr == 1) PG8_BAR;
        PG8_WAIT_V(2); PG8_BAR;
        PG8_STAGE(PG8_SB(1, 0), cB + kstep, voffB); PG8_STAGE(PG8_SA(1, 0), cA + kstep, voffA); PG8_STAGE(PG8_SB(1, 1), cB + hstepB + kstep, voffB);
        PG8_WAIT_V(6); PG8_BAR;
    } else {
        PG8_STAGE(PG8_SB(0, 0), cB, voffB); PG8_STAGE(PG8_SA(0, 0), cA, voffA); PG8_STAGE(PG8_SB(0, 1), cB + hstepB, voffB); PG8_STAGE(PG8_SA(0, 1), cA + hstepA, voffA);
        if (wr == 1) PG8_BAR;
        PG8_WAIT_V(4); PG8_BAR;
        PG8_STAGE(PG8_SB(1, 0), cB + kstep, voffB); PG8_STAGE(PG8_SA(1, 0), cA + kstep, voffA); PG8_STAGE(PG8_SB(1, 1), cB + hstepB + kstep, voffB);
        PG8_WAIT_V(6); PG8_BAR;
    }
    for (;;) {
        const bool has_next = S.next(ui + 1, nxt);
        const char* nA = has_next ? (const char*)g.A + (size_t)nxt.pm * tstepA + nxt.aoff : cA; const char* nB = has_next ? (const char*)g.Bt + (size_t)nxt.pn * tstepB + nxt.boff : cB;
#pragma unroll 1
        for (int t = 0; t < nt; t += 2) {
            const bool last = (t == nt - 2);
            const char* a1 = cA + (size_t)(t + 1) * kstep;
            const char* a2 = last ? nA : cA + (size_t)(t + 2) * kstep; const char* b2 = last ? nB : cB + (size_t)(t + 2) * kstep;
            const char* a3 = a2 + kstep; const char* b3 = b2 + kstep;
            if (last && has_next) S.a_ready(nxt);
            if constexpr (SP2) {
            PG8_LDB(B0, 0, 0); PG8_LDB(B1, 0, 1); PG8_SCHED; PG8_LDA(At, 0, 0); PG8_STAGE(PG8_SA(1, 1), a1 + hstepA, voffA);
            PG8_WAIT_V(8); PG8_WAIT_L(0); PG8_BAR; PG8_MMA(0, 0, At, B0); PG8_MMA(0, 1, At, B1); PG8_BAR; PG8_SCHED;
            PG8_LDA(At, 0, 1); PG8_STAGE(PG8_SB(0, 0), b2, voffB); PG8_STAGE(PG8_SB(0, 1), b2 + hstepB, voffB); PG8_STAGE(PG8_SA(0, 0), a2, voffA);
            PG8_WAIT_V(8); PG8_WAIT_L(0); PG8_BAR; PG8_MMA(1, 0, At, B0); PG8_MMA(1, 1, At, B1); PG8_BAR; PG8_SCHED;
            PG8_LDB(B0, 1, 0); PG8_LDB(B1, 1, 1); PG8_SCHED; PG8_LDA(At, 1, 0); PG8_STAGE(PG8_SA(0, 1), a2 + hstepA, voffA);
            PG8_WAIT_V(8); PG8_WAIT_L(0); PG8_BAR; PG8_MMA(0, 0, At, B0); PG8_MMA(0, 1, At, B1); PG8_BAR; PG8_SCHED;
            PG8_LDA(At, 1, 1); PG8_STAGE(PG8_SB(1, 0), b3, voffB); PG8_STAGE(PG8_SB(1, 1), b3 + hstepB, voffB); PG8_STAGE(PG8_SA(1, 0), a3, voffA);
            PG8_WAIT_V(8); PG8_WAIT_L(0); PG8_BAR; PG8_MMA(1, 0, At, B0); PG8_MMA(1, 1, At, B1); PG8_BAR; PG8_SCHED;
            } else {
            PG8_LDB(B0, 0, 0); PG8_SCHED; PG8_LDA(At, 0, 0); PG8_STAGE(PG8_SA(1, 1), a1 + hstepA, voffA);
            PG8_WAIT_L(8); PG8_BAR; PG8_WAIT_L(0); PG8_MMA(0, 0, At, B0); PG8_BAR; PG8_SCHED;
            PG8_LDB(B1, 0, 1); PG8_STAGE(PG8_SB(0, 0), b2, voffB);
            PG8_BAR; PG8_WAIT_L(0); PG8_MMA(0, 1, At, B1); PG8_BAR;
            PG8_LDA(At, 0, 1); PG8_STAGE(PG8_SA(0, 0), a2, voffA);
            PG8_BAR; PG8_WAIT_L(0); PG8_MMA(1, 0, At, B0); PG8_BAR; PG8_SCHED;
            PG8_STAGE(PG8_SB(0, 1), b2 + hstepB, voffB);
            PG8_WAIT_V(6); PG8_BAR; PG8_MMA(1, 1, At, B1); PG8_BAR;
            PG8_LDB(B0, 1, 0); PG8_SCHED; PG8_LDA(At, 1, 0); PG8_STAGE(PG8_SA(0, 1), a2 + hstepA, voffA);
            PG8_WAIT_L(8); PG8_BAR; PG8_WAIT_L(0); PG8_MMA(0, 0, At, B0); PG8_BAR; PG8_SCHED;
            PG8_LDB(B1, 1, 1); PG8_STAGE(PG8_SB(1, 0), b3, voffB);
            PG8_BAR; PG8_WAIT_L(0); PG8_MMA(0, 1, At, B1); PG8_BAR;
            PG8_LDA(At, 1, 1); PG8_STAGE(PG8_SA(1, 0), a3, voffA);
            PG8_BAR; PG8_WAIT_L(0); PG8_MMA(1, 0, At, B0); PG8_BAR; PG8_SCHED;
            PG8_STAGE(PG8_SB(1, 1), b3 + hstepB, voffB);
            PG8_WAIT_V(6); PG8_BAR; PG8_MMA(1, 1, At, B1); PG8_BAR;
            }
        }
        if constexpr (ALIGN_EPI) { if (wr == 0) PG8_BAR; }
        if constexpr (!Epi::AFTER_DRAIN) { E(acc, cur, wr, wc, fr, fq); S.done(cur); }
        if (!has_next) break;
#pragma unroll
        for (int a = 0; a < 2; ++a)
#pragma unroll
            for (int b = 0; b < 2; ++b)
#pragma unroll
                for (int m = 0; m < 4; ++m)
#pragma unroll
                    for (int n = 0; n < 2; ++n) acc[a][b][m][n] = (f32x4){0.f, 0.f, 0.f, 0.f};
        cur = nxt; cA = nA; cB = nB; ++ui;
        if constexpr (ALIGN_EPI) { if (wr == 1) PG8_BAR; }
    }
    PG8_WAIT_V(0);
    if constexpr (!ALIGN_EPI) { if (wr == 0) PG8_BAR; }
    PG8_BAR;
    if constexpr (Epi::AFTER_DRAIN) { E.fused(acc, cur, wr, wc, fr, fq, lds, wid, lane); S.done(cur); }
#undef PG8_SA
#undef PG8_SB
#undef PG8_STAGE
#undef PG8_LDA
#undef PG8_LDB
#undef PG8_MMA
#undef PG8_WAIT_V
#undef PG8_WAIT_L
#undef PG8_BAR
#undef PG8_SCHED
}
}

template <class AP, class BP, class Epi>
__device__ __forceinline__ void ngemm(int M, int N, int K, int lda, int ldb, AP ap, BP bp, Epi epi, float* lds) {
    const int tid = tid_(), ty = tid >> 4, tx = tid & 15;
    float* As = lds; float* Bs = lds + 32 * 128;
    const int ntm = M / 128, ntn = N / 128;
    const int lrow = tid >> 2, lkc = (tid & 3) * 8;
    for (int tile = bid_(); tile < ntm * ntn; tile += nblk_()) {
        const int tm = tile / ntn, tn = tile % ntn, m0 = tm * 128, n0 = tn * 128;
        const bf16_t* Ab = ap(m0, n0) + (size_t)lrow * lda + lkc; const bf16_t* Bb = bp(m0, n0) + (size_t)lrow * ldb + lkc;
        float acc[4][8];
#pragma unroll
        for (int i = 0; i < 4; ++i)
#pragma unroll
            for (int j = 0; j < 8; ++j) acc[i][j] = 0.f;
        for (int k0 = 0; k0 < K; k0 += 32) {
            const u32x4 va = *(const u32x4*)(Ab + k0); const u32x4 vb = *(const u32x4*)(Bb + k0);
            __syncthreads();
#pragma unroll
            for (int i = 0; i < 4; ++i) {
                As[(lkc + 2 * i) * 128 + lrow] = bf2f(va[i] & 0xffffu); As[(lkc + 2 * i + 1) * 128 + lrow] = bf2f(va[i] >> 16);
                Bs[(lkc + 2 * i) * 128 + lrow] = bf2f(vb[i] & 0xffffu); Bs[(lkc + 2 * i + 1) * 128 + lrow] = bf2f(vb[i] >> 16);
            }
            __syncthreads();
#pragma unroll 8
            for (int kk = 0; kk < 32; ++kk) {
                const f32x4 a = *(const f32x4*)(As + kk * 128 + ty * 4);
                const f32x4 b0 = *(const f32x4*)(Bs + kk * 128 + tx * 8), b1 = *(const f32x4*)(Bs + kk * 128 + tx * 8 + 4);
#pragma unroll
                for (int i = 0; i < 4; ++i) {
                    acc[i][0] += a[i] * b0.x; acc[i][1] += a[i] * b0.y; acc[i][2] += a[i] * b0.z; acc[i][3] += a[i] * b0.w;
                    acc[i][4] += a[i] * b1.x; acc[i][5] += a[i] * b1.y; acc[i][6] += a[i] * b1.z; acc[i][7] += a[i] * b1.w;
                }
            }
        }
#pragma unroll
        for (int i = 0; i < 4; ++i)
#pragma unroll
            for (int j = 0; j < 8; ++j) epi(m0 + ty * 4 + i, n0 + tx * 8 + j, acc[i][j]);
    }
    __syncthreads();
}

__device__ __forceinline__ void expert_offsets(CParams& p, int tb, int* Li) {
    const int tid = tid_(); const int* hist = (const int*)(p.ws + WS_CTL);
    int* tmp = Li + 128;
    const int e = tid & 31, part = tid >> 5;
    int s = 0, pre = 0;
    for (int i = 0; i < 16; ++i) { const int b = part * 16 + i; const int h = hist[b * 32 + e]; s += h; if (b < tb) pre += h; }
    tmp[part * 32 + e] = s; tmp[512 + part * 32 + e] = pre;
    __syncthreads();
    if (tid < 32) { int a = 0, b = 0; for (int i = 0; i < 16; ++i) { a += tmp[i * 32 + tid]; b += tmp[512 + i * 32 + tid]; } Li[tid] = a; Li[65 + tid] = b; }
    __syncthreads();
    if (tid == 0) { int ps = 0; for (int i = 0; i < 32; ++i) { Li[32 + i] = ps; ps += (Li[i] + 255) / 256 * 256; } Li[64] = ps; }
    __syncthreads();
}
__device__ __forceinline__ int tile_expert(const int* Li, int m0) { int e = 0; for (int i = 0; i < 32; ++i) if (m0 >= Li[32 + i] && m0 < Li[33 + i]) e = i; return e; }

__device__ __forceinline__ void phase_inproj(CParams& p, float* lds) {
    const bf16_t* XB = (const bf16_t*)(p.ws + WS_XB); const bf16_t* Bt = (const bf16_t*)(p.ws + WS_W + W_BT1); bf16_t* ZS = (bf16_t*)(p.ws + WS_R1 + R1_ZS);
    ngemm(T, ZSW, 1024, 1024, 1024, [=](int m0, int) { return XB + (size_t)m0 * 1024; }, [=](int, int n0) { return Bt + (size_t)n0 * 1024; },
          [=](int m, int n, float v) { ZS[(size_t)m * ZSW + n] = (bf16_t)f2bf(v); }, lds);
}
__device__ __forceinline__ float logsigmoid_(float x) { return -(fmaxf(-x, 0.f) + log1pf(expf(-fabsf(x)))); }
__device__ __forceinline__ void phase_upproj(CParams& p, int l, float* lds) {
    const int tid = tid_(), lane = tid & 63, wave = tid >> 6;
    const bf16_t* ZS = (const bf16_t*)(p.ws + WS_R1 + R1_ZS);
    const bf16_t* Bup = (const bf16_t*)(p.ws + WS_W + W_UQ); bf16_t* QKVR = (bf16_t*)(p.ws + WS_R1 + R1_QKVR);
    ngemm(T, 1024, 256, ZSW, 256, [=](int m0, int n0) { return ZS + (size_t)m0 * ZSW + (n0 >> 9) * 256; }, [=](int, int n0) { return Bup + (size_t)n0 * 256; },
          [=](int m, int n, float v) { QKVR[(size_t)m * 1024 + n] = (bf16_t)f2bf(v); }, lds);
}

__device__ __forceinline__ void phase_prep(CParams& p, int l, float* lds) {
    const int tid = tid_(), lane = tid & 63, wave = tid >> 6;
    const int gw = bid_() * NWAVES + wave, NGW = nblk_() * NWAVES;
    const bf16_t* ZS = (const bf16_t*)(p.ws + WS_R1 + R1_ZS); const bf16_t* QKVR = (const bf16_t*)(p.ws + WS_R1 + R1_QKVR);
    bf16_t* Qm = (bf16_t*)(p.ws + WS_C + C_QM); bf16_t* Km = (bf16_t*)(p.ws + WS_C + C_KM); bf16_t* Vm = (bf16_t*)(p.ws + WS_C + C_VM);
    for (int m = gw; m < T; m += NGW) {
        const bf16_t* zr = ZS + (size_t)m * ZSW;
        float sq = 0.f, skv = 0.f;
#pragma unroll
        for (int j = 0; j < 4; ++j) { const float v = bf2f(zr[C_CQ + lane + 64 * j]); sq += v * v; }
#pragma unroll
        for (int j = 0; j < 2; ++j) { const float v = bf2f(zr[C_CKV + lane + 64 * j]); skv += v * v; }
        const float rq = rsqrtf(wave_sum(sq) * (1.f / 256.f) + EPS), rkv = rsqrtf(wave_sum(skv) * (1.f / 128.f) + EPS);
        const float posf = (float)p.pos[m];
        float cs = 1.f, sn = 0.f;
        { const float inv = exp2f(-(float)(lane & 15) * (13.287712379549449f / 16.f)); sincosf(posf * inv, &sn, &cs); }
        const bf16_t* qr = QKVR + (size_t)m * 1024; const bf16_t* kvr = qr + 512;
#pragma unroll
        for (int j = 0; j < 6; ++j) {
            const int idx = lane + 64 * j, h = idx / 96, d = idx % 96;
            float q, k;
            const int i = (d - 64) & 15, hf = (d - 64) >> 4;
            const float c = __shfl(cs, i), s = __shfl(sn, i);
            if (d < 64) { q = bf2f(qr[h * 96 + d]); k = bf2f(kvr[h * 128 + d]) * rkv; }
            else {
                const float q1 = bf2f(qr[h * 96 + 64 + i]), q2 = bf2f(qr[h * 96 + 80 + i]);
                const float k1 = bf2f(zr[C_KR + i]), k2 = bf2f(zr[C_KR + 16 + i]);
                q = hf == 0 ? q1 * c - q2 * s : q2 * c + q1 * s;
                k = hf == 0 ? k1 * c - k2 * s : k2 * c + k1 * s;
            }
            Qm[(size_t)m * 384 + idx] = (bf16_t)f2bf(q * rq * C2_M);
            Km[(size_t)m * 384 + idx] = (bf16_t)f2bf(k);
        }
#pragma unroll
        for (int j = 0; j < 4; ++j) { const int idx = lane + 64 * j, h = idx >> 6, d = idx & 63; Vm[(size_t)m * 256 + idx] = (bf16_t)f2bf(bf2f(kvr[h * 128 + 64 + d]) * rkv); }
    }
    __syncthreads();
    float* hs = lds;
    float* ys = lds + 62 * 256;
    bf16_t* YS = (bf16_t*)(p.ws + WS_D);
    const float* cw = p.conv_w + (size_t)l * 31 * 256; const float* cb = p.conv_b + l * 256; const float* lg = p.conv_g + l * 256; const float* lb = p.conv_bb + l * 256;
    for (int ch = bid_(); ch < T / 32; ch += nblk_()) {
        const int m0 = ch * 32, t0 = m0 & (SEQ - 1);
        for (int idx = tid; idx < 62 * 256; idx += NTHREADS) {
            const int r = idx >> 8, c = idx & 255, tt = t0 - 30 + r; float v = 0.f;
            if (tt >= 0) { const bf16_t* zr = ZS + (size_t)(m0 - 30 + r) * ZSW; v = bf2f(zr[C_CVA + c]) * sigmoidf_(bf2f(zr[C_CVG + c])); }
            hs[idx] = v;
        }
        __syncthreads();
        { const int c = tid & 255, half = tid >> 8; float w[31];
#pragma unroll
            for (int i = 0; i < 31; ++i) w[i] = cw[i * 256 + c];
            const float bias = cb[c];
            for (int i = half * 16; i < half * 16 + 16; ++i) { float a = bias;
#pragma unroll
                for (int k = 0; k < 31; ++k) a += hs[(i + k) * 256 + c] * w[k];
                ys[i * 256 + c] = a; } }
        __syncthreads();
#pragma unroll
        for (int q = 0; q < 4; ++q) {
            const int i = wave * 4 + q; const f32x4 v = *(const f32x4*)(ys + i * 256 + lane * 4);
            const float mean = wave_sum((v.x + v.y) + (v.z + v.w)) * (1.f / 256.f);
            const f32x4 dv = v - mean; const float var = wave_sum((dv.x * dv.x + dv.y * dv.y) + (dv.z * dv.z + dv.w * dv.w)) * (1.f / 256.f);
            const float rstd = rsqrtf(var + EPS);
            const f32x4 g = *(const f32x4*)(lg + lane * 4), bb = *(const f32x4*)(lb + lane * 4);
            f32x4 y = dv * rstd * g + bb;
            y.x = y.x * sigmoidf_(y.x); y.y = y.y * sigmoidf_(y.y); y.z = y.z * sigmoidf_(y.z); y.w = y.w * sigmoidf_(y.w);
            u32x2 o; o.x = pk2(y.x, y.y); o.y = pk2(y.z, y.w);
            *(u32x2*)(YS + (size_t)(m0 + i) * 1024 + 512 + lane * 4) = o;
        }
        __syncthreads();
    }
}

template <int MODE, int DQ>
__device__ __forceinline__ void attn_naive(const bf16_t* Q, int qp, const bf16_t* K, int kp, const bf16_t* V, int vp, const float* CF, bf16_t* Y, float* lds) {
    const int tid = tid_(), lane = tid & 63, wave = tid >> 6;
    const int gw = bid_() * NWAVES + wave, NGW = nblk_() * NWAVES;
    float* qs = lds + wave * 128;
    for (int row = gw; row < T * 4; row += NGW) {
        const int m = row >> 2, h = row & 3, b = m >> 12, t = m & (SEQ - 1);
        LDS_FENCE();
        for (int d = lane; d < DQ; d += 64) qs[d] = bf2f(Q[(size_t)m * qp + h * DQ + d]);
        LDS_FENCE();
        float acc = 0.f, mx = -INFINITY, l = 0.f, R = 0.f;
        const int last = MODE == 1 ? t - 1 : t;
        const int nch = last < 0 ? 0 : (last >> 6) + 1;
        for (int ci = 0; ci < nch; ++ci) {
            const int j0 = (MODE == 1 ? (nch - 1 - ci) : ci) * 64, j = j0 + lane;
            const bool valid = j <= last;
            const int jc = valid ? j : last;
            const bf16_t* kr = K + ((size_t)b * SEQ + jc) * kp + h * DQ;
            float s = 0.f;
#pragma unroll
            for (int c = 0; c < DQ / 8; ++c) { const u32x4 kv = *(const u32x4*)(kr + c * 8);
#pragma unroll
                for (int i = 0; i < 4; ++i) s += qs[c * 8 + 2 * i] * bf2f(kv[i] & 0xffffu) + qs[c * 8 + 2 * i + 1] * bf2f(kv[i] >> 16); }
            float pj;
            if (MODE == 1) {
                float L2 = valid ? -(fmaxf(s, 0.f) + log2f(1.f + exp2f(-fabsf(s)))) : 0.f;
                float suf = L2;
#pragma unroll
                for (int o = 1; o < 64; o <<= 1) { const float y = __shfl_down(suf, o); if (lane + o < 64) suf += y; }
                const float after = R + (suf - L2);
                pj = valid ? exp2f(s + L2 + after) : 0.f;
                R += __shfl(suf, 0);
            } else {
                if (MODE == 2) s -= CF[((size_t)b * SEQ + jc) * 4 + h] * LOG2E;
                if (!valid) s = -INFINITY;
                const float mn = fmaxf(mx, wave_max(s));
                const float f = exp2f(mx - mn);
                pj = exp2f(s - mn);
                l = l * f + wave_sum(pj); acc *= f; mx = mn;
            }
            const bf16_t* vb = V + ((size_t)b * SEQ + j0) * vp + h * 64 + lane;
            const int nv = last - j0 + 1 < 64 ? last - j0 + 1 : 64;
            for (int jj = 0; jj < nv; ++jj) acc += __shfl(pj, jj) * bf2f(vb[(size_t)jj * vp]);
        }
        if (MODE != 1) acc = nch ? acc / l : 0.f;
        Y[(size_t)m * 1024 + h * 64 + lane] = (bf16_t)f2bf(acc);
    }
}
__device__ __forceinline__ void phase_attn(CParams& p, float* lds) {
    const bf16_t* ZS = (const bf16_t*)(p.ws + WS_R1 + R1_ZS); bf16_t* YS = (bf16_t*)(p.ws + WS_D);
    const bf16_t* Qm = (const bf16_t*)(p.ws + WS_C + C_QM); const bf16_t* Km = (const bf16_t*)(p.ws + WS_C + C_KM); const bf16_t* Vm = (const bf16_t*)(p.ws + WS_C + C_VM);
    const float* CF = (const float*)(p.ws + WS_ROUTE + RT_CF);
    attn_naive<0, 96>(Qm, 384, Km, 384, Vm, 256, nullptr, YS, lds);
    attn_naive<1, 64>(ZS + C_SBQ, ZSW, ZS + C_SBK, ZSW, ZS + C_SBV, ZSW, nullptr, YS + 256, lds);
    attn_naive<2, 64>(ZS + C_FXQ, ZSW, ZS + C_FXK, ZSW, ZS + C_FXV, ZSW, CF, YS + 768, lds);
}

__device__ __forceinline__ void phase_pgemm(CParams& p, float* lds) {
    const bf16_t* YS = (const bf16_t*)(p.ws + WS_D); const bf16_t* Bt = (const bf16_t*)(p.ws + WS_W + W_BR); bf16_t* PB = (bf16_t*)(p.ws + WS_R1 + R1_PB);
    ngemm(T, 4096, 256, 1024, 256, [=](int m0, int n0) { return YS + (size_t)m0 * 1024 + (n0 >> 10) * 256; }, [=](int, int n0) { return Bt + (size_t)n0 * 256; },
          [=](int m, int n, float v) { PB[(size_t)m * 4096 + n] = (bf16_t)f2bf(v); }, lds);
}
__device__ __forceinline__ void phase_gate(CParams& p, int l, float* lds) {
    const bf16_t* XB = (const bf16_t*)(p.ws + WS_XB); const bf16_t* Bt = (const bf16_t*)(p.ws + WS_W + W_GATE); bf16_t* PB = (bf16_t*)(p.ws + WS_R1 + R1_PB);
    const float* bg = p.b_gate + (size_t)l * 4096;
    ngemm(T, 4096, 1024, 1024, 1024, [=](int m0, int) { return XB + (size_t)m0 * 1024; }, [=](int, int n0) { return Bt + (size_t)n0 * 1024; },
          [=](int m, int n, float v) { const size_t i = (size_t)m * 4096 + n; PB[i] = (bf16_t)f2bf(sigmoidf_(v + bg[n]) * bf2f(PB[i])); }, lds);
}
__device__ __forceinline__ void phase_combine(CParams& p) {
    const bf16_t* PB = (const bf16_t*)(p.ws + WS_R1 + R1_PB); bf16_t* MG = (bf16_t*)(p.ws + WS_C);
    for (size_t i = (size_t)bid_() * NTHREADS + tid_(); i < (size_t)T * 1024; i += (size_t)nblk_() * NTHREADS) {
        const size_t m = i >> 10, d = i & 1023; const bf16_t* r = PB + m * 4096 + d;
        MG[i] = (bf16_t)f2bf((bf2f(r[0]) + bf2f(r[1024])) + (bf2f(r[2048]) + bf2f(r[3072])));
    }
}
__device__ __forceinline__ void phase_wo(CParams& p, int l, float* lds) {
    const bf16_t* MG = (const bf16_t*)(p.ws + WS_C); const bf16_t* Bt = (const bf16_t*)(p.ws + WS_W + W_O);
    const float* xf = l == 0 ? p.x : p.out; float* out = p.out;
    ngemm(T, 1024, 1024, 1024, 1024, [=](int m0, int) { return MG + (size_t)m0 * 1024; }, [=](int, int n0) { return Bt + (size_t)n0 * 1024; },
          [=](int m, int n, float v) { const size_t i = (size_t)m * 1024 + n; out[i] = ALPHA * xf[i] + v; }, lds);
}

__device__ __forceinline__ void ln_row(f32x4 (&v)[4], const float* g, const float* b, int lane) {
    float s = 0.f;
#pragma unroll
    for (int j = 0; j < 4; ++j) s += (v[j].x + v[j].y) + (v[j].z + v[j].w);
    const float mean = wave_sum(s) * (1.f / 1024.f); float s2 = 0.f;
#pragma unroll
    for (int j = 0; j < 4; ++j) { v[j] = v[j] - mean; s2 += (v[j].x * v[j].x + v[j].y * v[j].y) + (v[j].z * v[j].z + v[j].w * v[j].w); }
    const float rstd = rsqrtf(wave_sum(s2) * (1.f / 1024.f) + EPS);
#pragma unroll
    for (int j = 0; j < 4; ++j) { const f32x4 gg = *(const f32x4*)(g + 256 * j + 4 * lane), bb = *(const f32x4*)(b + 256 * j + 4 * lane); v[j] = v[j] * rstd * gg + bb; }
}

__device__ __forceinline__ void phase_ln1route(CParams& p, int l, float* lds) {
    const int tid = tid_(), lane = tid & 63, wave = tid >> 6;
    int* cnt = (int*)lds; float* sl = lds + 64 + wave * 64; float* hrow = lds + 1024 + wave * 1024;
    int* tok_e = (int*)(p.ws + WS_ROUTE + RT_TOKE); float* tok_w = (float*)(p.ws + WS_ROUTE + RT_TOKW); int* tok_p = (int*)(p.ws + WS_ROUTE + RT_TOKP);
    int* hist = (int*)(p.ws + WS_CTL); bf16_t* HB = (bf16_t*)(p.ws + WS_C);
    const float* wrg = p.w_rg + (size_t)l * 1024 * 4; const float* wre = p.w_re + (size_t)l * 1024 * 32;
    for (int tb = bid_(); tb < 256; tb += nblk_()) {
        if (tid < 32) cnt[tid] = 0;
        __syncthreads();
        for (int q = 0; q < 8; ++q) {
            const int m = tb * 64 + wave * 8 + q;
            f32x4* orow = (f32x4*)(p.out + (size_t)m * D) + lane; f32x4 v[4];
#pragma unroll
            for (int j = 0; j < 4; ++j) v[j] = orow[64 * j];
            ln_row(v, p.ln1_g + l * D, p.ln1_b + l * D, lane);
            u32x2* hb = (u32x2*)(HB + (size_t)m * D) + lane;
#pragma unroll
            for (int j = 0; j < 4; ++j) { orow[64 * j] = v[j]; u32x2 w; w.x = pk2(v[j].x, v[j].y); w.y = pk2(v[j].z, v[j].w); hb[64 * j] = w; }
            float ag[4] = {0.f, 0.f, 0.f, 0.f}; float ae[32];
#pragma unroll
            for (int i = 0; i < 32; ++i) ae[i] = 0.f;
#pragma unroll
            for (int j = 0; j < 4; ++j) *(f32x4*)(hrow + 256 * j + 4 * lane) = v[j];
            LDS_FENCE();
#pragma unroll 2
            for (int kk = 0; kk < 16; ++kk) {
                const int k = kk * 64 + lane; const float hv = hrow[k];
                const f32x4 g4 = *(const f32x4*)(wrg + (size_t)k * 4);
                ag[0] += hv * g4.x; ag[1] += hv * g4.y; ag[2] += hv * g4.z; ag[3] += hv * g4.w;
#pragma unroll
                for (int e4 = 0; e4 < 8; ++e4) { const f32x4 w4 = *(const f32x4*)(wre + (size_t)k * 32 + e4 * 4);
                    ae[e4 * 4 + 0] += hv * w4.x; ae[e4 * 4 + 1] += hv * w4.y; ae[e4 * 4 + 2] += hv * w4.z; ae[e4 * 4 + 3] += hv * w4.w; }
            }
#pragma unroll
            for (int i = 0; i < 4; ++i) { const float r = wave_sum(ag[i]); if (lane == 0) sl[i] = r + p.b_rg[l * 4 + i]; }
#pragma unroll
            for (int i = 0; i < 32; ++i) { const float r = wave_sum(ae[i]); if (lane == 0) sl[4 + i] = r + p.b_re[l * 32 + i]; }
            LDS_FENCE();
            if (lane == 0) {
                int g = 0; float gm = sl[0];
                for (int i = 1; i < 4; ++i) if (sl[i] > gm) { gm = sl[i]; g = i; }
                float gs = 0.f; for (int i = 0; i < 4; ++i) gs += expf(sl[i] - gm);
                const float grp_p = 1.f / gs;
                const float* le = sl + 4 + g * 8;
                int i0 = 0; float m0 = le[0];
                for (int i = 1; i < 8; ++i) if (le[i] > m0) { m0 = le[i]; i0 = i; }
                int i1 = -1; float m1 = -INFINITY;
                for (int i = 0; i < 8; ++i) if (i != i0 && le[i] > m1) { m1 = le[i]; i1 = i; }
                const float e1 = expf(m1 - m0), den = 1.f + e1;
                const int x0 = g * 8 + i0, x1 = g * 8 + i1;
                tok_e[m * 2] = x0; tok_e[m * 2 + 1] = x1;
                tok_w[m * 2] = grp_p / den; tok_w[m * 2 + 1] = grp_p * e1 / den;
                tok_p[m * 2] = atomicAdd(&cnt[x0], 1); tok_p[m * 2 + 1] = atomicAdd(&cnt[x1], 1);
            }
            LDS_FENCE();
        }
        __syncthreads();
        if (tid < 32) hist[tb * 32 + tid] = cnt[tid];
        __syncthreads();
    }
}

__device__ __forceinline__ void phase_gather(CParams& p, float* lds) {
    const int tid = tid_(), lane = tid & 63, wave = tid >> 6;
    int* Li = (int*)lds;
    const int* tok_e = (const int*)(p.ws + WS_ROUTE + RT_TOKE); const float* tok_w = (const float*)(p.ws + WS_ROUTE + RT_TOKW); const int* tok_p = (const int*)(p.ws + WS_ROUTE + RT_TOKP);
    int* tok_s = (int*)(p.ws + WS_ROUTE + RT_TOKS); float* slot_w = (float*)(p.ws + WS_ROUTE + RT_SLOTW);
    const bf16_t* HB = (const bf16_t*)(p.ws + WS_C); bf16_t* XG = (bf16_t*)(p.ws + WS_R1 + R1_XG);
    for (int tb = bid_(); tb < 256; tb += nblk_()) {
        expert_offsets(p, tb, Li);
        for (int q = 0; q < 16; ++q) {
            const int a = tb * 128 + wave * 16 + q, m = a >> 1;
            const int e = tok_e[a]; const int slot = Li[32 + e] + Li[65 + e] + tok_p[a];
            const u32x4* src = (const u32x4*)(HB + (size_t)m * D) + lane; u32x4* dst = (u32x4*)(XG + (size_t)slot * D) + lane;
            dst[0] = src[0]; dst[64] = src[64];
            if (lane == 0) { tok_s[a] = slot; slot_w[slot] = tok_w[a]; }
        }
        __syncthreads();
    }
}
__device__ __forceinline__ void phase_moeup(CParams& p, float* lds) {
    int* Li = (int*)(lds + 16384);
    expert_offsets(p, 0, Li);
    const bf16_t* XG = (const bf16_t*)(p.ws + WS_R1 + R1_XG); const bf16_t* Bt = (const bf16_t*)(p.ws + WS_W + W_GU); bf16_t* GU = (bf16_t*)(p.ws + WS_C);
    ngemm(Li[64], 512, 1024, 1024, 1024, [=](int m0, int) { return XG + (size_t)m0 * 1024; }, [=](int m0, int n0) { return Bt + ((size_t)tile_expert(Li, m0) * 512 + n0) * 1024; },
          [=](int m, int n, float v) { GU[(size_t)m * 512 + n] = (bf16_t)f2bf(v); }, lds);
}
__device__ __forceinline__ void phase_swiglu(CParams& p, float* lds) {
    int* Li = (int*)(lds + 16384);
    expert_offsets(p, 0, Li);
    const size_t n = (size_t)Li[64] * 256;
    const bf16_t* GU = (const bf16_t*)(p.ws + WS_C); bf16_t* HID = (bf16_t*)(p.ws + WS_R1 + R1_HID);
    for (size_t i = (size_t)bid_() * NTHREADS + tid_(); i < n; i += (size_t)nblk_() * NTHREADS) {
        const size_t s = i >> 8; const int f = (int)(i & 255), j = f >> 7, rr = f & 127;
        const float g = bf2f(GU[s * 512 + j * 256 + rr]), u = bf2f(GU[s * 512 + j * 256 + 128 + rr]);
        HID[i] = (bf16_t)f2bf(g * sigmoidf_(g) * u);
    }
    __syncthreads();
}
__device__ __forceinline__ void phase_moedown(CParams& p, float* lds) {
    int* Li = (int*)(lds + 16384);
    expert_offsets(p, 0, Li);
    const bf16_t* HID = (const bf16_t*)(p.ws + WS_R1 + R1_HID); const bf16_t* Bt = (const bf16_t*)(p.ws + WS_W + W_D); bf16_t* YSL = (bf16_t*)(p.ws + WS_R1 + R1_YSL);
    ngemm(Li[64], 1024, 256, 256, 256, [=](int m0, int) { return HID + (size_t)m0 * 256; }, [=](int m0, int n0) { return Bt + ((size_t)tile_expert(Li, m0) * 1024 + n0) * 256; },
          [=](int m, int n, float v) { YSL[(size_t)m * 1024 + n] = (bf16_t)f2bf(v); }, lds);
}
__device__ __forceinline__ void phase_ln2(CParams& p, int l) {
    const int tid = tid_(), lane = tid & 63, wave = tid >> 6;
    const int gw = bid_() * NWAVES + wave, NGW = nblk_() * NWAVES;
    const int* tok_s = (const int*)(p.ws + WS_ROUTE + RT_TOKS); const bf16_t* YSL = (const bf16_t*)(p.ws + WS_R1 + R1_YSL); const float* tok_w = (const float*)(p.ws + WS_ROUTE + RT_TOKW);
    for (int m = gw; m < T; m += NGW) {
        f32x4* orow = (f32x4*)(p.out + (size_t)m * D) + lane; f32x4 v[4];
        const u32x2* y0 = (const u32x2*)(YSL + (size_t)tok_s[m * 2] * D) + lane; const u32x2* y1 = (const u32x2*)(YSL + (size_t)tok_s[m * 2 + 1] * D) + lane;
        const float w0 = tok_w[m * 2], w1 = tok_w[m * 2 + 1];
#pragma unroll
        for (int j = 0; j < 4; ++j) {
            const u32x2 a = y0[64 * j], b = y1[64 * j]; const f32x4 hv = orow[64 * j];
            v[j].x = ALPHA * hv.x + (w0 * bf2f(a.x & 0xffffu) + w1 * bf2f(b.x & 0xffffu)); v[j].y = ALPHA * hv.y + (w0 * bf2f(a.x >> 16) + w1 * bf2f(b.x >> 16));
            v[j].z = ALPHA * hv.z + (w0 * bf2f(a.y & 0xffffu) + w1 * bf2f(b.y & 0xffffu)); v[j].w = ALPHA * hv.w + (w0 * bf2f(a.y >> 16) + w1 * bf2f(b.y >> 16));
        }
        ln_row(v, p.ln2_g + l * D, p.ln2_b + l * D, lane);
#pragma unroll
        for (int j = 0; j < 4; ++j) orow[64 * j] = v[j];
        if (l == 0) emit_xrow(p, v, m, 1, lane);
    }
}


typedef PG8_LAS unsigned char* ldsp_t;
constexpr int LI_OFF = 131072 + 1024;

__device__ __forceinline__ void fox_scan(CParams& p, int l, int bh, int lane) {
    const int b = bh >> 2, h = bh & 3; const float* F = (const float*)(p.ws + WS_ROUTE + RT_FXF); float* CF = (float*)(p.ws + WS_ROUTE + RT_CF);
    const float bf = p.b_forget[l * 4 + h];
    float run = 0.f;
    for (int j = 0; j < 64; ++j) run += logsigmoid_(F[((size_t)b * SEQ + lane * 64 + j) * 4 + h] + bf);
    float inc = run;
#pragma unroll
    for (int o = 1; o < 64; o <<= 1) { const float y = __shfl_up(inc, o); if (lane >= o) inc += y; }
    float c = inc - run;
    for (int j = 0; j < 64; ++j) { const size_t idx = ((size_t)b * SEQ + lane * 64 + j) * 4 + h; c += logsigmoid_(F[idx] + bf); CF[idx] = c; }
}
__device__ __forceinline__ void fphase_inproj(CParams& p, int l, ldsp_t lds) {
    pg8::Gemm g{(const bf16_t*)(p.ws + WS_XB), (const bf16_t*)(p.ws + WS_W + W_BT1), T, ZSW, 1024, 1024};
    pg8::StaticOrder S; S.init(T, ZSW, nblk_(), bid_());
    pg8::EpiBf16 E{(bf16_t*)(p.ws + WS_R1 + R1_ZS), ZSW};
    pg8::gemm_phase<pg8::EpiBf16, pg8::StaticOrder, 1024, 1024, true, true>(lds, g, S, E);
    const int tid = tid_(), bb = bid_(), nb = nblk_();
    const int first = nb >= 160 ? 128 : 0;
    for (int bh = bb - first; bh >= 0 && bh < 16; bh += nb) if ((tid >> 6) == 0) fox_scan(p, l, bh, tid & 63);
}
__device__ __forceinline__ void fphase_upproj(CParams& p, ldsp_t lds) {
    pg8::Gemm g{(const bf16_t*)(p.ws + WS_R1 + R1_ZS), (const bf16_t*)(p.ws + WS_W + W_UQ), T, 1024, 256, ZSW};
    pg8::BranchOrder S; S.s.init(T, 1024, nblk_(), bid_()); S.shift = 1;
    pg8::EpiBf16 E{(bf16_t*)(p.ws + WS_R1 + R1_QKVR), 1024};
    pg8::gemm_phase<pg8::EpiBf16, pg8::BranchOrder, 256, ZSW, true, true>(lds, g, S, E);
}
__device__ __forceinline__ void fphase_pgemm(CParams& p, ldsp_t lds) {
    pg8::Gemm g{(const bf16_t*)(p.ws + WS_D), (const bf16_t*)(p.ws + WS_W + W_BR), T, 4096, 256, 1024};
    pg8::BranchOrder S; S.s.init(T, 4096, nblk_(), bid_()); S.shift = 2;
    pg8::EpiBf16 E{(bf16_t*)(p.ws + WS_R1 + R1_PB), 4096};
    pg8::gemm_phase<pg8::EpiBf16, pg8::BranchOrder, 256, 1024, true, true>(lds, g, S, E);
}
__device__ __forceinline__ void fphase_gate(CParams& p, int l, ldsp_t lds) {
    pg8::Gemm g{(const bf16_t*)(p.ws + WS_XB), (const bf16_t*)(p.ws + WS_W + W_GATE), T, 4096, 1024, 1024};
    pg8::StaticOrder S; S.init(T, 4096, nblk_(), bid_());
    pg8::EpiGate E{(const bf16_t*)(p.ws + WS_R1 + R1_PB), (bf16_t*)(p.ws + WS_C), p.b_gate + (size_t)l * 4096};
    pg8::gemm_phase<pg8::EpiGate, pg8::StaticOrder, 1024, 1024, true, true>(lds, g, S, E);
}
__device__ __forceinline__ void fphase_wo(CParams& p, int l, ldsp_t lds) {
    pg8::Gemm g{(const bf16_t*)(p.ws + WS_C), (const bf16_t*)(p.ws + WS_W + W_O), T, 1024, 1024, 1024};
    pg8::StaticOrder S; S.init(T, 1024, nblk_(), bid_());
    pg8::EpiRes E{l == 0 ? p.x : p.out, p.out, ALPHA};
    pg8::gemm_phase<pg8::EpiRes, pg8::StaticOrder, 1024, 1024, true, true>(lds, g, S, E);
}
__device__ __forceinline__ void fphase_moeup(CParams& p, ldsp_t lds, float* ldsf) {
    int* Li = (int*)(ldsf + LI_OFF / 4);
    expert_offsets(p, 0, Li);
    pg8::Gemm g{(const bf16_t*)(p.ws + WS_R1 + R1_XG), (const bf16_t*)(p.ws + WS_W + W_GU), 0, 512, 1024, 1024};
    pg8::MoeOrder S{Li, 2, nblk_(), bid_(), (long)512 * 1024 * 2};
    pg8::EpiSwiglu E{(bf16_t*)(p.ws + WS_R1 + R1_HID)};
    pg8::gemm_phase<pg8::EpiSwiglu, pg8::MoeOrder, 1024, 1024, true, true>(lds, g, S, E);
}
__device__ __forceinline__ void fphase_moedown(CParams& p, ldsp_t lds, float* ldsf) {
    int* Li = (int*)(ldsf + LI_OFF / 4);
    expert_offsets(p, 0, Li);
    pg8::Gemm g{(const bf16_t*)(p.ws + WS_R1 + R1_HID), (const bf16_t*)(p.ws + WS_W + W_D), 0, 1024, 256, 256};
    pg8::MoeOrder S{Li, 4, nblk_(), bid_(), (long)1024 * 256 * 2};
    pg8::EpiBf16 E{(bf16_t*)(p.ws + WS_R1 + R1_YSL), 1024};
    pg8::gemm_phase<pg8::EpiBf16, pg8::MoeOrder, 256, 256, true, true>(lds, g, S, E);
}

enum { PH_CONVW = 0, PH_INPROJ, PH_UPPROJ, PH_PREP, PH_ATTN, PH_PGEMM, PH_GATE, PH_COMBINE, PH_WO, PH_LN1, PH_GATHER, PH_MOEUP, PH_SWIGLU, PH_MOEDOWN, PH_LN2, PH_N };
__device__ __forceinline__ void run_phase(CParams& p, int ph, int l, float* lds, ldsp_t ldsp) {
    switch (ph) {
        case PH_CONVW: phase_convw(p, l, lds); if (l == 0) phase_convx(p); break;
        case PH_INPROJ: if constexpr ((FAST & F_INPROJ) != 0) fphase_inproj(p, l, ldsp); else phase_inproj(p, lds); break;
        case PH_UPPROJ:
            if constexpr ((FAST & F_INPROJ) == 0) { const int tid = tid_(); for (int bh = bid_(); bh < 16; bh += nblk_()) if ((tid >> 6) == 0) fox_scan(p, l, bh, tid & 63); }
            if constexpr ((FAST & F_UPPROJ) != 0) fphase_upproj(p, ldsp); else phase_upproj(p, l, lds); break;
        case PH_PREP: phase_prep(p, l, lds); break;
        case PH_ATTN: phase_attn(p, lds); break;
        case PH_PGEMM: if constexpr ((FAST & F_PGEMM) != 0) fphase_pgemm(p, ldsp); else phase_pgemm(p, lds); break;
        case PH_GATE: if constexpr ((FAST & F_GATE) != 0) fphase_gate(p, l, ldsp); else phase_gate(p, l, lds); break;
        case PH_COMBINE: if constexpr ((FAST & F_GATE) == 0) phase_combine(p); break;
        case PH_WO: if constexpr ((FAST & F_WO) != 0) fphase_wo(p, l, ldsp); else phase_wo(p, l, lds); break;
        case PH_LN1: phase_ln1route(p, l, lds); break;
        case PH_GATHER: phase_gather(p, lds); break;
        case PH_MOEUP: if constexpr ((FAST & F_MOEUP) != 0) fphase_moeup(p, ldsp, lds); else phase_moeup(p, lds); break;
        case PH_SWIGLU: if constexpr ((FAST & F_MOEUP) == 0) phase_swiglu(p, lds); break;
        case PH_MOEDOWN: if constexpr ((FAST & F_MOEDOWN) != 0) fphase_moedown(p, ldsp, lds); else phase_moedown(p, lds); break;
        case PH_LN2: phase_ln2(p, l); break;
    }
}
__global__ void __launch_bounds__(NTHREADS, 2) mega(Params p) {
    extern __shared__ __attribute__((aligned(16))) unsigned char lds_raw[];
    cg::grid_group grid = cg::this_grid();
#pragma unroll 1
    for (int l = 0; l < 2; ++l) {
#pragma unroll 1
        for (int ph = 0; ph < PH_N; ++ph) {
            if ((ph == PH_COMBINE && (FAST & F_GATE) != 0) || (ph == PH_SWIGLU && (FAST & F_MOEUP) != 0)) continue;
            CParams* pp = (CParams*)__builtin_amdgcn_kernarg_segment_ptr();
            asm volatile("" : "+s"(pp));
            run_phase(*pp, ph, l, (float*)lds_raw, (ldsp_t)lds_raw);
            if (!(l == 1 && ph == PH_N - 1)) grid.sync();
        }
    }
}

extern "C" void kernel_launch(void* const* d_in, const int* in_sizes, int n_in, void* d_out, int out_size, void* d_ws, size_t ws_size, hipStream_t stream) {
    static int grid = 0;
    if (grid == 0) {
        if (n_in != 26 || out_size != T * D || ws_size < WS_END) { fprintf(stderr, "kernel_launch: unexpected shapes (n_in %d out %d ws %zu, need %zu)\n", n_in, out_size, ws_size, (size_t)WS_END); grid = -1; return; }
        int dev = 0, cus = 0, per_cu = 0;
        (void)hipGetDevice(&dev); (void)hipDeviceGetAttribute(&cus, hipDeviceAttributeMultiprocessorCount, dev);
        (void)hipFuncSetAttribute((const void*)mega, hipFuncAttributeMaxDynamicSharedMemorySize, LDS_BYTES);
        if (hipOccupancyMaxActiveBlocksPerMultiprocessor(&per_cu, (const void*)mega, NTHREADS, LDS_BYTES) != hipSuccess || per_cu < 1) { fprintf(stderr, "kernel_launch: occupancy query says %d\n", per_cu); grid = -1; return; }
        grid = cus;
    }
    if (grid < 0) return;
    Params p{};
    const float** pf = (const float**)&p;
    p.x = (const float*)d_in[0]; p.pos = (const int*)d_in[1];
    for (int i = 2; i < 26; ++i) pf[i] = (const float*)d_in[i];
    p.out = (float*)d_out; p.ws = (unsigned char*)d_ws;
    void* args[] = {&p};
    hipError_t e = hipLaunchCooperativeKernel((const void*)mega, dim3(grid), dim3(NTHREADS), args, LDS_BYTES, stream);
    if (e != hipSuccess) fprintf(stderr, "cooperative launch failed: %s (grid %d)\n", hipGetErrorString(e), grid);
}
```

```cpp
#include <hip/hip_runtime.h>
#include <hip/hip_cooperative_groups.h>
#include <cstdio>
#include <cstdint>
namespace cg = cooperative_groups;

typedef unsigned short bf16_t;
typedef float f32x4 __attribute__((ext_vector_type(4)));
typedef unsigned u32x4 __attribute__((ext_vector_type(4)));
typedef unsigned u32x2 __attribute__((ext_vector_type(2)));

constexpr int NB = 4, SEQ = 4096, T = NB * SEQ, D = 1024, NIN = 6564, ZSW = 2560;
constexpr int NEXP = 32, EFF = 256, MAXSLOT = 40960;
constexpr int C_CQ = 0, C_CKV = 256, C_KR = 384, C_SBQ = 416, C_SBK = 672, C_SBV = 928, C_CVA = 1184, C_CVG = 1440,
              C_FXQ = 1696, C_FXK = 1952, C_FXV = 2208, C_FXF = 2464, C_GATE = 2468;
constexpr float LOG2E = 1.4426950408889634f;
constexpr float C2_64 = 0.125f * LOG2E;
constexpr float C2_M = 0.10206207261596575f * LOG2E;
constexpr float ALPHA = 1.4142135623730951f;
constexpr float EPS = 1e-5f;
constexpr int NTHREADS = 512, NWAVES = 8;
constexpr unsigned F_INPROJ = 1, F_UPPROJ = 2, F_PGEMM = 4, F_GATE = 8, F_WO = 16, F_MOEUP = 32, F_MOEDOWN = 64, F_AMLA = 128, F_ASB = 256, F_AFOX = 512;
#ifndef FAST_MASK
#define FAST_MASK 1023
#endif
constexpr unsigned FAST = FAST_MASK;
constexpr int LDS_BYTES = 147456;

constexpr size_t MiB = 1u << 20;
constexpr size_t WS_CTL = 0;
constexpr size_t WS_ROUTE = 1 * MiB;
constexpr size_t RT_TOKE = 0, RT_TOKW = 131072, RT_TOKP = 262144, RT_TOKS = 393216, RT_SLOTW = 524288, RT_FXF = 786432, RT_CF = 1048576;
constexpr size_t WS_W = 3 * MiB;
constexpr size_t W_BT1 = 0, W_GATE = 5 * MiB, W_UQ = 13 * MiB, W_UKV = W_UQ + 262144, W_BR = W_UKV + 262144, W_O = W_BR + 2 * MiB, W_GU = W_O + 2 * MiB, W_D = W_GU + 32 * MiB;
static_assert(W_D + 16 * MiB <= 66 * MiB, "weights");
constexpr size_t WS_XB = 69 * MiB;
constexpr size_t WS_R1 = 101 * MiB;
constexpr size_t R1_ZS = 0, R1_QKVR = 80 * MiB, R1_PB = 0, R1_XG = 0, R1_HID = 80 * MiB, R1_YSL = 0;
constexpr size_t WS_C = 229 * MiB;
constexpr size_t C_QM = 0, C_KM = 12 * MiB, C_VM = 24 * MiB;
constexpr size_t WS_D = 261 * MiB;
constexpr size_t WS_E = 293 * MiB;
constexpr size_t E_QF = 0, E_KF = 10 * MiB;
constexpr size_t WS_END = 313 * MiB;
constexpr size_t CTL_QUEUE = 65536;

struct Params {
    const float* x; const int* pos; const float* w_in; const float* b_gate; const float* b_forget;
    const float* q_norm; const float* kv_norm; const float* w_uq; const float* w_ukv;
    const float* conv_w; const float* conv_b; const float* conv_g; const float* conv_bb;
    const float* w_branch; const float* w_o; const float* ln1_g; const float* ln1_b;
    const float* w_rg; const float* b_rg; const float* w_re; const float* b_re;
    const float* w_eg; const float* w_eu; const float* w_ed; const float* ln2_g; const float* ln2_b;
    float* out; unsigned char* ws; int phase; int layer;
};
typedef const __attribute__((address_space(4))) Params CParams;

__device__ __forceinline__ unsigned f2bf(float f) { unsigned u = __float_as_uint(f); return (u + 0x7fffu + ((u >> 16) & 1u)) >> 16; }
__device__ __forceinline__ float bf2f(unsigned b) { return __uint_as_float(b << 16); }
__device__ __forceinline__ unsigned pk2(float lo, float hi) { return f2bf(lo) | (f2bf(hi) << 16); }
__device__ __forceinline__ float wave_sum(float v) {
#pragma unroll
    for (int o = 1; o < 64; o <<= 1) v += __shfl_xor(v, o);
    return v;
}
__device__ __forceinline__ float wave_max(float v) {
#pragma unroll
    for (int o = 1; o < 64; o <<= 1) v = fmaxf(v, __shfl_xor(v, o));
    return v;
}
__device__ __forceinline__ float sigmoidf_(float x) { return 1.f / (1.f + __expf(-x)); }
#define LDS_FENCE() asm volatile("s_waitcnt lgkmcnt(0)" ::: "memory")
__device__ __forceinline__ int tid_() { int t = threadIdx.x; asm volatile("" : "+v"(t)); return t; }
__device__ __forceinline__ int bid_() { int t = blockIdx.x; asm volatile("" : "+s"(t)); return t; }
__device__ __forceinline__ int nblk_() { int t = gridDim.x; asm volatile("" : "+s"(t)); return t; }

template <class F>
__device__ __forceinline__ void tr_item(const float* W, int ldw, bf16_t* out, int Kd, int r0, int k0, const float* ks, F f, float* scr, int lane) {
    const int rl = lane & 31, r = r0 + rl, c = f.col(r); const float s = f.rs(r);
#pragma unroll 8
    for (int i = 0; i < 32; ++i) {
        const int kk = 2 * i + (lane >> 5); float v = 0.f;
        if (c >= 0) { v = W[(size_t)(k0 + kk) * ldw + c] * s; if (ks) v *= ks[k0 + kk]; }
        scr[kk * 33 + rl] = v;
    }
    LDS_FENCE();
    const int cc = lane & 7;
#pragma unroll
    for (int j = 0; j < 4; ++j) {
        const int n = (lane >> 3) + 8 * j; const float* s8 = scr + (8 * cc) * 33 + n;
        u32x4 o; o.x = pk2(s8[0], s8[33]); o.y = pk2(s8[66], s8[99]); o.z = pk2(s8[132], s8[165]); o.w = pk2(s8[198], s8[231]);
        *(u32x4*)(out + (size_t)(r0 + n) * Kd + k0 + 8 * cc) = o;
    }
    LDS_FENCE();
}
struct MapBt1 { __device__ int col(int r) const { return r < C_GATE ? r : -1; } __device__ float rs(int r) const { return ((r >= C_SBQ && r < C_SBK) || (r >= C_FXQ && r < C_FXK)) ? C2_64 : 1.f; } };
struct MapGate { __device__ int col(int r) const { return C_GATE + r; } __device__ float rs(int) const { return 1.f; } };
struct MapGateP { __device__ int col(int r) const { const int pn = r >> 8, cl = r & 255; return C_GATE + (2 * (cl >> 7) + ((cl >> 4) & 1)) * 1024 + pn * 64 + 16 * ((cl >> 5) & 3) + (cl & 15); } __device__ float rs(int) const { return 1.f; } };
struct MapLim { int lim; __device__ int col(int r) const { return r < lim ? r : -1; } __device__ float rs(int) const { return 1.f; } };
struct MapGU { __device__ int col(int r) const { return ((r >> 8) << 7) + (r & 127); } __device__ float rs(int) const { return 1.f; } };

__device__ __forceinline__ void phase_convw(CParams& p, int l, float* lds) {
    const int tid = tid_(), lane = tid & 63, wave = tid >> 6;
    float* scr = lds + wave * (64 * 33);
    unsigned char* W = p.ws + WS_W;
    const int gw = bid_() * NWAVES + wave, NGW = nblk_() * NWAVES;
    constexpr int I_A = 80 * 16, I_B = 128 * 16, I_C = 16 * 4, I_Dd = 16 * 4, I_E = 4 * 128, I_F = 32 * 16, I_G = 32 * 256, I_H = 32 * 128;
    constexpr int NIT = I_A + I_B + I_C + I_Dd + I_E + I_F + I_G + I_H;
    for (int it = gw; it < NIT; it += NGW) {
        int r = it;
        if (r < I_A) { tr_item(p.w_in + (size_t)l * D * NIN, NIN, (bf16_t*)(W + W_BT1), 1024, (r >> 4) * 32, (r & 15) * 64, nullptr, MapBt1{}, scr, lane); continue; } r -= I_A;
        if (r < I_B) { if constexpr ((FAST & F_GATE) != 0) tr_item(p.w_in + (size_t)l * D * NIN, NIN, (bf16_t*)(W + W_GATE), 1024, (r >> 4) * 32, (r & 15) * 64, nullptr, MapGateP{}, scr, lane); else tr_item(p.w_in + (size_t)l * D * NIN, NIN, (bf16_t*)(W + W_GATE), 1024, (r >> 4) * 32, (r & 15) * 64, nullptr, MapGate{}, scr, lane); continue; } r -= I_B;
        if (r < I_C) { tr_item(p.w_uq + (size_t)l * 256 * 384, 384, (bf16_t*)(W + W_UQ), 256, (r >> 2) * 32, (r & 3) * 64, p.q_norm + l * 256, MapLim{384}, scr, lane); continue; } r -= I_C;
        if (r < I_Dd) { const int kb = r & 3; if (kb < 2) tr_item(p.w_ukv + (size_t)l * 128 * 512, 512, (bf16_t*)(W + W_UKV), 256, (r >> 2) * 32, kb * 64, p.kv_norm + l * 128, MapLim{512}, scr, lane);
            else tr_item(p.w_ukv, 512, (bf16_t*)(W + W_UKV), 256, (r >> 2) * 32, kb * 64, nullptr, MapLim{0}, scr, lane); continue; } r -= I_Dd;
        if (r < I_E) { const int n = r >> 7, q = r & 127; tr_item(p.w_branch + ((size_t)l * 4 + n) * 256 * 1024, 1024, (bf16_t*)(W + W_BR) + (size_t)n * 1024 * 256, 256, (q >> 2) * 32, (q & 3) * 64, nullptr, MapLim{1024}, scr, lane); continue; } r -= I_E;
        if (r < I_F) { tr_item(p.w_o + (size_t)l * 1024 * 1024, 1024, (bf16_t*)(W + W_O), 1024, (r >> 4) * 32, (r & 15) * 64, nullptr, MapLim{1024}, scr, lane); continue; } r -= I_F;
        if (r < I_G) { const int e = r >> 8, q = r & 255, rb = q >> 4, kb = q & 15; const int r0 = rb * 32; const bool up = (r0 >> 7) & 1;
            const float* src = (up ? p.w_eu : p.w_eg) + ((size_t)l * NEXP + e) * 1024 * 256;
            tr_item(src, 256, (bf16_t*)(W + W_GU) + (size_t)e * 512 * 1024, 1024, r0, kb * 64, nullptr, MapGU{}, scr, lane); continue; } r -= I_G;
        { const int e = r >> 7, q = r & 127; tr_item(p.w_ed + ((size_t)l * NEXP + e) * 256 * 1024, 1024, (bf16_t*)(W + W_D) + (size_t)e * 1024 * 256, 256, (q >> 2) * 32, (q & 3) * 64, nullptr, MapLim{1024}, scr, lane); }
    }
}

__device__ __forceinline__ void emit_xrow(CParams& p, const f32x4 (&v)[4], int m, int l, int lane) {
    u32x2* o8 = (u32x2*)((bf16_t*)(p.ws + WS_XB) + (size_t)m * D) + lane;
    f32x4 acc = {0.f, 0.f, 0.f, 0.f};
    const float* wf = p.w_in + (size_t)l * D * NIN + C_FXF;
#pragma unroll
    for (int j = 0; j < 4; ++j) {
        u32x2 w; w.x = pk2(v[j].x, v[j].y); w.y = pk2(v[j].z, v[j].w); o8[64 * j] = w;
        const int k = 256 * j + 4 * lane;
        acc += v[j].x * *(const f32x4*)(wf + (size_t)(k + 0) * NIN);
        acc += v[j].y * *(const f32x4*)(wf + (size_t)(k + 1) * NIN);
        acc += v[j].z * *(const f32x4*)(wf + (size_t)(k + 2) * NIN);
        acc += v[j].w * *(const f32x4*)(wf + (size_t)(k + 3) * NIN);
    }
    acc.x = wave_sum(acc.x); acc.y = wave_sum(acc.y); acc.z = wave_sum(acc.z); acc.w = wave_sum(acc.w);
    if (lane == 0) *(f32x4*)((float*)(p.ws + WS_ROUTE + RT_FXF) + (size_t)m * 4) = acc;
}
__device__ __forceinline__ void phase_convx(CParams& p) {
    const int tid = tid_(), lane = tid & 63, wave = tid >> 6;
    const int gw = bid_() * NWAVES + wave, NGW = nblk_() * NWAVES;
    for (int m = gw; m < T; m += NGW) {
        const f32x4* xr = (const f32x4*)(p.x + (size_t)m * D) + lane; f32x4 v[4];
#pragma unroll
        for (int j = 0; j < 4; ++j) v[j] = xr[64 * j];
        emit_xrow(p, v, m, 0, lane);
    }
}

namespace pg8 {
#define PG8_LAS __attribute__((address_space(3)))
typedef unsigned short bf16_t;
typedef short bf16x8 __attribute__((ext_vector_type(8)));
typedef float f32x4 __attribute__((ext_vector_type(4)));
typedef unsigned u32x4 __attribute__((ext_vector_type(4)));
constexpr int BM = 256, BK = 64, HALF = 128, HTB = HALF * BK * 2  , STAGE_BYTES = 8 * HTB, NXCD = 8, WGM = 8;

__host__ __device__ __forceinline__ int lds_byte(int r, int c) { const int st = (r >> 4) * 2 + (c >> 5), rr = r & 15, cc = c & 31, ob = rr * 64 + cc * 2; return st * 1024 + (ob ^ (((ob >> 9) & 1) << 5)); }
__host__ __device__ __forceinline__ void stage_rc(int b, int& R, int& C) { const int st = b / 1024, sb = b % 1024, swz = sb ^ (((sb >> 9) & 1) << 5); R = (st >> 1) * 16 + swz / 64; C = (st & 1) * 32 + (swz % 64) / 2; }
__host__ __device__ __forceinline__ int perm32(int rho) { const int n = rho >> 4, i = rho & 15; return 8 * (i >> 2) + 4 * n + (i & 3); }

struct Unit { int pm, pn; long aoff, boff; };
struct Gemm { const bf16_t* A; const bf16_t* Bt; int M, N, K, lda; };

struct StaticOrder {
    int nM, nN, nwg, G, c;
    __host__ __device__ void init(int M, int N, int G_, int c_) { nM = M / BM; nN = N / BM; nwg = nM * nN; G = G_; c = c_; }
    __host__ __device__ bool next(int i, Unit& u) const {
        const long L = (long)i * G + c; if (L >= nwg) return false;
        int wgid = (int)L; { const int q = nwg / NXCD, r = nwg % NXCD, xcd = wgid % NXCD, off = wgid / NXCD; wgid = (xcd < r ? xcd * (q + 1) : r * (q + 1) + (xcd - r) * q) + off; }
        const int nig = WGM * nN, gid = wgid / nig, fm = gid * WGM, gsz = (nM - fm) < WGM ? (nM - fm) : WGM;
        u.pm = fm + ((wgid % nig) % gsz); u.pn = (wgid % nig) / gsz; u.aoff = 0; u.boff = 0; return true;
    }
    __device__ __forceinline__ void a_ready(const Unit&) const {}
    __device__ __forceinline__ void done(const Unit&) const {}
};


__device__ __forceinline__ unsigned cvt_pk_bf16(float lo, float hi) { unsigned r; asm volatile("v_cvt_pk_bf16_f32 %0, %1, %2" : "=v"(r) : "v"(lo), "v"(hi)); return r; }
__device__ __forceinline__ float sig_(float x) { return __builtin_amdgcn_rcpf(1.f + __builtin_amdgcn_exp2f(-1.4426950408889634f * x)); }
struct EpiBf16 {
    static constexpr bool PERM = true, AFTER_DRAIN = false;
    bf16_t* O; int ldc;
    __device__ __forceinline__ void operator()(const f32x4 (&acc)[2][2][4][2], const Unit& u, int wr, int wc, int fr, int fq) const {
        const int row0 = u.pm * BM + wr * 64 + fr, col0 = u.pn * BM + wc * 32 + 8 * fq;
#pragma unroll
        for (int ai = 0; ai < 2; ++ai)
#pragma unroll
            for (int m = 0; m < 4; ++m) { const int row = row0 + ai * HALF + m * 16; bf16_t* rowp = O + (size_t)row * ldc + col0;
#pragma unroll
                for (int bj = 0; bj < 2; ++bj) { const f32x4 v0 = acc[ai][bj][m][0], v1 = acc[ai][bj][m][1];
                    u32x4 w; w.x = cvt_pk_bf16(v0[0], v0[1]); w.y = cvt_pk_bf16(v0[2], v0[3]); w.z = cvt_pk_bf16(v1[0], v1[1]); w.w = cvt_pk_bf16(v1[2], v1[3]);
                    *(u32x4*)(rowp + bj * HALF) = w; } }
    }
};
struct EpiGate {
    static constexpr bool PERM = false, AFTER_DRAIN = false;
    const bf16_t* PB; bf16_t* MG; const float* bg;
    __device__ __forceinline__ void operator()(const f32x4 (&acc)[2][2][4][2], const Unit& u, int wr, int wc, int fr, int fq) const {
        typedef unsigned u32x2_t __attribute__((ext_vector_type(2)));
        const int row0 = u.pm * BM + wr * 64 + fr, d0 = u.pn * 64 + wc * 16 + fq * 4;
        f32x4 bv[2][2];
#pragma unroll
        for (int bj = 0; bj < 2; ++bj)
#pragma unroll
            for (int n = 0; n < 2; ++n) bv[bj][n] = *(const f32x4*)(bg + (2 * bj + n) * 1024 + d0);
#pragma unroll
        for (int ai = 0; ai < 2; ++ai)
#pragma unroll
            for (int m = 0; m < 4; ++m) { const int row = row0 + ai * HALF + m * 16; const bf16_t* pr = PB + (size_t)row * 4096 + d0; f32x4 s = {0.f, 0.f, 0.f, 0.f};
#pragma unroll
                for (int bj = 0; bj < 2; ++bj)
#pragma unroll
                    for (int n = 0; n < 2; ++n) { const u32x2_t pv = *(const u32x2_t*)(pr + (2 * bj + n) * 1024); const f32x4 a = acc[ai][bj][m][n] + bv[bj][n];
                        s[0] += sig_(a[0]) * __uint_as_float(pv.x << 16); s[1] += sig_(a[1]) * __uint_as_float(pv.x & 0xffff0000u);
                        s[2] += sig_(a[2]) * __uint_as_float(pv.y << 16); s[3] += sig_(a[3]) * __uint_as_float(pv.y & 0xffff0000u); }
                u32x2_t w; w.x = cvt_pk_bf16(s[0], s[1]); w.y = cvt_pk_bf16(s[2], s[3]); *(u32x2_t*)(MG + (size_t)row * 1024 + d0) = w; }
    }
};
struct EpiRes {
    static constexpr bool PERM = false, AFTER_DRAIN = false;
    const float* base; float* out; float alpha;
    __device__ __forceinline__ void operator()(const f32x4 (&acc)[2][2][4][2], const Unit& u, int wr, int wc, int fr, int fq) const {
        const int row0 = u.pm * BM + wr * 64 + fr, col0 = u.pn * BM + wc * 32 + 4 * fq;
#pragma unroll
        for (int ai = 0; ai < 2; ++ai)
#pragma unroll
            for (int m = 0; m < 4; ++m) { const size_t off = (size_t)(row0 + ai * HALF + m * 16) * 1024 + col0;
#pragma unroll
                for (int bj = 0; bj < 2; ++bj)
#pragma unroll
                    for (int n = 0; n < 2; ++n) { const f32x4 b = *(const f32x4*)(base + off + bj * HALF + n * 16); *(f32x4*)(out + off + bj * HALF + n * 16) = b * alpha + acc[ai][bj][m][n]; } }
    }
};
struct EpiSwiglu {
    static constexpr bool PERM = true, AFTER_DRAIN = false;
    bf16_t* HID;
    __device__ __forceinline__ void operator()(const f32x4 (&acc)[2][2][4][2], const Unit& u, int wr, int wc, int fr, int fq) const {
        const int row0 = u.pm * BM + wr * 64 + fr, col0 = u.pn * HALF + wc * 32 + 8 * fq;
#pragma unroll
        for (int ai = 0; ai < 2; ++ai)
#pragma unroll
            for (int m = 0; m < 4; ++m) { const int row = row0 + ai * HALF + m * 16; float h[8];
#pragma unroll
                for (int n = 0; n < 2; ++n)
#pragma unroll
                    for (int i = 0; i < 4; ++i) { const float g = acc[ai][0][m][n][i], uu = acc[ai][1][m][n][i]; h[n * 4 + i] = g * sig_(g) * uu; }
                u32x4 w; w.x = cvt_pk_bf16(h[0], h[1]); w.y = cvt_pk_bf16(h[2], h[3]); w.z = cvt_pk_bf16(h[4], h[5]); w.w = cvt_pk_bf16(h[6], h[7]);
                *(u32x4*)(HID + (size_t)row * 256 + col0) = w; }
    }
};
struct BranchOrder {
    StaticOrder s; int shift;
    __device__ bool next(int i, Unit& u) const { if (!s.next(i, u)) return false; u.aoff = (long)(u.pn >> shift) * 512; return true; }
    __device__ __forceinline__ void a_ready(const Unit&) const {}
    __device__ __forceinline__ void done(const Unit&) const {}
};
struct MoeOrder {
    const int* Li; int nN, G, c; long bstride;
    __device__ bool next(int i, Unit& u) const {
        const int L = i * G + c, ntile = Li[64] >> 8; if (L >= ntile * nN) return false;
        u.pm = L / nN; u.pn = L % nN; const int m0 = u.pm << 8; int e = 0;
        for (int k = 0; k < 32; ++k) if (m0 >= Li[32 + k] && m0 < Li[33 + k]) e = k;
        u.aoff = 0; u.boff = (long)e * bstride; return true;
    }
    __device__ __forceinline__ void a_ready(const Unit&) const {}
    __device__ __forceinline__ void done(const Unit&) const {}
};
template <class Epi, class Sched, int KK, int LDA, bool ALIGN_EPI = false, bool SP2 = false>
__device__ __forceinline__ void gemm_phase(PG8_LAS unsigned char* lds, const Gemm g, const Sched& S, const Epi& E) {
    const int tid = tid_(), wid = __builtin_amdgcn_readfirstlane(tid >> 6), lane = tid & 63, wr = wid >> 2, wc = wid & 3, fr = lane & 15, fq = lane >> 4;
    constexpr int K = KK, nt = K / BK;
    unsigned voffA[2], voffB[2];
#pragma unroll
    for (int i = 0; i < 2; ++i) { int R, C; stage_rc(tid * 16 + i * 8192, R, C); const int Rb = Epi::PERM ? ((R & ~31) + perm32(R & 31)) : R;
        voffA[i] = (unsigned)(R * LDA + C) * 2u; voffB[i] = (unsigned)(Rb * K + C) * 2u; }
    constexpr size_t kstep = (size_t)(BK * 2);
    constexpr size_t hstepA = (size_t)HALF * LDA * 2, hstepB = (size_t)HALF * K * 2;
    constexpr size_t tstepA = 2 * hstepA, tstepB = 2 * hstepB;
    const unsigned ldsw = (unsigned)wid * 1024u;
    const int aoff = lds_byte(wr * 64 + fr, fq * 8), boff = lds_byte(wc * 32 + fr, fq * 8);
#define PG8_SA(b, h) (((b) * 2 + (h)) * HTB)
#define PG8_SB(b, h) ((4 + (b) * 2 + (h)) * HTB)
#define PG8_STAGE(bufoff, gbase, voff) do { _Pragma("unroll") for (int _i = 0; _i < 2; ++_i) \
        __builtin_amdgcn_global_load_lds((const unsigned*)((const char*)(gbase) + (voff)[_i]), (PG8_LAS unsigned*)(lds + (bufoff) + ldsw + _i * 8192), 16, 0, 0); } while (0)
#define PG8_LDA(dst, b, h) do { _Pragma("unroll") for (int m = 0; m < 4; ++m) _Pragma("unroll") for (int k = 0; k < 2; ++k) dst[m][k] = *(const PG8_LAS bf16x8*)(lds + PG8_SA(b, h) + aoff + m * 2048 + k * 1024); } while (0)
#define PG8_LDB(dst, b, h) do { _Pragma("unroll") for (int n = 0; n < 2; ++n) _Pragma("unroll") for (int k = 0; k < 2; ++k) dst[n][k] = *(const PG8_LAS bf16x8*)(lds + PG8_SB(b, h) + boff + n * 2048 + k * 1024); } while (0)
#define PG8_MMA(ai, bj, At, Bt) do { __builtin_amdgcn_s_setprio(1); _Pragma("unroll") for (int m = 0; m < 4; ++m) _Pragma("unroll") for (int n = 0; n < 2; ++n) _Pragma("unroll") for (int k = 0; k < 2; ++k) \
        acc[ai][bj][m][n] = __builtin_amdgcn_mfma_f32_16x16x32_bf16(Bt[n][k], At[m][k], acc[ai][bj][m][n], 0, 0, 0); __builtin_amdgcn_s_setprio(0); } while (0)
#define PG8_WAIT_V(n) asm volatile("s_waitcnt vmcnt(" #n ")" ::: "memory")
#define PG8_WAIT_L(n) asm volatile("s_waitcnt lgkmcnt(" #n ")" ::: "memory")
#define PG8_BAR __builtin_amdgcn_s_barrier()
#define PG8_SCHED __builtin_amdgcn_sched_barrier(0)
    Unit cur, nxt; int ui = 0;
    if (!S.next(0, cur)) return;
    f32x4 acc[2][2][4][2];
#pragma unroll
    for (int a = 0; a < 2; ++a)
#pragma unroll
        for (int b = 0; b < 2; ++b)
#pragma unroll
            for (int m = 0; m < 4; ++m)
#pragma unroll
                for (int n = 0; n < 2; ++n) acc[a][b][m][n] = (f32x4){0.f, 0.f, 0.f, 0.f};
    bf16x8 At[4][2], B0[2][2], B1[2][2];
    const char* cA = (const char*)g.A + (size_t)cur.pm * tstepA + cur.aoff; const char* cB = (const char*)g.Bt + (size_t)cur.pn * tstepB + cur.boff;
    S.a_ready(cur);
    if constexpr (SP2) {
        PG8_STAGE(PG8_SB(0, 0), cB, voffB); PG8_STAGE(PG8_SB(0, 1), cB + hstepB, voffB); PG8_STAGE(PG8_SA(0, 0), cA, voffA); PG8_STAGE(PG8_SA(0, 1), cA + hstepA, voffA);
        if (wr == 1) PG8_BAR;
        PG8_WAIT_V(2); PG8_BAR;
        PG8_STAGE(PG8_SB(1, 0), cB + kstep, voffB); PG8_STAGE(PG8_SA(1, 0), cA + kstep, voffA); PG8_STAGE(PG8_SB(1, 1), cB + hstepB + kstep, voffB);
        PG8_WAIT_V(6); PG8_BAR;
    } else {
        PG8_STAGE(PG8_SB(0, 0), cB, voffB); PG8_STAGE(PG8_SA(0, 0), cA, voffA); PG8_STAGE(PG8_SB(0, 1), cB + hstepB, voffB); PG8_STAGE(PG8_SA(0, 1), cA + hstepA, voffA);
        if (wr == 1) PG8_BAR;
        PG8_WAIT_V(4); PG8_BAR;
        PG8_STAGE(PG8_SB(1, 0), cB + kstep, voffB); PG8_STAGE(PG8_SA(1, 0), cA + kstep, voffA); PG8_STAGE(PG8_SB(1, 1), cB + hstepB + kstep, voffB);
        PG8_WAIT_V(6); PG8_BAR;
    }
    for (;;) {
        const bool has_next = S.next(ui + 1, nxt);
        const char* nA = has_next ? (const char*)g.A + (size_t)nxt.pm * tstepA + nxt.aoff : cA; const char* nB = has_next ? (const char*)g.Bt + (size_t)nxt.pn * tstepB + nxt.boff : cB;
#pragma unroll 1
        for (int t = 0; t < nt; t += 2) {
            const bool last = (t == nt - 2);
            const char* a1 = cA + (size_t)(t + 1) * kstep;
            const char* a2 = last ? nA : cA + (size_t)(t + 2) * kstep; const char* b2 = last ? nB : cB + (size_t)(t + 2) * kstep;
            const char* a3 = a2 + kstep; const char* b3 = b2 + kstep;
            if (last && has_next) S.a_ready(nxt);
            if constexpr (SP2) {
            PG8_LDB(B0, 0, 0); PG8_LDB(B1, 0, 1); PG8_SCHED; PG8_LDA(At, 0, 0); PG8_STAGE(PG8_SA(1, 1), a1 + hstepA, voffA);
            PG8_WAIT_V(8); PG8_WAIT_L(0); PG8_BAR; PG8_MMA(0, 0, At, B0); PG8_MMA(0, 1, At, B1); PG8_BAR; PG8_SCHED;
            PG8_LDA(At, 0, 1); PG8_STAGE(PG8_SB(0, 0), b2, voffB); PG8_STAGE(PG8_SB(0, 1), b2 + hstepB, voffB); PG8_STAGE(PG8_SA(0, 0), a2, voffA);
            PG8_WAIT_V(8); PG8_WAIT_L(0); PG8_BAR; PG8_MMA(1, 0, At, B0); PG8_MMA(1, 1, At, B1); PG8_BAR; PG8_SCHED;
            PG8_LDB(B0, 1, 0); PG8_LDB(B1, 1, 1); PG8_SCHED; PG8_LDA(At, 1, 0); PG8_STAGE(PG8_SA(0, 1), a2 + hstepA, voffA);
            PG8_WAIT_V(8); PG8_WAIT_L(0); PG8_BAR; PG8_MMA(0, 0, At, B0); PG8_MMA(0, 1, At, B1); PG8_BAR; PG8_SCHED;
            PG8_LDA(At, 1, 1); PG8_STAGE(PG8_SB(1, 0), b3, voffB); PG8_STAGE(PG8_SB(1, 1), b3 + hstepB, voffB); PG8_STAGE(PG8_SA(1, 0), a3, voffA);
            PG8_WAIT_V(8); PG8_WAIT_L(0); PG8_BAR; PG8_MMA(1, 0, At, B0); PG8_MMA(1, 1, At, B1); PG8_BAR; PG8_SCHED;
            } else {
            PG8_LDB(B0, 0, 0); PG8_SCHED; PG8_LDA(At, 0, 0); PG8_STAGE(PG8_SA(1, 1), a1 + hstepA, voffA);
            PG8_WAIT_L(8); PG8_BAR; PG8_WAIT_L(0); PG8_MMA(0, 0, At, B0); PG8_BAR; PG8_SCHED;
            PG8_LDB(B1, 0, 1); PG8_STAGE(PG8_SB(0, 0), b2, voffB);
            PG8_BAR; PG8_WAIT_L(0); PG8_MMA(0, 1, At, B1); PG8_BAR;
            PG8_LDA(At, 0, 1); PG8_STAGE(PG8_SA(0, 0), a2, voffA);
            PG8_BAR; PG8_WAIT_L(0); PG8_MMA(1, 0, At, B0); PG8_BAR; PG8_SCHED;
            PG8_STAGE(PG8_SB(0, 1), b2 + hstepB, voffB);
            PG8_WAIT_V(6); PG8_BAR; PG8_MMA(1, 1, At, B1); PG8_BAR;
            PG8_LDB(B0, 1, 0); PG8_SCHED; PG8_LDA(At, 1, 0); PG8_STAGE(PG8_SA(0, 1), a2 + hstepA, voffA);
            PG8_WAIT_L(8); PG8_BAR; PG8_WAIT_L(0); PG8_MMA(0, 0, At, B0); PG8_BAR; PG8_SCHED;
            PG8_LDB(B1, 1, 1); PG8_STAGE(PG8_SB(1, 0), b3, voffB);
            PG8_BAR; PG8_WAIT_L(0); PG8_MMA(0, 1, At, B1); PG8_BAR;
            PG8_LDA(At, 1, 1); PG8_STAGE(PG8_SA(1, 0), a3, voffA);
            PG8_BAR; PG8_WAIT_L(0); PG8_MMA(1, 0, At, B0); PG8_BAR; PG8_SCHED;
            PG8_STAGE(PG8_SB(1, 1), b3 + hstepB, voffB);
            PG8_WAIT_V(6); PG8_BAR; PG8_MMA(1, 1, At, B1); PG8_BAR;
            }
        }
        if constexpr (ALIGN_EPI) { if (wr == 0) PG8_BAR; }
        if constexpr (!Epi::AFTER_DRAIN) { E(acc, cur, wr, wc, fr, fq); S.done(cur); }
        if (!has_next) break;
#pragma unroll
        for (int a = 0; a < 2; ++a)
#pragma unroll
            for (int b = 0; b < 2; ++b)
#pragma unroll
                for (int m = 0; m < 4; ++m)
#pragma unroll
                    for (int n = 0; n < 2; ++n) acc[a][b][m][n] = (f32x4){0.f, 0.f, 0.f, 0.f};
        cur = nxt; cA = nA; cB = nB; ++ui;
        if constexpr (ALIGN_EPI) { if (wr == 1) PG8_BAR; }
    }
    PG8_WAIT_V(0);
    if constexpr (!ALIGN_EPI) { if (wr == 0) PG8_BAR; }
    PG8_BAR;
    if constexpr (Epi::AFTER_DRAIN) { E.fused(acc, cur, wr, wc, fr, fq, lds, wid, lane); S.done(cur); }
#undef PG8_SA
#undef PG8_SB
#undef PG8_STAGE
#undef PG8_LDA
#undef PG8_LDB
#undef PG8_MMA
#undef PG8_WAIT_V
#undef PG8_WAIT_L
#undef PG8_BAR
#undef PG8_SCHED
}
}

template <class AP, class BP, class Epi>
__device__ __forceinline__ void ngemm(int M, int N, int K, int lda, int ldb, AP ap, BP bp, Epi epi, float* lds) {
    const int tid = tid_(), ty = tid >> 4, tx = tid & 15;
    float* As = lds; float* Bs = lds + 32 * 128;
    const int ntm = M / 128, ntn = N / 128;
    const int lrow = tid >> 2, lkc = (tid & 3) * 8;
    for (int tile = bid_(); tile < ntm * ntn; tile += nblk_()) {
        const int tm = tile / ntn, tn = tile % ntn, m0 = tm * 128, n0 = tn * 128;
        const bf16_t* Ab = ap(m0, n0) + (size_t)lrow * lda + lkc; const bf16_t* Bb = bp(m0, n0) + (size_t)lrow * ldb + lkc;
        float acc[4][8];
#pragma unroll
        for (int i = 0; i < 4; ++i)
#pragma unroll
            for (int j = 0; j < 8; ++j) acc[i][j] = 0.f;
        for (int k0 = 0; k0 < K; k0 += 32) {
            const u32x4 va = *(const u32x4*)(Ab + k0); const u32x4 vb = *(const u32x4*)(Bb + k0);
            __syncthreads();
#pragma unroll
            for (int i = 0; i < 4; ++i) {
                As[(lkc + 2 * i) * 128 + lrow] = bf2f(va[i] & 0xffffu); As[(lkc + 2 * i + 1) * 128 + lrow] = bf2f(va[i] >> 16);
                Bs[(lkc + 2 * i) * 128 + lrow] = bf2f(vb[i] & 0xffffu); Bs[(lkc + 2 * i + 1) * 128 + lrow] = bf2f(vb[i] >> 16);
            }
            __syncthreads();
#pragma unroll 8
            for (int kk = 0; kk < 32; ++kk) {
                const f32x4 a = *(const f32x4*)(As + kk * 128 + ty * 4);
                const f32x4 b0 = *(const f32x4*)(Bs + kk * 128 + tx * 8), b1 = *(const f32x4*)(Bs + kk * 128 + tx * 8 + 4);
#pragma unroll
                for (int i = 0; i < 4; ++i) {
                    acc[i][0] += a[i] * b0.x; acc[i][1] += a[i] * b0.y; acc[i][2] += a[i] * b0.z; acc[i][3] += a[i] * b0.w;
                    acc[i][4] += a[i] * b1.x; acc[i][5] += a[i] * b1.y; acc[i][6] += a[i] * b1.z; acc[i][7] += a[i] * b1.w;
                }
            }
        }
#pragma unroll
        for (int i = 0; i < 4; ++i)
#pragma unroll
            for (int j = 0; j < 8; ++j) epi(m0 + ty * 4 + i, n0 + tx * 8 + j, acc[i][j]);
    }
    __syncthreads();
}

__device__ __forceinline__ void expert_offsets(CParams& p, int tb, int* Li) {
    const int tid = tid_(); const int* hist = (const int*)(p.ws + WS_CTL);
    int* tmp = Li + 128;
    const int e = tid & 31, part = tid >> 5;
    int s = 0, pre = 0;
    for (int i = 0; i < 16; ++i) { const int b = part * 16 + i; const int h = hist[b * 32 + e]; s += h; if (b < tb) pre += h; }
    tmp[part * 32 + e] = s; tmp[512 + part * 32 + e] = pre;
    __syncthreads();
    if (tid < 32) { int a = 0, b = 0; for (int i = 0; i < 16; ++i) { a += tmp[i * 32 + tid]; b += tmp[512 + i * 32 + tid]; } Li[tid] = a; Li[65 + tid] = b; }
    __syncthreads();
    if (tid == 0) { int ps = 0; for (int i = 0; i < 32; ++i) { Li[32 + i] = ps; ps += (Li[i] + 255) / 256 * 256; } Li[64] = ps; }
    __syncthreads();
}
__device__ __forceinline__ int tile_expert(const int* Li, int m0) { int e = 0; for (int i = 0; i < 32; ++i) if (m0 >= Li[32 + i] && m0 < Li[33 + i]) e = i; return e; }

__device__ __forceinline__ void phase_inproj(CParams& p, float* lds) {
    const bf16_t* XB = (const bf16_t*)(p.ws + WS_XB); const bf16_t* Bt = (const bf16_t*)(p.ws + WS_W + W_BT1); bf16_t* ZS = (bf16_t*)(p.ws + WS_R1 + R1_ZS);
    ngemm(T, ZSW, 1024, 1024, 1024, [=](int m0, int) { return XB + (size_t)m0 * 1024; }, [=](int, int n0) { return Bt + (size_t)n0 * 1024; },
          [=](int m, int n, float v) { ZS[(size_t)m * ZSW + n] = (bf16_t)f2bf(v); }, lds);
}
__device__ __forceinline__ float logsigmoid_(float x) { return -(fmaxf(-x, 0.f) + log1pf(expf(-fabsf(x)))); }
__device__ __forceinline__ void phase_upproj(CParams& p, int l, float* lds) {
    const int tid = tid_(), lane = tid & 63, wave = tid >> 6;
    const bf16_t* ZS = (const bf16_t*)(p.ws + WS_R1 + R1_ZS);
    const bf16_t* Bup = (const bf16_t*)(p.ws + WS_W + W_UQ); bf16_t* QKVR = (bf16_t*)(p.ws + WS_R1 + R1_QKVR);
    ngemm(T, 1024, 256, ZSW, 256, [=](int m0, int n0) { return ZS + (size_t)m0 * ZSW + (n0 >> 9) * 256; }, [=](int, int n0) { return Bup + (size_t)n0 * 256; },
          [=](int m, int n, float v) { QKVR[(size_t)m * 1024 + n] = (bf16_t)f2bf(v); }, lds);
}

__device__ __forceinline__ void phase_prep(CParams& p, int l, float* lds) {
    const int tid = tid_(), lane = tid & 63, wave = tid >> 6;
    const int gw = bid_() * NWAVES + wave, NGW = nblk_() * NWAVES;
    const bf16_t* ZS = (const bf16_t*)(p.ws + WS_R1 + R1_ZS); const bf16_t* QKVR = (const bf16_t*)(p.ws + WS_R1 + R1_QKVR);
    bf16_t* Qm = (bf16_t*)(p.ws + WS_C + C_QM); bf16_t* Km = (bf16_t*)(p.ws + WS_C + C_KM); bf16_t* Vm = (bf16_t*)(p.ws + WS_C + C_VM);
    bf16_t* QF = (bf16_t*)(p.ws + WS_E + E_QF); bf16_t* KF = (bf16_t*)(p.ws + WS_E + E_KF); const float* CFp = (const float*)(p.ws + WS_ROUTE + RT_CF);
    for (int m = gw; m < T; m += NGW) {
        const bf16_t* zr = ZS + (size_t)m * ZSW;
        float sq = 0.f, skv = 0.f;
#pragma unroll
        for (int j = 0; j < 4; ++j) { const float v = bf2f(zr[C_CQ + lane + 64 * j]); sq += v * v; }
#pragma unroll
        for (int j = 0; j < 2; ++j) { const float v = bf2f(zr[C_CKV + lane + 64 * j]); skv += v * v; }
        const float rq = rsqrtf(wave_sum(sq) * (1.f / 256.f) + EPS), rkv = rsqrtf(wave_sum(skv) * (1.f / 128.f) + EPS);
        const float posf = (float)p.pos[m];
        float cs = 1.f, sn = 0.f;
        { const float inv = exp2f(-(float)(lane & 15) * (13.287712379549449f / 16.f)); sincosf(posf * inv, &sn, &cs); }
        const bf16_t* qr = QKVR + (size_t)m * 1024; const bf16_t* kvr = qr + 512;
#pragma unroll
        for (int j = 0; j < 6; ++j) {
            const int idx = lane + 64 * j, h = idx / 96, d = idx % 96;
            float q, k;
            const int i = (d - 64) & 15, hf = (d - 64) >> 4;
            const float c = __shfl(cs, i), s = __shfl(sn, i);
            if (d < 64) { q = bf2f(qr[h * 96 + d]); k = bf2f(kvr[h * 128 + d]) * rkv; }
            else {
                const float q1 = bf2f(qr[h * 96 + 64 + i]), q2 = bf2f(qr[h * 96 + 80 + i]);
                const float k1 = bf2f(zr[C_KR + i]), k2 = bf2f(zr[C_KR + 16 + i]);
                q = hf == 0 ? q1 * c - q2 * s : q2 * c + q1 * s;
                k = hf == 0 ? k1 * c - k2 * s : k2 * c + k1 * s;
            }
            Qm[(size_t)m * 384 + idx] = (bf16_t)f2bf(q * rq * C2_M);
            Km[(size_t)m * 384 + idx] = (bf16_t)f2bf(k);
        }
#pragma unroll
        for (int j = 0; j < 4; ++j) { const int idx = lane + 64 * j, h = idx >> 6, d = idx & 63; Vm[(size_t)m * 256 + idx] = (bf16_t)f2bf(bf2f(kvr[h * 128 + 64 + d]) * rkv); }
        { const f32x4 c4 = *(const f32x4*)(CFp + (size_t)m * 4);
#pragma unroll
          for (int j = 0; j < 5; ++j) {
            const int idx = lane + 64 * j, h = idx / 80, d = idx % 80;
            const float bias = -c4[h] * LOG2E; const unsigned bh_ = f2bf(bias); const unsigned bl_ = f2bf(bias - bf2f(bh_));
            unsigned qv, kv;
            if (d < 64) { qv = zr[C_FXQ + h * 64 + d]; kv = zr[C_FXK + h * 64 + d]; }
            else { qv = d < 66 ? 0x3f80u : 0u; kv = d == 64 ? bh_ : (d == 65 ? bl_ : 0u); }
            QF[(size_t)m * 320 + idx] = (bf16_t)qv; KF[(size_t)m * 320 + idx] = (bf16_t)kv;
          } }
    }
    if (bid_() == 0 && tid == 0) *(unsigned*)(p.ws + WS_CTL + CTL_QUEUE) = 0u;
    __syncthreads();
    float* hs = lds;
    float* ys = lds + 62 * 256;
    bf16_t* YS = (bf16_t*)(p.ws + WS_D);
    const float* cw = p.conv_w + (size_t)l * 31 * 256; const float* cb = p.conv_b + l * 256; const float* lg = p.conv_g + l * 256; const float* lb = p.conv_bb + l * 256;
    for (int ch = bid_(); ch < T / 32; ch += nblk_()) {
        const int m0 = ch * 32, t0 = m0 & (SEQ - 1);
        for (int idx = tid; idx < 62 * 256; idx += NTHREADS) {
            const int r = idx >> 8, c = idx & 255, tt = t0 - 30 + r; float v = 0.f;
            if (tt >= 0) { const bf16_t* zr = ZS + (size_t)(m0 - 30 + r) * ZSW; v = bf2f(zr[C_CVA + c]) * sigmoidf_(bf2f(zr[C_CVG + c])); }
            hs[idx] = v;
        }
        __syncthreads();
        { const int c = tid & 255, half = tid >> 8; float w[31];
#pragma unroll
            for (int i = 0; i < 31; ++i) w[i] = cw[i * 256 + c];
            const float bias = cb[c];
            for (int i = half * 16; i < half * 16 + 16; ++i) { float a = bias;
#pragma unroll
                for (int k = 0; k < 31; ++k) a += hs[(i + k) * 256 + c] * w[k];
                ys[i * 256 + c] = a; } }
        __syncthreads();
#pragma unroll
        for (int q = 0; q < 4; ++q) {
            const int i = wave * 4 + q; const f32x4 v = *(const f32x4*)(ys + i * 256 + lane * 4);
            const float mean = wave_sum((v.x + v.y) + (v.z + v.w)) * (1.f / 256.f);
            const f32x4 dv = v - mean; const float var = wave_sum((dv.x * dv.x + dv.y * dv.y) + (dv.z * dv.z + dv.w * dv.w)) * (1.f / 256.f);
            const float rstd = rsqrtf(var + EPS);
            const f32x4 g = *(const f32x4*)(lg + lane * 4), bb = *(const f32x4*)(lb + lane * 4);
            f32x4 y = dv * rstd * g + bb;
            y.x = y.x * sigmoidf_(y.x); y.y = y.y * sigmoidf_(y.y); y.z = y.z * sigmoidf_(y.z); y.w = y.w * sigmoidf_(y.w);
            u32x2 o; o.x = pk2(y.x, y.y); o.y = pk2(y.z, y.w);
            *(u32x2*)(YS + (size_t)(m0 + i) * 1024 + 512 + lane * 4) = o;
        }
        __syncthreads();
    }
}

template <int MODE, int DQ>
__device__ __forceinline__ void attn_naive(const bf16_t* Q, int qp, const bf16_t* K, int kp, const bf16_t* V, int vp, const float* CF, bf16_t* Y, float* lds) {
    const int tid = tid_(), lane = tid & 63, wave = tid >> 6;
    const int gw = bid_() * NWAVES + wave, NGW = nblk_() * NWAVES;
    float* qs = lds + wave * 128;
    for (int row = gw; row < T * 4; row += NGW) {
        const int m = row >> 2, h = row & 3, b = m >> 12, t = m & (SEQ - 1);
        LDS_FENCE();
        for (int d = lane; d < DQ; d += 64) qs[d] = bf2f(Q[(size_t)m * qp + h * DQ + d]);
        LDS_FENCE();
        float acc = 0.f, mx = -INFINITY, l = 0.f, R = 0.f;
        const int last = MODE == 1 ? t - 1 : t;
        const int nch = last < 0 ? 0 : (last >> 6) + 1;
        for (int ci = 0; ci < nch; ++ci) {
            const int j0 = (MODE == 1 ? (nch - 1 - ci) : ci) * 64, j = j0 + lane;
            const bool valid = j <= last;
            const int jc = valid ? j : last;
            const bf16_t* kr = K + ((size_t)b * SEQ + jc) * kp + h * DQ;
            float s = 0.f;
#pragma unroll
            for (int c = 0; c < DQ / 8; ++c) { const u32x4 kv = *(const u32x4*)(kr + c * 8);
#pragma unroll
                for (int i = 0; i < 4; ++i) s += qs[c * 8 + 2 * i] * bf2f(kv[i] & 0xffffu) + qs[c * 8 + 2 * i + 1] * bf2f(kv[i] >> 16); }
            float pj;
            if (MODE == 1) {
                float L2 = valid ? -(fmaxf(s, 0.f) + log2f(1.f + exp2f(-fabsf(s)))) : 0.f;
                float suf = L2;
#pragma unroll
                for (int o = 1; o < 64; o <<= 1) { const float y = __shfl_down(suf, o); if (lane + o < 64) suf += y; }
                const float after = R + (suf - L2);
                pj = valid ? exp2f(s + L2 + after) : 0.f;
                R += __shfl(suf, 0);
            } else {
                if (MODE == 2) s -= CF[((size_t)b * SEQ + jc) * 4 + h] * LOG2E;
                if (!valid) s = -INFINITY;
                const float mn = fmaxf(mx, wave_max(s));
                const float f = exp2f(mx - mn);
                pj = exp2f(s - mn);
                l = l * f + wave_sum(pj); acc *= f; mx = mn;
            }
            const bf16_t* vb = V + ((size_t)b * SEQ + j0) * vp + h * 64 + lane;
            const int nv = last - j0 + 1 < 64 ? last - j0 + 1 : 64;
            for (int jj = 0; jj < nv; ++jj) acc += __shfl(pj, jj) * bf2f(vb[(size_t)jj * vp]);
        }
        if (MODE != 1) acc = nch ? acc / l : 0.f;
        Y[(size_t)m * 1024 + h * 64 + lane] = (bf16_t)f2bf(acc);
    }
}
__device__ __forceinline__ void phase_attn(CParams& p, float* lds) {
    const bf16_t* ZS = (const bf16_t*)(p.ws + WS_R1 + R1_ZS); bf16_t* YS = (bf16_t*)(p.ws + WS_D);
    const bf16_t* Qm = (const bf16_t*)(p.ws + WS_C + C_QM); const bf16_t* Km = (const bf16_t*)(p.ws + WS_C + C_KM); const bf16_t* Vm = (const bf16_t*)(p.ws + WS_C + C_VM);
    const float* CF = (const float*)(p.ws + WS_ROUTE + RT_CF);
    attn_naive<0, 96>(Qm, 384, Km, 384, Vm, 256, nullptr, YS, lds);
    attn_naive<1, 64>(ZS + C_SBQ, ZSW, ZS + C_SBK, ZSW, ZS + C_SBV, ZSW, nullptr, YS + 256, lds);
    attn_naive<2, 64>(ZS + C_FXQ, ZSW, ZS + C_FXK, ZSW, ZS + C_FXV, ZSW, CF, YS + 768, lds);
}

__device__ __forceinline__ void phase_pgemm(CParams& p, float* lds) {
    const bf16_t* YS = (const bf16_t*)(p.ws + WS_D); const bf16_t* Bt = (const bf16_t*)(p.ws + WS_W + W_BR); bf16_t* PB = (bf16_t*)(p.ws + WS_R1 + R1_PB);
    ngemm(T, 4096, 256, 1024, 256, [=](int m0, int n0) { return YS + (size_t)m0 * 1024 + (n0 >> 10) * 256; }, [=](int, int n0) { return Bt + (size_t)n0 * 256; },
          [=](int m, int n, float v) { PB[(size_t)m * 4096 + n] = (bf16_t)f2bf(v); }, lds);
}
__device__ __forceinline__ void phase_gate(CParams& p, int l, float* lds) {
    const bf16_t* XB = (const bf16_t*)(p.ws + WS_XB); const bf16_t* Bt = (const bf16_t*)(p.ws + WS_W + W_GATE); bf16_t* PB = (bf16_t*)(p.ws + WS_R1 + R1_PB);
    const float* bg = p.b_gate + (size_t)l * 4096;
    ngemm(T, 4096, 1024, 1024, 1024, [=](int m0, int) { return XB + (size_t)m0 * 1024; }, [=](int, int n0) { return Bt + (size_t)n0 * 1024; },
          [=](int m, int n, float v) { const size_t i = (size_t)m * 4096 + n; PB[i] = (bf16_t)f2bf(sigmoidf_(v + bg[n]) * bf2f(PB[i])); }, lds);
}
__device__ __forceinline__ void phase_combine(CParams& p) {
    const bf16_t* PB = (const bf16_t*)(p.ws + WS_R1 + R1_PB); bf16_t* MG = (bf16_t*)(p.ws + WS_C);
    for (size_t i = (size_t)bid_() * NTHREADS + tid_(); i < (size_t)T * 1024; i += (size_t)nblk_() * NTHREADS) {
        const size_t m = i >> 10, d = i & 1023; const bf16_t* r = PB + m * 4096 + d;
        MG[i] = (bf16_t)f2bf((bf2f(r[0]) + bf2f(r[1024])) + (bf2f(r[2048]) + bf2f(r[3072])));
    }
}
__device__ __forceinline__ void phase_wo(CParams& p, int l, float* lds) {
    const bf16_t* MG = (const bf16_t*)(p.ws + WS_C); const bf16_t* Bt = (const bf16_t*)(p.ws + WS_W + W_O);
    const float* xf = l == 0 ? p.x : p.out; float* out = p.out;
    ngemm(T, 1024, 1024, 1024, 1024, [=](int m0, int) { return MG + (size_t)m0 * 1024; }, [=](int, int n0) { return Bt + (size_t)n0 * 1024; },
          [=](int m, int n, float v) { const size_t i = (size_t)m * 1024 + n; out[i] = ALPHA * xf[i] + v; }, lds);
}

__device__ __forceinline__ void ln_row(f32x4 (&v)[4], const float* g, const float* b, int lane) {
    float s = 0.f;
#pragma unroll
    for (int j = 0; j < 4; ++j) s += (v[j].x + v[j].y) + (v[j].z + v[j].w);
    const float mean = wave_sum(s) * (1.f / 1024.f); float s2 = 0.f;
#pragma unroll
    for (int j = 0; j < 4; ++j) { v[j] = v[j] - mean; s2 += (v[j].x * v[j].x + v[j].y * v[j].y) + (v[j].z * v[j].z + v[j].w * v[j].w); }
    const float rstd = rsqrtf(wave_sum(s2) * (1.f / 1024.f) + EPS);
#pragma unroll
    for (int j = 0; j < 4; ++j) { const f32x4 gg = *(const f32x4*)(g + 256 * j + 4 * lane), bb = *(const f32x4*)(b + 256 * j + 4 * lane); v[j] = v[j] * rstd * gg + bb; }
}

__device__ __forceinline__ void phase_ln1route(CParams& p, int l, float* lds) {
    const int tid = tid_(), lane = tid & 63, wave = tid >> 6;
    int* cnt = (int*)lds; float* sl = lds + 64 + wave * 64; float* hrow = lds + 1024 + wave * 1024;
    int* tok_e = (int*)(p.ws + WS_ROUTE + RT_TOKE); float* tok_w = (float*)(p.ws + WS_ROUTE + RT_TOKW); int* tok_p = (int*)(p.ws + WS_ROUTE + RT_TOKP);
    int* hist = (int*)(p.ws + WS_CTL); bf16_t* HB = (bf16_t*)(p.ws + WS_C);
    const float* wrg = p.w_rg + (size_t)l * 1024 * 4; const float* wre = p.w_re + (size_t)l * 1024 * 32;
    for (int tb = bid_(); tb < 256; tb += nblk_()) {
        if (tid < 32) cnt[tid] = 0;
        __syncthreads();
        for (int q = 0; q < 8; ++q) {
            const int m = tb * 64 + wave * 8 + q;
            f32x4* orow = (f32x4*)(p.out + (size_t)m * D) + lane; f32x4 v[4];
#pragma unroll
            for (int j = 0; j < 4; ++j) v[j] = orow[64 * j];
            ln_row(v, p.ln1_g + l * D, p.ln1_b + l * D, lane);
            u32x2* hb = (u32x2*)(HB + (size_t)m * D) + lane;
#pragma unroll
            for (int j = 0; j < 4; ++j) { orow[64 * j] = v[j]; u32x2 w; w.x = pk2(v[j].x, v[j].y); w.y = pk2(v[j].z, v[j].w); hb[64 * j] = w; }
            float ag[4] = {0.f, 0.f, 0.f, 0.f}; float ae[32];
#pragma unroll
            for (int i = 0; i < 32; ++i) ae[i] = 0.f;
#pragma unroll
            for (int j = 0; j < 4; ++j) *(f32x4*)(hrow + 256 * j + 4 * lane) = v[j];
            LDS_FENCE();
#pragma unroll 2
            for (int kk = 0; kk < 16; ++kk) {
                const int k = kk * 64 + lane; const float hv = hrow[k];
                const f32x4 g4 = *(const f32x4*)(wrg + (size_t)k * 4);
                ag[0] += hv * g4.x; ag[1] += hv * g4.y; ag[2] += hv * g4.z; ag[3] += hv * g4.w;
#pragma unroll
                for (int e4 = 0; e4 < 8; ++e4) { const f32x4 w4 = *(const f32x4*)(wre + (size_t)k * 32 + e4 * 4);
                    ae[e4 * 4 + 0] += hv * w4.x; ae[e4 * 4 + 1] += hv * w4.y; ae[e4 * 4 + 2] += hv * w4.z; ae[e4 * 4 + 3] += hv * w4.w; }
            }
#pragma unroll
            for (int i = 0; i < 4; ++i) { const float r = wave_sum(ag[i]); if (lane == 0) sl[i] = r + p.b_rg[l * 4 + i]; }
#pragma unroll
            for (int i = 0; i < 32; ++i) { const float r = wave_sum(ae[i]); if (lane == 0) sl[4 + i] = r + p.b_re[l * 32 + i]; }
            LDS_FENCE();
            if (lane == 0) {
                int g = 0; float gm = sl[0];
                for (int i = 1; i < 4; ++i) if (sl[i] > gm) { gm = sl[i]; g = i; }
                float gs = 0.f; for (int i = 0; i < 4; ++i) gs += expf(sl[i] - gm);
                const float grp_p = 1.f / gs;
                const float* le = sl + 4 + g * 8;
                int i0 = 0; float m0 = le[0];
                for (int i = 1; i < 8; ++i) if (le[i] > m0) { m0 = le[i]; i0 = i; }
                int i1 = -1; float m1 = -INFINITY;
                for (int i = 0; i < 8; ++i) if (i != i0 && le[i] > m1) { m1 = le[i]; i1 = i; }
                const float e1 = expf(m1 - m0), den = 1.f + e1;
                const int x0 = g * 8 + i0, x1 = g * 8 + i1;
                tok_e[m * 2] = x0; tok_e[m * 2 + 1] = x1;
                tok_w[m * 2] = grp_p / den; tok_w[m * 2 + 1] = grp_p * e1 / den;
                tok_p[m * 2] = atomicAdd(&cnt[x0], 1); tok_p[m * 2 + 1] = atomicAdd(&cnt[x1], 1);
            }
            LDS_FENCE();
        }
        __syncthreads();
        if (tid < 32) hist[tb * 32 + tid] = cnt[tid];
        __syncthreads();
    }
}

__device__ __forceinline__ void phase_gather(CParams& p, float* lds) {
    const int tid = tid_(), lane = tid & 63, wave = tid >> 6;
    int* Li = (int*)lds;
    const int* tok_e = (const int*)(p.ws + WS_ROUTE + RT_TOKE); const float* tok_w = (const float*)(p.ws + WS_ROUTE + RT_TOKW); const int* tok_p = (const int*)(p.ws + WS_ROUTE + RT_TOKP);
    int* tok_s = (int*)(p.ws + WS_ROUTE + RT_TOKS); float* slot_w = (float*)(p.ws + WS_ROUTE + RT_SLOTW);
    const bf16_t* HB = (const bf16_t*)(p.ws + WS_C); bf16_t* XG = (bf16_t*)(p.ws + WS_R1 + R1_XG);
    for (int tb = bid_(); tb < 256; tb += nblk_()) {
        expert_offsets(p, tb, Li);
        for (int q = 0; q < 16; ++q) {
            const int a = tb * 128 + wave * 16 + q, m = a >> 1;
            const int e = tok_e[a]; const int slot = Li[32 + e] + Li[65 + e] + tok_p[a];
            const u32x4* src = (const u32x4*)(HB + (size_t)m * D) + lane; u32x4* dst = (u32x4*)(XG + (size_t)slot * D) + lane;
            dst[0] = src[0]; dst[64] = src[64];
            if (lane == 0) { tok_s[a] = slot; slot_w[slot] = tok_w[a]; }
        }
        __syncthreads();
    }
}
__device__ __forceinline__ void phase_moeup(CParams& p, float* lds) {
    int* Li = (int*)(lds + 16384);
    expert_offsets(p, 0, Li);
    const bf16_t* XG = (const bf16_t*)(p.ws + WS_R1 + R1_XG); const bf16_t* Bt = (const bf16_t*)(p.ws + WS_W + W_GU); bf16_t* GU = (bf16_t*)(p.ws + WS_C);
    ngemm(Li[64], 512, 1024, 1024, 1024, [=](int m0, int) { return XG + (size_t)m0 * 1024; }, [=](int m0, int n0) { return Bt + ((size_t)tile_expert(Li, m0) * 512 + n0) * 1024; },
          [=](int m, int n, float v) { GU[(size_t)m * 512 + n] = (bf16_t)f2bf(v); }, lds);
}
__device__ __forceinline__ void phase_swiglu(CParams& p, float* lds) {
    int* Li = (int*)(lds + 16384);
    expert_offsets(p, 0, Li);
    const size_t n = (size_t)Li[64] * 256;
    const bf16_t* GU = (const bf16_t*)(p.ws + WS_C); bf16_t* HID = (bf16_t*)(p.ws + WS_R1 + R1_HID);
    for (size_t i = (size_t)bid_() * NTHREADS + tid_(); i < n; i += (size_t)nblk_() * NTHREADS) {
        const size_t s = i >> 8; const int f = (int)(i & 255), j = f >> 7, rr = f & 127;
        const float g = bf2f(GU[s * 512 + j * 256 + rr]), u = bf2f(GU[s * 512 + j * 256 + 128 + rr]);
        HID[i] = (bf16_t)f2bf(g * sigmoidf_(g) * u);
    }
    __syncthreads();
}
__device__ __forceinline__ void phase_moedown(CParams& p, float* lds) {
    int* Li = (int*)(lds + 16384);
    expert_offsets(p, 0, Li);
    const bf16_t* HID = (const bf16_t*)(p.ws + WS_R1 + R1_HID); const bf16_t* Bt = (const bf16_t*)(p.ws + WS_W + W_D); bf16_t* YSL = (bf16_t*)(p.ws + WS_R1 + R1_YSL);
    ngemm(Li[64], 1024, 256, 256, 256, [=](int m0, int) { return HID + (size_t)m0 * 256; }, [=](int m0, int n0) { return Bt + ((size_t)tile_expert(Li, m0) * 1024 + n0) * 256; },
          [=](int m, int n, float v) { YSL[(size_t)m * 1024 + n] = (bf16_t)f2bf(v); }, lds);
}
__device__ __forceinline__ void phase_ln2(CParams& p, int l) {
    const int tid = tid_(), lane = tid & 63, wave = tid >> 6;
    const int gw = bid_() * NWAVES + wave, NGW = nblk_() * NWAVES;
    const int* tok_s = (const int*)(p.ws + WS_ROUTE + RT_TOKS); const bf16_t* YSL = (const bf16_t*)(p.ws + WS_R1 + R1_YSL); const float* tok_w = (const float*)(p.ws + WS_ROUTE + RT_TOKW);
    for (int m = gw; m < T; m += NGW) {
        f32x4* orow = (f32x4*)(p.out + (size_t)m * D) + lane; f32x4 v[4];
        const u32x2* y0 = (const u32x2*)(YSL + (size_t)tok_s[m * 2] * D) + lane; const u32x2* y1 = (const u32x2*)(YSL + (size_t)tok_s[m * 2 + 1] * D) + lane;
        const float w0 = tok_w[m * 2], w1 = tok_w[m * 2 + 1];
#pragma unroll
        for (int j = 0; j < 4; ++j) {
            const u32x2 a = y0[64 * j], b = y1[64 * j]; const f32x4 hv = orow[64 * j];
            v[j].x = ALPHA * hv.x + (w0 * bf2f(a.x & 0xffffu) + w1 * bf2f(b.x & 0xffffu)); v[j].y = ALPHA * hv.y + (w0 * bf2f(a.x >> 16) + w1 * bf2f(b.x >> 16));
            v[j].z = ALPHA * hv.z + (w0 * bf2f(a.y & 0xffffu) + w1 * bf2f(b.y & 0xffffu)); v[j].w = ALPHA * hv.w + (w0 * bf2f(a.y >> 16) + w1 * bf2f(b.y >> 16));
        }
        ln_row(v, p.ln2_g + l * D, p.ln2_b + l * D, lane);
#pragma unroll
        for (int j = 0; j < 4; ++j) orow[64 * j] = v[j];
        if (l == 0) emit_xrow(p, v, m, 1, lane);
    }
}


namespace att {
typedef short bf16x8 __attribute__((ext_vector_type(8)));
typedef short s16x4 __attribute__((ext_vector_type(4)));
typedef float f32x16 __attribute__((ext_vector_type(16)));
#define ALAS __attribute__((address_space(3)))
typedef ALAS unsigned char* lp_t;
constexpr float THR = 6.f;
__device__ __forceinline__ int crow(int r, int hi) { return (r & 3) + 8 * (r >> 2) + 4 * hi; }
__device__ __forceinline__ s16x4 vtr(lp_t p) { return __builtin_bit_cast(s16x4, __builtin_amdgcn_ds_read_tr16_b64_v4i16((ALAS s16x4*)p)); }
__device__ __forceinline__ bf16x8 pack8(const f32x16& p, int b) {
    u32x4 w; w.x = pg8::cvt_pk_bf16(p[b], p[b + 1]); w.y = pg8::cvt_pk_bf16(p[b + 2], p[b + 3]); w.z = pg8::cvt_pk_bf16(p[b + 4], p[b + 5]); w.w = pg8::cvt_pk_bf16(p[b + 6], p[b + 7]);
    return __builtin_bit_cast(bf16x8, w);
}
template <int MODE, int DQK>
__device__ __forceinline__ void attn_unit(const bf16_t* Q, int QP, const bf16_t* K, int KP, const bf16_t* V, int VP, const float* CF, bf16_t* Y, int b, int h, int qb, lp_t lds) {
    constexpr int ND = DQK / 16, NCH = DQK / 8, KSZ = NCH * 1024, VOFF = 2 * KSZ, WOFF = VOFF + 16384;
    const int tid = tid_(), lane = tid & 63, r32 = lane & 31, hi = lane >> 5, wid = __builtin_amdgcn_readfirstlane(tid >> 6);
    const int q0 = qb * 256; const long rowbase = (long)b * SEQ;
    const int qw0 = q0 + wid * 32, qrow = qw0 + r32;
    bf16x8 qf[ND];
    { const bf16_t* qp = Q + (size_t)(rowbase + qrow) * QP + h * DQK + hi * 8;
#pragma unroll
      for (int d0 = 0; d0 < ND; ++d0) qf[d0] = *(const bf16x8*)(qp + d0 * 16); }
    const int NT = (q0 + 256) / 64;
    float ct2 = 0.f; if (MODE == 2) ct2 = CF[(size_t)(rowbase + qrow) * 4 + h] * LOG2E;
    f32x16 o0, o1;
#pragma unroll
    for (int r = 0; r < 16; ++r) { o0[r] = 0.f; o1[r] = 0.f; }
    float mhat = 0.f, lsum = 0.f, R = 0.f;
    ALAS float* wsf = (ALAS float*)(lds + WOFF) + wid * 64;
    const bf16_t* kg = K + (size_t)(rowbase + lane) * KP + h * DQK;
    const bf16_t* vg = V + (size_t)(rowbase + 16 * (wid & 3) + (lane >> 2)) * VP + h * 64 + (wid >> 2) * 32 + (lane & 3) * 8;
#define ATT_DMA(tt, buf) do { \
        for (int c_ = wid; c_ < NCH; c_ += 8) __builtin_amdgcn_global_load_lds((const unsigned*)(kg + (size_t)(tt) * 64 * KP + c_ * 8), (ALAS unsigned*)(lds + (buf) * KSZ + c_ * 1024), 16, 0, 0); \
        __builtin_amdgcn_global_load_lds((const unsigned*)(vg + (size_t)(tt) * 64 * VP), (ALAS unsigned*)(lds + VOFF + (buf) * 8192 + wid * 1024), 16, 0, 0); } while (0)
    ATT_DMA(MODE == 1 ? NT - 1 : 0, 0);
    asm volatile("s_waitcnt vmcnt(0)" ::: "memory"); __syncthreads();
#pragma unroll 1
    for (int t = 0; t < NT; ++t) {
        const int tt = MODE == 1 ? NT - 1 - t : t, buf = t & 1;
        if (t + 1 < NT) ATT_DMA(MODE == 1 ? tt - 1 : tt + 1, buf ^ 1);
        const int k0 = 64 * tt;
        const bool active = MODE == 1 ? (k0 < qw0 + 31) : (k0 <= qw0 + 31);
        if (active) {
            const lp_t kb = lds + buf * KSZ + hi * 1024 + r32 * 16;
            f32x16 p0, p1;
            { const float base = MODE == 1 ? 0.f : ct2 - mhat;
#pragma unroll
              for (int r = 0; r < 16; ++r) { p0[r] = base; p1[r] = base; } }
#pragma unroll
            for (int d0 = 0; d0 < ND; ++d0) {
                const bf16x8 b0 = *(const ALAS bf16x8*)(kb + d0 * 2048), b1 = *(const ALAS bf16x8*)(kb + d0 * 2048 + 512);
                p0 = __builtin_amdgcn_mfma_f32_32x32x16_bf16(b0, qf[d0], p0, 0, 0, 0); p1 = __builtin_amdgcn_mfma_f32_32x32x16_bf16(b1, qf[d0], p1, 0, 0, 0);
            }
            const bool band = MODE == 1 ? (k0 + 63 >= qw0) : (k0 + 63 > qw0);
            if (MODE != 1) {
                if (band) {
#pragma unroll
                    for (int r = 0; r < 16; ++r) { const int kv = k0 + crow(r, hi); if (kv > qrow) p0[r] = -INFINITY; if (kv + 32 > qrow) p1[r] = -INFINITY; }
                }
                float rm = fmaxf(p0[0], p1[0]);
#pragma unroll
                for (int r = 1; r < 16; ++r) rm = fmaxf(rm, fmaxf(p0[r], p1[r]));
                rm = fmaxf(rm, __shfl_xor(rm, 32));
                const bool first = (t == 0);
                if (first || __any(rm > THR)) {
                    const float dl = first ? rm : fmaxf(rm, 0.f); const float f = first ? 1.f : __builtin_amdgcn_exp2f(-dl);
                    mhat += dl; lsum *= f;
#pragma unroll
                    for (int r = 0; r < 16; ++r) { p0[r] -= dl; p1[r] -= dl; }
                    if (!first) {
                        if (hi == 0) wsf[r32] = f;
                        asm volatile("s_waitcnt lgkmcnt(0)" ::: "memory");
#pragma unroll
                        for (int r = 0; r < 16; ++r) { const float fr = wsf[crow(r, hi)]; o0[r] *= fr; o1[r] *= fr; }
                        asm volatile("s_waitcnt lgkmcnt(0)" ::: "memory");
                    }
                }
                float sacc = 0.f;
#pragma unroll
                for (int r = 0; r < 16; ++r) { p0[r] = __builtin_amdgcn_exp2f(p0[r]); p1[r] = __builtin_amdgcn_exp2f(p1[r]); sacc += p0[r] + p1[r]; }
                lsum += sacc;
            } else {
                f32x16 L0, L1;
#pragma unroll
                for (int r = 0; r < 16; ++r) {
                    const float z0 = p0[r], z1 = p1[r];
                    L0[r] = -(fmaxf(z0, 0.f) + __builtin_amdgcn_logf(1.f + __builtin_amdgcn_exp2f(-fabsf(z0))));
                    L1[r] = -(fmaxf(z1, 0.f) + __builtin_amdgcn_logf(1.f + __builtin_amdgcn_exp2f(-fabsf(z1))));
                }
                if (band) {
#pragma unroll
                    for (int r = 0; r < 16; ++r) { const int kv = k0 + crow(r, hi); if (kv >= qrow) L0[r] = 0.f; if (kv + 32 >= qrow) L1[r] = 0.f; }
                }
                float G0[4], G1[4], P0[4], P1[4];
#pragma unroll
                for (int g = 0; g < 4; ++g) { G0[g] = (L0[4 * g] + L0[4 * g + 1]) + (L0[4 * g + 2] + L0[4 * g + 3]); G1[g] = (L1[4 * g] + L1[4 * g + 1]) + (L1[4 * g + 2] + L1[4 * g + 3]);
                    P0[g] = __shfl_xor(G0[g], 32); P1[g] = __shfl_xor(G1[g], 32); }
                float run = R;
#pragma unroll
                for (int g = 3; g >= 0; --g) { float s = run + (hi == 0 ? P1[g] : 0.f);
#pragma unroll
                    for (int i = 3; i >= 0; --i) { const float l = L1[4 * g + i]; p1[4 * g + i] = __builtin_amdgcn_exp2f(p1[4 * g + i] + l + s); s += l; }
                    run += G1[g] + P1[g]; }
#pragma unroll
                for (int g = 3; g >= 0; --g) { float s = run + (hi == 0 ? P0[g] : 0.f);
#pragma unroll
                    for (int i = 3; i >= 0; --i) { const float l = L0[4 * g + i]; p0[4 * g + i] = __builtin_amdgcn_exp2f(p0[4 * g + i] + l + s); s += l; }
                    run += G0[g] + P0[g]; }
                R = run;
                if (band) {
#pragma unroll
                    for (int r = 0; r < 16; ++r) { const int kv = k0 + crow(r, hi); if (kv >= qrow) p0[r] = 0.f; if (kv + 32 >= qrow) p1[r] = 0.f; }
                }
            }
            const bf16x8 pa0 = pack8(p0, 0), pa1 = pack8(p0, 8), pa2 = pack8(p1, 0), pa3 = pack8(p1, 8);
            const lp_t vb = lds + VOFF + buf * 8192 + ((lane >> 4) & 1) * 32 + (lane & 3) * 8 + (4 * hi + ((lane & 15) >> 2)) * 64;
#define ATT_PV(o, d0, ks, pa) do { const s16x4 lo_ = vtr(vb + (d0) * 4096 + (ks) * 1024), hi_ = vtr(vb + (d0) * 4096 + (ks) * 1024 + 512); \
                const bf16x8 vf_ = {lo_[0], lo_[1], lo_[2], lo_[3], hi_[0], hi_[1], hi_[2], hi_[3]}; o = __builtin_amdgcn_mfma_f32_32x32x16_bf16(pa, vf_, o, 0, 0, 0); } while (0)
            ATT_PV(o0, 0, 0, pa0); ATT_PV(o1, 1, 0, pa0); ATT_PV(o0, 0, 1, pa1); ATT_PV(o1, 1, 1, pa1);
            ATT_PV(o0, 0, 2, pa2); ATT_PV(o1, 1, 2, pa2); ATT_PV(o0, 0, 3, pa3); ATT_PV(o1, 1, 3, pa3);
#undef ATT_PV
        }
        asm volatile("s_waitcnt vmcnt(0) lgkmcnt(0)" ::: "memory"); __syncthreads();
    }
#undef ATT_DMA
    if (MODE != 1) {
        const float lt = lsum + __shfl_xor(lsum, 32);
        if (hi == 0) wsf[r32] = lt;
        asm volatile("s_waitcnt lgkmcnt(0)" ::: "memory");
#pragma unroll
        for (int r = 0; r < 16; ++r) { const float rl = 1.f / wsf[crow(r, hi)]; o0[r] *= rl; o1[r] *= rl; }
        asm volatile("s_waitcnt lgkmcnt(0)" ::: "memory");
    }
    bf16_t* yb = Y + (size_t)(rowbase + qw0) * 1024 + h * 64 + r32;
#pragma unroll
    for (int r = 0; r < 16; ++r) { bf16_t* yr = yb + (size_t)crow(r, hi) * 1024; yr[0] = (bf16_t)f2bf(o0[r]); yr[32] = (bf16_t)f2bf(o1[r]); }
}
}

typedef PG8_LAS unsigned char* ldsp_t;
constexpr int LI_OFF = 131072 + 1024;

__device__ __forceinline__ void fox_scan(CParams& p, int l, int bh, int lane) {
    const int b = bh >> 2, h = bh & 3; const float* F = (const float*)(p.ws + WS_ROUTE + RT_FXF); float* CF = (float*)(p.ws + WS_ROUTE + RT_CF);
    const float bf = p.b_forget[l * 4 + h];
    float run = 0.f;
    for (int j = 0; j < 64; ++j) run += logsigmoid_(F[((size_t)b * SEQ + lane * 64 + j) * 4 + h] + bf);
    float inc = run;
#pragma unroll
    for (int o = 1; o < 64; o <<= 1) { const float y = __shfl_up(inc, o); if (lane >= o) inc += y; }
    float c = inc - run;
    for (int j = 0; j < 64; ++j) { const size_t idx = ((size_t)b * SEQ + lane * 64 + j) * 4 + h; c += logsigmoid_(F[idx] + bf); CF[idx] = c; }
}
__device__ __forceinline__ void fphase_inproj(CParams& p, int l, ldsp_t lds) {
    pg8::Gemm g{(const bf16_t*)(p.ws + WS_XB), (const bf16_t*)(p.ws + WS_W + W_BT1), T, ZSW, 1024, 1024};
    pg8::StaticOrder S; S.init(T, ZSW, nblk_(), bid_());
    pg8::EpiBf16 E{(bf16_t*)(p.ws + WS_R1 + R1_ZS), ZSW};
    pg8::gemm_phase<pg8::EpiBf16, pg8::StaticOrder, 1024, 1024, true, true>(lds, g, S, E);
    const int tid = tid_(), bb = bid_(), nb = nblk_();
    const int first = nb >= 160 ? 128 : 0;
    for (int bh = bb - first; bh >= 0 && bh < 16; bh += nb) if ((tid >> 6) == 0) fox_scan(p, l, bh, tid & 63);
}
__device__ __forceinline__ void fphase_upproj(CParams& p, ldsp_t lds) {
    pg8::Gemm g{(const bf16_t*)(p.ws + WS_R1 + R1_ZS), (const bf16_t*)(p.ws + WS_W + W_UQ), T, 1024, 256, ZSW};
    pg8::BranchOrder S; S.s.init(T, 1024, nblk_(), bid_()); S.shift = 1;
    pg8::EpiBf16 E{(bf16_t*)(p.ws + WS_R1 + R1_QKVR), 1024};
    pg8::gemm_phase<pg8::EpiBf16, pg8::BranchOrder, 256, ZSW, true, true>(lds, g, S, E);
}
__device__ __forceinline__ void fphase_pgemm(CParams& p, ldsp_t lds) {
    pg8::Gemm g{(const bf16_t*)(p.ws + WS_D), (const bf16_t*)(p.ws + WS_W + W_BR), T, 4096, 256, 1024};
    pg8::BranchOrder S; S.s.init(T, 4096, nblk_(), bid_()); S.shift = 2;
    pg8::EpiBf16 E{(bf16_t*)(p.ws + WS_R1 + R1_PB), 4096};
    pg8::gemm_phase<pg8::EpiBf16, pg8::BranchOrder, 256, 1024, true, true>(lds, g, S, E);
}
__device__ __forceinline__ void fphase_gate(CParams& p, int l, ldsp_t lds) {
    pg8::Gemm g{(const bf16_t*)(p.ws + WS_XB), (const bf16_t*)(p.ws + WS_W + W_GATE), T, 4096, 1024, 1024};
    pg8::StaticOrder S; S.init(T, 4096, nblk_(), bid_());
    pg8::EpiGate E{(const bf16_t*)(p.ws + WS_R1 + R1_PB), (bf16_t*)(p.ws + WS_C), p.b_gate + (size_t)l * 4096};
    pg8::gemm_phase<pg8::EpiGate, pg8::StaticOrder, 1024, 1024, true, true>(lds, g, S, E);
}
__device__ __forceinline__ void fphase_wo(CParams& p, int l, ldsp_t lds) {
    pg8::Gemm g{(const bf16_t*)(p.ws + WS_C), (const bf16_t*)(p.ws + WS_W + W_O), T, 1024, 1024, 1024};
    pg8::StaticOrder S; S.init(T, 1024, nblk_(), bid_());
    pg8::EpiRes E{l == 0 ? p.x : p.out, p.out, ALPHA};
    pg8::gemm_phase<pg8::EpiRes, pg8::StaticOrder, 1024, 1024, true, true>(lds, g, S, E);
}
__device__ __forceinline__ void fphase_moeup(CParams& p, ldsp_t lds, float* ldsf) {
    int* Li = (int*)(ldsf + LI_OFF / 4);
    expert_offsets(p, 0, Li);
    pg8::Gemm g{(const bf16_t*)(p.ws + WS_R1 + R1_XG), (const bf16_t*)(p.ws + WS_W + W_GU), 0, 512, 1024, 1024};
    pg8::MoeOrder S{Li, 2, nblk_(), bid_(), (long)512 * 1024 * 2};
    pg8::EpiSwiglu E{(bf16_t*)(p.ws + WS_R1 + R1_HID)};
    pg8::gemm_phase<pg8::EpiSwiglu, pg8::MoeOrder, 1024, 1024, true, true>(lds, g, S, E);
}
__device__ __forceinline__ void fphase_moedown(CParams& p, ldsp_t lds, float* ldsf) {
    int* Li = (int*)(ldsf + LI_OFF / 4);
    expert_offsets(p, 0, Li);
    pg8::Gemm g{(const bf16_t*)(p.ws + WS_R1 + R1_HID), (const bf16_t*)(p.ws + WS_W + W_D), 0, 1024, 256, 256};
    pg8::MoeOrder S{Li, 4, nblk_(), bid_(), (long)1024 * 256 * 2};
    pg8::EpiBf16 E{(bf16_t*)(p.ws + WS_R1 + R1_YSL), 1024};
    pg8::gemm_phase<pg8::EpiBf16, pg8::MoeOrder, 256, 256, true, true>(lds, g, S, E);
}


__device__ __forceinline__ void fphase_attn(CParams& p, ldsp_t ldsp, float* ldsf) {
    const int tid = tid_();
    const bf16_t* ZS = (const bf16_t*)(p.ws + WS_R1 + R1_ZS); bf16_t* YS = (bf16_t*)(p.ws + WS_D);
    const bf16_t* Qm = (const bf16_t*)(p.ws + WS_C + C_QM); const bf16_t* Km = (const bf16_t*)(p.ws + WS_C + C_KM); const bf16_t* Vm = (const bf16_t*)(p.ws + WS_C + C_VM);
    const bf16_t* QF = (const bf16_t*)(p.ws + WS_E + E_QF); const bf16_t* KF = (const bf16_t*)(p.ws + WS_E + E_KF);
    const float* CF = (const float*)(p.ws + WS_ROUTE + RT_CF);
    unsigned* ctr = (unsigned*)(p.ws + WS_CTL + CTL_QUEUE);
    volatile int* su = (volatile int*)(ldsf + 131072 / 4);
    for (;;) {
        __syncthreads();
        if (tid == 0) su[0] = (int)atomicAdd(ctr, 1u);
        __syncthreads();
        const int k = su[0];
        if (k >= 768) break;
        const int cls = k >> 4, bh = k & 15, qb = 15 - cls / 3, v = cls % 3, b = bh >> 2, h = bh & 3;
        if (v == 0) { if constexpr ((FAST & F_ASB) != 0) att::attn_unit<1, 64>(ZS + C_SBQ, ZSW, ZS + C_SBK, ZSW, ZS + C_SBV, ZSW, nullptr, YS + 256, b, h, qb, ldsp); }
        else if (v == 1) { if constexpr ((FAST & F_AMLA) != 0) att::attn_unit<0, 96>(Qm, 384, Km, 384, Vm, 256, nullptr, YS, b, h, qb, ldsp); }
        else { if constexpr ((FAST & F_AFOX) != 0) att::attn_unit<2, 80>(QF, 320, KF, 320, ZS + C_FXV, ZSW, CF, YS + 768, b, h, qb, ldsp); }
    }
    __syncthreads();
    if constexpr ((FAST & F_AMLA) == 0) attn_naive<0, 96>(Qm, 384, Km, 384, Vm, 256, nullptr, YS, ldsf);
    if constexpr ((FAST & F_ASB) == 0) attn_naive<1, 64>(ZS + C_SBQ, ZSW, ZS + C_SBK, ZSW, ZS + C_SBV, ZSW, nullptr, YS + 256, ldsf);
    if constexpr ((FAST & F_AFOX) == 0) attn_naive<2, 64>(ZS + C_FXQ, ZSW, ZS + C_FXK, ZSW, ZS + C_FXV, ZSW, CF, YS + 768, ldsf);
}

enum { PH_CONVW = 0, PH_INPROJ, PH_UPPROJ, PH_PREP, PH_ATTN, PH_PGEMM, PH_GATE, PH_COMBINE, PH_WO, PH_LN1, PH_GATHER, PH_MOEUP, PH_SWIGLU, PH_MOEDOWN, PH_LN2, PH_N };
__device__ __forceinline__ void run_phase(CParams& p, int ph, int l, float* lds, ldsp_t ldsp) {
    switch (ph) {
        case PH_CONVW: phase_convw(p, l, lds); if (l == 0) phase_convx(p); break;
        case PH_INPROJ: if constexpr ((FAST & F_INPROJ) != 0) fphase_inproj(p, l, ldsp); else phase_inproj(p, lds); break;
        case PH_UPPROJ:
            if constexpr ((FAST & F_INPROJ) == 0) { const int tid = tid_(); for (int bh = bid_(); bh < 16; bh += nblk_()) if ((tid >> 6) == 0) fox_scan(p, l, bh, tid & 63); }
            if constexpr ((FAST & F_UPPROJ) != 0) fphase_upproj(p, ldsp); else phase_upproj(p, l, lds); break;
        case PH_PREP: phase_prep(p, l, lds); break;
        case PH_ATTN: if constexpr ((FAST & (F_AMLA | F_ASB | F_AFOX)) != 0) fphase_attn(p, ldsp, lds); else phase_attn(p, lds); break;
        case PH_PGEMM: if constexpr ((FAST & F_PGEMM) != 0) fphase_pgemm(p, ldsp); else phase_pgemm(p, lds); break;
        case PH_GATE: if constexpr ((FAST & F_GATE) != 0) fphase_gate(p, l, ldsp); else phase_gate(p, l, lds); break;
        case PH_COMBINE: if constexpr ((FAST & F_GATE) == 0) phase_combine(p); break;
        case PH_WO: if constexpr ((FAST & F_WO) != 0) fphase_wo(p, l, ldsp); else phase_wo(p, l, lds); break;
        case PH_LN1: phase_ln1route(p, l, lds); break;
        case PH_GATHER: phase_gather(p, lds); break;
        case PH_MOEUP: if constexpr ((FAST & F_MOEUP) != 0) fphase_moeup(p, ldsp, lds); else phase_moeup(p, lds); break;
        case PH_SWIGLU: if constexpr ((FAST & F_MOEUP) == 0) phase_swiglu(p, lds); break;
        case PH_MOEDOWN: if constexpr ((FAST & F_MOEDOWN) != 0) fphase_moedown(p, ldsp, lds); else phase_moedown(p, lds); break;
        case PH_LN2: phase_ln2(p, l); break;
    }
}
__global__ void __launch_bounds__(NTHREADS, 2) mega(Params p) {
    extern __shared__ __attribute__((aligned(16))) unsigned char lds_raw[];
    cg::grid_group grid = cg::this_grid();
#pragma unroll 1
    for (int l = 0; l < 2; ++l) {
#pragma unroll 1
        for (int ph = 0; ph < PH_N; ++ph) {
            if ((ph == PH_COMBINE && (FAST & F_GATE) != 0) || (ph == PH_SWIGLU && (FAST & F_MOEUP) != 0)) continue;
            CParams* pp = (CParams*)__builtin_amdgcn_kernarg_segment_ptr();
            asm volatile("" : "+s"(pp));
            run_phase(*pp, ph, l, (float*)lds_raw, (ldsp_t)lds_raw);
            if (!(l == 1 && ph == PH_N - 1)) grid.sync();
        }
    }
}

extern "C" void kernel_launch(void* const* d_in, const int* in_sizes, int n_in, void* d_out, int out_size, void* d_ws, size_t ws_size, hipStream_t stream) {
    static int grid = 0;
    if (grid == 0) {
        if (n_in != 26 || out_size != T * D || ws_size < WS_END) { fprintf(stderr, "kernel_launch: unexpected shapes (n_in %d out %d ws %zu, need %zu)\n", n_in, out_size, ws_size, (size_t)WS_END); grid = -1; return; }
        int dev = 0, cus = 0, per_cu = 0;
        (void)hipGetDevice(&dev); (void)hipDeviceGetAttribute(&cus, hipDeviceAttributeMultiprocessorCount, dev);
        (void)hipFuncSetAttribute((const void*)mega, hipFuncAttributeMaxDynamicSharedMemorySize, LDS_BYTES);
        if (hipOccupancyMaxActiveBlocksPerMultiprocessor(&per_cu, (const void*)mega, NTHREADS, LDS_BYTES) != hipSuccess || per_cu < 1) { fprintf(stderr, "kernel_launch: occupancy query says %d\n", per_cu); grid = -1; return; }
        grid = cus;
    }
    if (grid < 0) return;
    Params p{};
    const float** pf = (const float**)&p;
    p.x = (const float*)d_in[0]; p.pos = (const int*)d_in[1];
    for (int i = 2; i < 26; ++i) pf[i] = (const float*)d_in[i];
    p.out = (float*)d_out; p.ws = (unsigned char*)d_ws;
    void* args[] = {&p};
    hipError_t e = hipLaunchCooperativeKernel((const void*)mega, dim3(grid), dim3(NTHREADS), args, LDS_BYTES, stream);
    if (e != hipSuccess) fprintf(stderr, "cooperative launch failed: %s (grid %d)\n", hipGetErrorString(e), grid);
}
```

```cpp
#include <hip/hip_runtime.h>
#include <hip/hip_cooperative_groups.h>
#include <cstdio>
#include <cstdint>
namespace cg = cooperative_groups;

typedef unsigned short bf16_t;
typedef float f32x4 __attribute__((ext_vector_type(4)));
typedef unsigned u32x4 __attribute__((ext_vector_type(4)));
typedef unsigned u32x2 __attribute__((ext_vector_type(2)));

constexpr int NB = 4, SEQ = 4096, T = NB * SEQ, D = 1024, NIN = 6564, ZSW = 2560;
constexpr int NEXP = 32, EFF = 256, MAXSLOT = 40960;
constexpr int C_CQ = 0, C_CKV = 256, C_KR = 384, C_SBQ = 416, C_SBK = 672, C_SBV = 928, C_CVA = 1184, C_CVG = 1440,
              C_FXQ = 1696, C_FXK = 1952, C_FXV = 2208, C_FXF = 2464, C_GATE = 2468;
constexpr float LOG2E = 1.4426950408889634f;
constexpr float C2_64 = 0.125f * LOG2E;
constexpr float C2_M = 0.10206207261596575f * LOG2E;
constexpr float ALPHA = 1.4142135623730951f;
constexpr float EPS = 1e-5f;
constexpr int NTHREADS = 512, NWAVES = 8;
constexpr unsigned F_INPROJ = 1, F_UPPROJ = 2, F_PGEMM = 4, F_GATE = 8, F_WO = 16, F_MOEUP = 32, F_MOEDOWN = 64, F_AMLA = 128, F_ASB = 256, F_AFOX = 512;
#ifndef FAST_MASK
#define FAST_MASK 1023
#endif
constexpr unsigned FAST = FAST_MASK;
constexpr int LDS_BYTES = 147456;

constexpr size_t MiB = 1u << 20;
constexpr size_t WS_CTL = 0;
constexpr size_t WS_ROUTE = 1 * MiB;
constexpr size_t RT_TOKE = 0, RT_TOKW = 131072, RT_TOKP = 262144, RT_TOKS = 393216, RT_SLOTW = 524288, RT_FXF = 786432, RT_CF = 1048576;
constexpr size_t WS_W = 3 * MiB;
constexpr size_t W_BT1 = 0, W_GATE = 5 * MiB, W_UQ = 13 * MiB, W_UKV = W_UQ + 262144, W_BR = W_UKV + 262144, W_O = W_BR + 2 * MiB, W_GU = W_O + 2 * MiB, W_D = W_GU + 32 * MiB;
static_assert(W_D + 16 * MiB <= 66 * MiB, "weights");
constexpr size_t WS_XB = 69 * MiB;
constexpr size_t WS_R1 = 101 * MiB;
constexpr size_t R1_ZS = 0, R1_QKVR = 80 * MiB, R1_PB = 0, R1_XG = 0, R1_HID = 80 * MiB, R1_YSL = 0;
constexpr size_t WS_C = 229 * MiB;
constexpr size_t C_QM = 0, C_KM = 12 * MiB, C_VM = 24 * MiB;
constexpr size_t WS_D = 261 * MiB;
constexpr size_t WS_E = 293 * MiB;
constexpr size_t E_QF = 0, E_KF = 10 * MiB;
constexpr size_t WS_END = 313 * MiB;
constexpr size_t CTL_BAR = 131072, CTL_BAR_BYTES = 16384;
constexpr size_t CTL_QUEUE = 65536;

struct Params {
    const float* x; const int* pos; const float* w_in; const float* b_gate; const float* b_forget;
    const float* q_norm; const float* kv_norm; const float* w_uq; const float* w_ukv;
    const float* conv_w; const float* conv_b; const float* conv_g; const float* conv_bb;
    const float* w_branch; const float* w_o; const float* ln1_g; const float* ln1_b;
    const float* w_rg; const float* b_rg; const float* w_re; const float* b_re;
    const float* w_eg; const float* w_eu; const float* w_ed; const float* ln2_g; const float* ln2_b;
    float* out; unsigned char* ws; int phase; int layer;
};
typedef const __attribute__((address_space(4))) Params CParams;

__device__ __forceinline__ unsigned f2bf(float f) { unsigned u = __float_as_uint(f); return (u + 0x7fffu + ((u >> 16) & 1u)) >> 16; }
__device__ __forceinline__ float bf2f(unsigned b) { return __uint_as_float(b << 16); }
__device__ __forceinline__ unsigned pk2(float lo, float hi) { return f2bf(lo) | (f2bf(hi) << 16); }
__device__ __forceinline__ float wave_sum(float v) {
#pragma unroll
    for (int o = 1; o < 64; o <<= 1) v += __shfl_xor(v, o);
    return v;
}
__device__ __forceinline__ float wave_max(float v) {
#pragma unroll
    for (int o = 1; o < 64; o <<= 1) v = fmaxf(v, __shfl_xor(v, o));
    return v;
}
__device__ __forceinline__ float sigmoidf_(float x) { return 1.f / (1.f + __expf(-x)); }
#define LDS_FENCE() asm volatile("s_waitcnt lgkmcnt(0)" ::: "memory")
__device__ __forceinline__ int tid_() { int t = threadIdx.x; asm volatile("" : "+v"(t)); return t; }
__device__ __forceinline__ int bid_() { int t = blockIdx.x; asm volatile("" : "+s"(t)); return t; }
__device__ __forceinline__ int nblk_() { int t = gridDim.x; asm volatile("" : "+s"(t)); return t; }

template <class F>
__device__ __forceinline__ void tr_item(const float* W, int ldw, bf16_t* out, int Kd, int r0, int k0, const float* ks, F f, float* scr, int lane) {
    const int rl = lane & 31, r = r0 + rl, c = f.col(r); const float s = f.rs(r);
#pragma unroll 8
    for (int i = 0; i < 32; ++i) {
        const int kk = 2 * i + (lane >> 5); float v = 0.f;
        if (c >= 0) { v = W[(size_t)(k0 + kk) * ldw + c] * s; if (ks) v *= ks[k0 + kk]; }
        scr[kk * 33 + rl] = v;
    }
    LDS_FENCE();
    const int cc = lane & 7;
#pragma unroll
    for (int j = 0; j < 4; ++j) {
        const int n = (lane >> 3) + 8 * j; const float* s8 = scr + (8 * cc) * 33 + n;
        u32x4 o; o.x = pk2(s8[0], s8[33]); o.y = pk2(s8[66], s8[99]); o.z = pk2(s8[132], s8[165]); o.w = pk2(s8[198], s8[231]);
        *(u32x4*)(out + (size_t)(r0 + n) * Kd + k0 + 8 * cc) = o;
    }
    LDS_FENCE();
}
struct MapBt1 { __device__ int col(int r) const { return r < C_GATE ? r : -1; } __device__ float rs(int r) const { return ((r >= C_SBQ && r < C_SBK) || (r >= C_FXQ && r < C_FXK)) ? C2_64 : 1.f; } };
struct MapGate { __device__ int col(int r) const { return C_GATE + r; } __device__ float rs(int) const { return 1.f; } };
struct MapGateP { __device__ int col(int r) const { const int pn = r >> 8, cl = r & 255; return C_GATE + (2 * (cl >> 7) + ((cl >> 4) & 1)) * 1024 + pn * 64 + 16 * ((cl >> 5) & 3) + (cl & 15); } __device__ float rs(int) const { return 1.f; } };
struct MapLim { int lim; __device__ int col(int r) const { return r < lim ? r : -1; } __device__ float rs(int) const { return 1.f; } };
struct MapGU { __device__ int col(int r) const { return ((r >> 8) << 7) + (r & 127); } __device__ float rs(int) const { return 1.f; } };

__device__ __forceinline__ void phase_convw(CParams& p, int l, float* lds) {
    const int tid = tid_(), lane = tid & 63, wave = tid >> 6;
    float* scr = lds + wave * (64 * 33);
    unsigned char* W = p.ws + WS_W;
    const int gw = bid_() * NWAVES + wave, NGW = nblk_() * NWAVES;
    constexpr int I_A = 80 * 16, I_B = 128 * 16, I_C = 16 * 4, I_Dd = 16 * 4, I_E = 4 * 128, I_F = 32 * 16, I_G = 32 * 256, I_H = 32 * 128;
    constexpr int NIT = I_A + I_B + I_C + I_Dd + I_E + I_F + I_G + I_H;
    for (int it = gw; it < NIT; it += NGW) {
        int r = it;
        if (r < I_A) { tr_item(p.w_in + (size_t)l * D * NIN, NIN, (bf16_t*)(W + W_BT1), 1024, (r >> 4) * 32, (r & 15) * 64, nullptr, MapBt1{}, scr, lane); continue; } r -= I_A;
        if (r < I_B) { if constexpr ((FAST & F_GATE) != 0) tr_item(p.w_in + (size_t)l * D * NIN, NIN, (bf16_t*)(W + W_GATE), 1024, (r >> 4) * 32, (r & 15) * 64, nullptr, MapGateP{}, scr, lane); else tr_item(p.w_in + (size_t)l * D * NIN, NIN, (bf16_t*)(W + W_GATE), 1024, (r >> 4) * 32, (r & 15) * 64, nullptr, MapGate{}, scr, lane); continue; } r -= I_B;
        if (r < I_C) { tr_item(p.w_uq + (size_t)l * 256 * 384, 384, (bf16_t*)(W + W_UQ), 256, (r >> 2) * 32, (r & 3) * 64, p.q_norm + l * 256, MapLim{384}, scr, lane); continue; } r -= I_C;
        if (r < I_Dd) { const int kb = r & 3; if (kb < 2) tr_item(p.w_ukv + (size_t)l * 128 * 512, 512, (bf16_t*)(W + W_UKV), 256, (r >> 2) * 32, kb * 64, p.kv_norm + l * 128, MapLim{512}, scr, lane);
            else tr_item(p.w_ukv, 512, (bf16_t*)(W + W_UKV), 256, (r >> 2) * 32, kb * 64, nullptr, MapLim{0}, scr, lane); continue; } r -= I_Dd;
        if (r < I_E) { const int n = r >> 7, q = r & 127; tr_item(p.w_branch + ((size_t)l * 4 + n) * 256 * 1024, 1024, (bf16_t*)(W + W_BR) + (size_t)n * 1024 * 256, 256, (q >> 2) * 32, (q & 3) * 64, nullptr, MapLim{1024}, scr, lane); continue; } r -= I_E;
        if (r < I_F) { tr_item(p.w_o + (size_t)l * 1024 * 1024, 1024, (bf16_t*)(W + W_O), 1024, (r >> 4) * 32, (r & 15) * 64, nullptr, MapLim{1024}, scr, lane); continue; } r -= I_F;
        if (r < I_G) { const int e = r >> 8, q = r & 255, rb = q >> 4, kb = q & 15; const int r0 = rb * 32; const bool up = (r0 >> 7) & 1;
            const float* src = (up ? p.w_eu : p.w_eg) + ((size_t)l * NEXP + e) * 1024 * 256;
            tr_item(src, 256, (bf16_t*)(W + W_GU) + (size_t)e * 512 * 1024, 1024, r0, kb * 64, nullptr, MapGU{}, scr, lane); continue; } r -= I_G;
        { const int e = r >> 7, q = r & 127; tr_item(p.w_ed + ((size_t)l * NEXP + e) * 256 * 1024, 1024, (bf16_t*)(W + W_D) + (size_t)e * 1024 * 256, 256, (q >> 2) * 32, (q & 3) * 64, nullptr, MapLim{1024}, scr, lane); }
    }
}

__device__ __forceinline__ void emit_xrow(CParams& p, const f32x4 (&v)[4], int m, int l, int lane) {
    u32x2* o8 = (u32x2*)((bf16_t*)(p.ws + WS_XB) + (size_t)m * D) + lane;
    f32x4 acc = {0.f, 0.f, 0.f, 0.f};
    const float* wf = p.w_in + (size_t)l * D * NIN + C_FXF;
#pragma unroll
    for (int j = 0; j < 4; ++j) {
        u32x2 w; w.x = pk2(v[j].x, v[j].y); w.y = pk2(v[j].z, v[j].w); o8[64 * j] = w;
        const int k = 256 * j + 4 * lane;
        acc += v[j].x * *(const f32x4*)(wf + (size_t)(k + 0) * NIN);
        acc += v[j].y * *(const f32x4*)(wf + (size_t)(k + 1) * NIN);
        acc += v[j].z * *(const f32x4*)(wf + (size_t)(k + 2) * NIN);
        acc += v[j].w * *(const f32x4*)(wf + (size_t)(k + 3) * NIN);
    }
    acc.x = wave_sum(acc.x); acc.y = wave_sum(acc.y); acc.z = wave_sum(acc.z); acc.w = wave_sum(acc.w);
    if (lane == 0) *(f32x4*)((float*)(p.ws + WS_ROUTE + RT_FXF) + (size_t)m * 4) = acc;
}
__device__ __forceinline__ void phase_convx(CParams& p) {
    const int tid = tid_(), lane = tid & 63, wave = tid >> 6;
    const int gw = bid_() * NWAVES + wave, NGW = nblk_() * NWAVES;
    for (int m = gw; m < T; m += NGW) {
        const f32x4* xr = (const f32x4*)(p.x + (size_t)m * D) + lane; f32x4 v[4];
#pragma unroll
        for (int j = 0; j < 4; ++j) v[j] = xr[64 * j];
        emit_xrow(p, v, m, 0, lane);
    }
}

namespace pg8 {
#define PG8_LAS __attribute__((address_space(3)))
typedef unsigned short bf16_t;
typedef short bf16x8 __attribute__((ext_vector_type(8)));
typedef float f32x4 __attribute__((ext_vector_type(4)));
typedef unsigned u32x4 __attribute__((ext_vector_type(4)));
constexpr int BM = 256, BK = 64, HALF = 128, HTB = HALF * BK * 2  , STAGE_BYTES = 8 * HTB, NXCD = 8, WGM = 8;

__host__ __device__ __forceinline__ int lds_byte(int r, int c) { const int st = (r >> 4) * 2 + (c >> 5), rr = r & 15, cc = c & 31, ob = rr * 64 + cc * 2; return st * 1024 + (ob ^ (((ob >> 9) & 1) << 5)); }
__host__ __device__ __forceinline__ void stage_rc(int b, int& R, int& C) { const int st = b / 1024, sb = b % 1024, swz = sb ^ (((sb >> 9) & 1) << 5); R = (st >> 1) * 16 + swz / 64; C = (st & 1) * 32 + (swz % 64) / 2; }
__host__ __device__ __forceinline__ int perm32(int rho) { const int n = rho >> 4, i = rho & 15; return 8 * (i >> 2) + 4 * n + (i & 3); }

struct Unit { int pm, pn; long aoff, boff; };
struct Gemm { const bf16_t* A; const bf16_t* Bt; int M, N, K, lda; };

struct StaticOrder {
    int nM, nN, nwg, G, c;
    __host__ __device__ void init(int M, int N, int G_, int c_) { nM = M / BM; nN = N / BM; nwg = nM * nN; G = G_; c = c_; }
    __host__ __device__ bool next(int i, Unit& u) const {
        const long L = (long)i * G + c; if (L >= nwg) return false;
        int wgid = (int)L; { const int q = nwg / NXCD, r = nwg % NXCD, xcd = wgid % NXCD, off = wgid / NXCD; wgid = (xcd < r ? xcd * (q + 1) : r * (q + 1) + (xcd - r) * q) + off; }
        const int nig = WGM * nN, gid = wgid / nig, fm = gid * WGM, gsz = (nM - fm) < WGM ? (nM - fm) : WGM;
        u.pm = fm + ((wgid % nig) % gsz); u.pn = (wgid % nig) / gsz; u.aoff = 0; u.boff = 0; return true;
    }
    __device__ __forceinline__ void a_ready(const Unit&) const {}
    __device__ __forceinline__ void done(const Unit&) const {}
};


__device__ __forceinline__ unsigned cvt_pk_bf16(float lo, float hi) { unsigned r; asm volatile("v_cvt_pk_bf16_f32 %0, %1, %2" : "=v"(r) : "v"(lo), "v"(hi)); return r; }
__device__ __forceinline__ float sig_(float x) { return __builtin_amdgcn_rcpf(1.f + __builtin_amdgcn_exp2f(-1.4426950408889634f * x)); }
struct EpiBf16 {
    static constexpr bool PERM = true, AFTER_DRAIN = false;
    bf16_t* O; int ldc;
    __device__ __forceinline__ void operator()(const f32x4 (&acc)[2][2][4][2], const Unit& u, int wr, int wc, int fr, int fq) const {
        const int row0 = u.pm * BM + wr * 64 + fr, col0 = u.pn * BM + wc * 32 + 8 * fq;
#pragma unroll
        for (int ai = 0; ai < 2; ++ai)
#pragma unroll
            for (int m = 0; m < 4; ++m) { const int row = row0 + ai * HALF + m * 16; bf16_t* rowp = O + (size_t)row * ldc + col0;
#pragma unroll
                for (int bj = 0; bj < 2; ++bj) { const f32x4 v0 = acc[ai][bj][m][0], v1 = acc[ai][bj][m][1];
                    u32x4 w; w.x = cvt_pk_bf16(v0[0], v0[1]); w.y = cvt_pk_bf16(v0[2], v0[3]); w.z = cvt_pk_bf16(v1[0], v1[1]); w.w = cvt_pk_bf16(v1[2], v1[3]);
                    *(u32x4*)(rowp + bj * HALF) = w; } }
    }
};
struct EpiGate {
    static constexpr bool PERM = false, AFTER_DRAIN = false;
    const bf16_t* PB; bf16_t* MG; const float* bg;
    __device__ __forceinline__ void operator()(const f32x4 (&acc)[2][2][4][2], const Unit& u, int wr, int wc, int fr, int fq) const {
        typedef unsigned u32x2_t __attribute__((ext_vector_type(2)));
        const int row0 = u.pm * BM + wr * 64 + fr, d0 = u.pn * 64 + wc * 16 + fq * 4;
        f32x4 bv[2][2];
#pragma unroll
        for (int bj = 0; bj < 2; ++bj)
#pragma unroll
            for (int n = 0; n < 2; ++n) bv[bj][n] = *(const f32x4*)(bg + (2 * bj + n) * 1024 + d0);
#pragma unroll
        for (int ai = 0; ai < 2; ++ai)
#pragma unroll
            for (int m = 0; m < 4; ++m) { const int row = row0 + ai * HALF + m * 16; const bf16_t* pr = PB + (size_t)row * 4096 + d0; f32x4 s = {0.f, 0.f, 0.f, 0.f};
#pragma unroll
                for (int bj = 0; bj < 2; ++bj)
#pragma unroll
                    for (int n = 0; n < 2; ++n) { const u32x2_t pv = *(const u32x2_t*)(pr + (2 * bj + n) * 1024); const f32x4 a = acc[ai][bj][m][n] + bv[bj][n];
                        s[0] += sig_(a[0]) * __uint_as_float(pv.x << 16); s[1] += sig_(a[1]) * __uint_as_float(pv.x & 0xffff0000u);
                        s[2] += sig_(a[2]) * __uint_as_float(pv.y << 16); s[3] += sig_(a[3]) * __uint_as_float(pv.y & 0xffff0000u); }
                u32x2_t w; w.x = cvt_pk_bf16(s[0], s[1]); w.y = cvt_pk_bf16(s[2], s[3]); *(u32x2_t*)(MG + (size_t)row * 1024 + d0) = w; }
    }
};
struct EpiRes {
    static constexpr bool PERM = false, AFTER_DRAIN = false;
    const float* base; float* out; float alpha;
    __device__ __forceinline__ void operator()(const f32x4 (&acc)[2][2][4][2], const Unit& u, int wr, int wc, int fr, int fq) const {
        const int row0 = u.pm * BM + wr * 64 + fr, col0 = u.pn * BM + wc * 32 + 4 * fq;
#pragma unroll
        for (int ai = 0; ai < 2; ++ai)
#pragma unroll
            for (int m = 0; m < 4; ++m) { const size_t off = (size_t)(row0 + ai * HALF + m * 16) * 1024 + col0;
#pragma unroll
                for (int bj = 0; bj < 2; ++bj)
#pragma unroll
                    for (int n = 0; n < 2; ++n) { const f32x4 b = *(const f32x4*)(base + off + bj * HALF + n * 16); *(f32x4*)(out + off + bj * HALF + n * 16) = b * alpha + acc[ai][bj][m][n]; } }
    }
};
struct EpiSwiglu {
    static constexpr bool PERM = true, AFTER_DRAIN = false;
    bf16_t* HID;
    __device__ __forceinline__ void operator()(const f32x4 (&acc)[2][2][4][2], const Unit& u, int wr, int wc, int fr, int fq) const {
        const int row0 = u.pm * BM + wr * 64 + fr, col0 = u.pn * HALF + wc * 32 + 8 * fq;
#pragma unroll
        for (int ai = 0; ai < 2; ++ai)
#pragma unroll
            for (int m = 0; m < 4; ++m) { const int row = row0 + ai * HALF + m * 16; float h[8];
#pragma unroll
                for (int n = 0; n < 2; ++n)
#pragma unroll
                    for (int i = 0; i < 4; ++i) { const float g = acc[ai][0][m][n][i], uu = acc[ai][1][m][n][i]; h[n * 4 + i] = g * sig_(g) * uu; }
                u32x4 w; w.x = cvt_pk_bf16(h[0], h[1]); w.y = cvt_pk_bf16(h[2], h[3]); w.z = cvt_pk_bf16(h[4], h[5]); w.w = cvt_pk_bf16(h[6], h[7]);
                *(u32x4*)(HID + (size_t)row * 256 + col0) = w; }
    }
};
struct BranchOrder {
    StaticOrder s; int shift;
    __device__ bool next(int i, Unit& u) const { if (!s.next(i, u)) return false; u.aoff = (long)(u.pn >> shift) * 512; return true; }
    __device__ __forceinline__ void a_ready(const Unit&) const {}
    __device__ __forceinline__ void done(const Unit&) const {}
};
struct MoeOrder {
    const int* Li; int nN, G, c; long bstride;
    __device__ bool next(int i, Unit& u) const {
        const int L = i * G + c, ntile = Li[64] >> 8; if (L >= ntile * nN) return false;
        u.pm = L / nN; u.pn = L % nN; const int m0 = u.pm << 8; int e = 0;
        for (int k = 0; k < 32; ++k) if (m0 >= Li[32 + k] && m0 < Li[33 + k]) e = k;
        u.aoff = 0; u.boff = (long)e * bstride; return true;
    }
    __device__ __forceinline__ void a_ready(const Unit&) const {}
    __device__ __forceinline__ void done(const Unit&) const {}
};
template <class Epi, class Sched, int KK, int LDA, bool ALIGN_EPI = false, bool SP2 = false>
__device__ __forceinline__ void gemm_phase(PG8_LAS unsigned char* lds, const Gemm g, const Sched& S, const Epi& E) {
    const int tid = tid_(), wid = __builtin_amdgcn_readfirstlane(tid >> 6), lane = tid & 63, wr = wid >> 2, wc = wid & 3, fr = lane & 15, fq = lane >> 4;
    constexpr int K = KK, nt = K / BK;
    unsigned voffA[2], voffB[2];
#pragma unroll
    for (int i = 0; i < 2; ++i) { int R, C; stage_rc(tid * 16 + i * 8192, R, C); const int Rb = Epi::PERM ? ((R & ~31) + perm32(R & 31)) : R;
        voffA[i] = (unsigned)(R * LDA + C) * 2u; voffB[i] = (unsigned)(Rb * K + C) * 2u; }
    constexpr size_t kstep = (size_t)(BK * 2);
    constexpr size_t hstepA = (size_t)HALF * LDA * 2, hstepB = (size_t)HALF * K * 2;
    constexpr size_t tstepA = 2 * hstepA, tstepB = 2 * hstepB;
    const unsigned ldsw = (unsigned)wid * 1024u;
    const int aoff = lds_byte(wr * 64 + fr, fq * 8), boff = lds_byte(wc * 32 + fr, fq * 8);
#define PG8_SA(b, h) (((b) * 2 + (h)) * HTB)
#define PG8_SB(b, h) ((4 + (b) * 2 + (h)) * HTB)
#define PG8_STAGE(bufoff, gbase, voff) do { _Pragma("unroll") for (int _i = 0; _i < 2; ++_i) \
        __builtin_amdgcn_global_load_lds((const unsigned*)((const char*)(gbase) + (voff)[_i]), (PG8_LAS unsigned*)(lds + (bufoff) + ldsw + _i * 8192), 16, 0, 0); } while (0)
#define PG8_LDA(dst, b, h) do { _Pragma("unroll") for (int m = 0; m < 4; ++m) _Pragma("unroll") for (int k = 0; k < 2; ++k) dst[m][k] = *(const PG8_LAS bf16x8*)(lds + PG8_SA(b, h) + aoff + m * 2048 + k * 1024); } while (0)
#define PG8_LDB(dst, b, h) do { _Pragma("unroll") for (int n = 0; n < 2; ++n) _Pragma("unroll") for (int k = 0; k < 2; ++k) dst[n][k] = *(const PG8_LAS bf16x8*)(lds + PG8_SB(b, h) + boff + n * 2048 + k * 1024); } while (0)
#define PG8_MMA(ai, bj, At, Bt) do { __builtin_amdgcn_s_setprio(1); _Pragma("unroll") for (int m = 0; m < 4; ++m) _Pragma("unroll") for (int n = 0; n < 2; ++n) _Pragma("unroll") for (int k = 0; k < 2; ++k) \
        acc[ai][bj][m][n] = __builtin_amdgcn_mfma_f32_16x16x32_bf16(Bt[n][k], At[m][k], acc[ai][bj][m][n], 0, 0, 0); __builtin_amdgcn_s_setprio(0); } while (0)
#define PG8_WAIT_V(n) asm volatile("s_waitcnt vmcnt(" #n ")" ::: "memory")
#define PG8_WAIT_L(n) asm volatile("s_waitcnt lgkmcnt(" #n ")" ::: "memory")
#define PG8_BAR __builtin_amdgcn_s_barrier()
#define PG8_SCHED __builtin_amdgcn_sched_barrier(0)
    Unit cur, nxt; int ui = 0;
    if (!S.next(0, cur)) return;
    f32x4 acc[2][2][4][2];
#pragma unroll
    for (int a = 0; a < 2; ++a)
#pragma unroll
        for (int b = 0; b < 2; ++b)
#pragma unroll
            for (int m = 0; m < 4; ++m)
#pragma unroll
                for (int n = 0; n < 2; ++n) acc[a][b][m][n] = (f32x4){0.f, 0.f, 0.f, 0.f};
    bf16x8 At[4][2], B0[2][2], B1[2][2];
    const char* cA = (const char*)g.A + (size_t)cur.pm * tstepA + cur.aoff; const char* cB = (const char*)g.Bt + (size_t)cur.pn * tstepB + cur.boff;
    S.a_ready(cur);
    if constexpr (SP2) {
        PG8_STAGE(PG8_SB(0, 0), cB, voffB); PG8_STAGE(PG8_SB(0, 1), cB + hstepB, voffB); PG8_STAGE(PG8_SA(0, 0), cA, voffA); PG8_STAGE(PG8_SA(0, 1), cA + hstepA, voffA);
        if (wr == 1) PG8_BAR;
        PG8_WAIT_V(2); PG8_BAR;
        PG8_STAGE(PG8_SB(1, 0), cB + kstep, voffB); PG8_STAGE(PG8_SA(1, 0), cA + kstep, voffA); PG8_STAGE(PG8_SB(1, 1), cB + hstepB + kstep, voffB);
        PG8_WAIT_V(6); PG8_BAR;
    } else {
        PG8_STAGE(PG8_SB(0, 0), cB, voffB); PG8_STAGE(PG8_SA(0, 0), cA, voffA); PG8_STAGE(PG8_SB(0, 1), cB + hstepB, voffB); PG8_STAGE(PG8_SA(0, 1), cA + hstepA, voffA);
        if (wr == 1) PG8_BAR;
        PG8_WAIT_V(4); PG8_BAR;
        PG8_STAGE(PG8_SB(1, 0), cB + kstep, voffB); PG8_STAGE(PG8_SA(1, 0), cA + kstep, voffA); PG8_STAGE(PG8_SB(1, 1), cB + hstepB + kstep, voffB);
        PG8_WAIT_V(6); PG8_BAR;
    }
    for (;;) {
        const bool has_next = S.next(ui + 1, nxt);
        const char* nA = has_next ? (const char*)g.A + (size_t)nxt.pm * tstepA + nxt.aoff : cA; const char* nB = has_next ? (const char*)g.Bt + (size_t)nxt.pn * tstepB + nxt.boff : cB;
#pragma unroll 1
        for (int t = 0; t < nt; t += 2) {
            const bool last = (t == nt - 2);
            const char* a1 = cA + (size_t)(t + 1) * kstep;
            const char* a2 = last ? nA : cA + (size_t)(t + 2) * kstep; const char* b2 = last ? nB : cB + (size_t)(t + 2) * kstep;
            const char* a3 = a2 + kstep; const char* b3 = b2 + kstep;
            if (last && has_next) S.a_ready(nxt);
            if constexpr (SP2) {
            PG8_LDB(B0, 0, 0); PG8_LDB(B1, 0, 1); PG8_SCHED; PG8_LDA(At, 0, 0); PG8_STAGE(PG8_SA(1, 1), a1 + hstepA, voffA);
            PG8_WAIT_V(8); PG8_WAIT_L(0); PG8_BAR; PG8_MMA(0, 0, At, B0); PG8_MMA(0, 1, At, B1); PG8_BAR; PG8_SCHED;
            PG8_LDA(At, 0, 1); PG8_STAGE(PG8_SB(0, 0), b2, voffB); PG8_STAGE(PG8_SB(0, 1), b2 + hstepB, voffB); PG8_STAGE(PG8_SA(0, 0), a2, voffA);
            PG8_WAIT_V(8); PG8_WAIT_L(0); PG8_BAR; PG8_MMA(1, 0, At, B0); PG8_MMA(1, 1, At, B1); PG8_BAR; PG8_SCHED;
            PG8_LDB(B0, 1, 0); PG8_LDB(B1, 1, 1); PG8_SCHED; PG8_LDA(At, 1, 0); PG8_STAGE(PG8_SA(0, 1), a2 + hstepA, voffA);
            PG8_WAIT_V(8); PG8_WAIT_L(0); PG8_BAR; PG8_MMA(0, 0, At, B0); PG8_MMA(0, 1, At, B1); PG8_BAR; PG8_SCHED;
            PG8_LDA(At, 1, 1); PG8_STAGE(PG8_SB(1, 0), b3, voffB); PG8_STAGE(PG8_SB(1, 1), b3 + hstepB, voffB); PG8_STAGE(PG8_SA(1, 0), a3, voffA);
            PG8_WAIT_V(8); PG8_WAIT_L(0); PG8_BAR; PG8_MMA(1, 0, At, B0); PG8_MMA(1, 1, At, B1); PG8_BAR; PG8_SCHED;
            } else {
            PG8_LDB(B0, 0, 0); PG8_SCHED; PG8_LDA(At, 0, 0); PG8_STAGE(PG8_SA(1, 1), a1 + hstepA, voffA);
            PG8_WAIT_L(8); PG8_BAR; PG8_WAIT_L(0); PG8_MMA(0, 0, At, B0); PG8_BAR; PG8_SCHED;
            PG8_LDB(B1, 0, 1); PG8_STAGE(PG8_SB(0, 0), b2, voffB);
            PG8_BAR; PG8_WAIT_L(0); PG8_MMA(0, 1, At, B1); PG8_BAR;
            PG8_LDA(At, 0, 1); PG8_STAGE(PG8_SA(0, 0), a2, voffA);
            PG8_BAR; PG8_WAIT_L(0); PG8_MMA(1, 0, At, B0); PG8_BAR; PG8_SCHED;
            PG8_STAGE(PG8_SB(0, 1), b2 + hstepB, voffB);
            PG8_WAIT_V(6); PG8_BAR; PG8_MMA(1, 1, At, B1); PG8_BAR;
            PG8_LDB(B0, 1, 0); PG8_SCHED; PG8_LDA(At, 1, 0); PG8_STAGE(PG8_SA(0, 1), a2 + hstepA, voffA);
            PG8_WAIT_L(8); PG8_BAR; PG8_WAIT_L(0); PG8_MMA(0, 0, At, B0); PG8_BAR; PG8_SCHED;
            PG8_LDB(B1, 1, 1); PG8_STAGE(PG8_SB(1, 0), b3, voffB);
            PG8_BAR; PG8_WAIT_L(0); PG8_MMA(0, 1, At, B1); PG8_BAR;
            PG8_LDA(At, 1, 1); PG8_STAGE(PG8_SA(1, 0), a3, voffA);
            PG8_BAR; PG8_WAIT_L(0); PG8_MMA(1, 0, At, B0); PG8_BAR; PG8_SCHED;
            PG8_STAGE(PG8_SB(1, 1), b3 + hstepB, voffB);
            PG8_WAIT_V(6); PG8_BAR; PG8_MMA(1, 1, At, B1); PG8_BAR;
            }
        }
        if constexpr (ALIGN_EPI) { if (wr == 0) PG8_BAR; }
        if constexpr (!Epi::AFTER_DRAIN) { E(acc, cur, wr, wc, fr, fq); S.done(cur); }
        if (!has_next) break;
#pragma unroll
        for (int a = 0; a < 2; ++a)
#pragma unroll
            for (int b = 0; b < 2; ++b)
#pragma unroll
                for (int m = 0; m < 4; ++m)
#pragma unroll
                    for (int n = 0; n < 2; ++n) acc[a][b][m][n] = (f32x4){0.f, 0.f, 0.f, 0.f};
        cur = nxt; cA = nA; cB = nB; ++ui;
        if constexpr (ALIGN_EPI) { if (wr == 1) PG8_BAR; }
    }
    PG8_WAIT_V(0);
    if constexpr (!ALIGN_EPI) { if (wr == 0) PG8_BAR; }
    PG8_BAR;
    if constexpr (Epi::AFTER_DRAIN) { E.fused(acc, cur, wr, wc, fr, fq, lds, wid, lane); S.done(cur); }
#undef PG8_SA
#undef PG8_SB
#undef PG8_STAGE
#undef PG8_LDA
#undef PG8_LDB
#undef PG8_MMA
#undef PG8_WAIT_V
#undef PG8_WAIT_L
#undef PG8_BAR
#undef PG8_SCHED
}
}

template <class AP, class BP, class Epi>
__device__ __forceinline__ void ngemm(int M, int N, int K, int lda, int ldb, AP ap, BP bp, Epi epi, float* lds) {
    const int tid = tid_(), ty = tid >> 4, tx = tid & 15;
    float* As = lds; float* Bs = lds + 32 * 128;
    const int ntm = M / 128, ntn = N / 128;
    const int lrow = tid >> 2, lkc = (tid & 3) * 8;
    for (int tile = bid_(); tile < ntm * ntn; tile += nblk_()) {
        const int tm = tile / ntn, tn = tile % ntn, m0 = tm * 128, n0 = tn * 128;
        const bf16_t* Ab = ap(m0, n0) + (size_t)lrow * lda + lkc; const bf16_t* Bb = bp(m0, n0) + (size_t)lrow * ldb + lkc;
        float acc[4][8];
#pragma unroll
        for (int i = 0; i < 4; ++i)
#pragma unroll
            for (int j = 0; j < 8; ++j) acc[i][j] = 0.f;
        for (int k0 = 0; k0 < K; k0 += 32) {
            const u32x4 va = *(const u32x4*)(Ab + k0); const u32x4 vb = *(const u32x4*)(Bb + k0);
            __syncthreads();
#pragma unroll
            for (int i = 0; i < 4; ++i) {
                As[(lkc + 2 * i) * 128 + lrow] = bf2f(va[i] & 0xffffu); As[(lkc + 2 * i + 1) * 128 + lrow] = bf2f(va[i] >> 16);
                Bs[(lkc + 2 * i) * 128 + lrow] = bf2f(vb[i] & 0xffffu); Bs[(lkc + 2 * i + 1) * 128 + lrow] = bf2f(vb[i] >> 16);
            }
            __syncthreads();
#pragma unroll 8
            for (int kk = 0; kk < 32; ++kk) {
                const f32x4 a = *(const f32x4*)(As + kk * 128 + ty * 4);
                const f32x4 b0 = *(const f32x4*)(Bs + kk * 128 + tx * 8), b1 = *(const f32x4*)(Bs + kk * 128 + tx * 8 + 4);
#pragma unroll
                for (int i = 0; i < 4; ++i) {
                    acc[i][0] += a[i] * b0.x; acc[i][1] += a[i] * b0.y; acc[i][2] += a[i] * b0.z; acc[i][3] += a[i] * b0.w;
                    acc[i][4] += a[i] * b1.x; acc[i][5] += a[i] * b1.y; acc[i][6] += a[i] * b1.z; acc[i][7] += a[i] * b1.w;
                }
            }
        }
#pragma unroll
        for (int i = 0; i < 4; ++i)
#pragma unroll
            for (int j = 0; j < 8; ++j) epi(m0 + ty * 4 + i, n0 + tx * 8 + j, acc[i][j]);
    }
    __syncthreads();
}

__device__ __forceinline__ void expert_offsets(CParams& p, int tb, int* Li) {
    const int tid = tid_(); const int* hist = (const int*)(p.ws + WS_CTL);
    int* tmp = Li + 128;
    const int e = tid & 31, part = tid >> 5;
    int s = 0, pre = 0;
    for (int i = 0; i < 16; ++i) { const int b = part * 16 + i; const int h = hist[b * 32 + e]; s += h; if (b < tb) pre += h; }
    tmp[part * 32 + e] = s; tmp[512 + part * 32 + e] = pre;
    __syncthreads();
    if (tid < 32) { int a = 0, b = 0; for (int i = 0; i < 16; ++i) { a += tmp[i * 32 + tid]; b += tmp[512 + i * 32 + tid]; } Li[tid] = a; Li[65 + tid] = b; }
    __syncthreads();
    if (tid == 0) { int ps = 0; for (int i = 0; i < 32; ++i) { Li[32 + i] = ps; ps += (Li[i] + 255) / 256 * 256; } Li[64] = ps; }
    __syncthreads();
}
__device__ __forceinline__ int tile_expert(const int* Li, int m0) { int e = 0; for (int i = 0; i < 32; ++i) if (m0 >= Li[32 + i] && m0 < Li[33 + i]) e = i; return e; }

__device__ __forceinline__ void phase_inproj(CParams& p, float* lds) {
    const bf16_t* XB = (const bf16_t*)(p.ws + WS_XB); const bf16_t* Bt = (const bf16_t*)(p.ws + WS_W + W_BT1); bf16_t* ZS = (bf16_t*)(p.ws + WS_R1 + R1_ZS);
    ngemm(T, ZSW, 1024, 1024, 1024, [=](int m0, int) { return XB + (size_t)m0 * 1024; }, [=](int, int n0) { return Bt + (size_t)n0 * 1024; },
          [=](int m, int n, float v) { ZS[(size_t)m * ZSW + n] = (bf16_t)f2bf(v); }, lds);
}
__device__ __forceinline__ float logsigmoid_(float x) { return -(fmaxf(-x, 0.f) + log1pf(expf(-fabsf(x)))); }
__device__ __forceinline__ void phase_upproj(CParams& p, int l, float* lds) {
    const int tid = tid_(), lane = tid & 63, wave = tid >> 6;
    const bf16_t* ZS = (const bf16_t*)(p.ws + WS_R1 + R1_ZS);
    const bf16_t* Bup = (const bf16_t*)(p.ws + WS_W + W_UQ); bf16_t* QKVR = (bf16_t*)(p.ws + WS_R1 + R1_QKVR);
    ngemm(T, 1024, 256, ZSW, 256, [=](int m0, int n0) { return ZS + (size_t)m0 * ZSW + (n0 >> 9) * 256; }, [=](int, int n0) { return Bup + (size_t)n0 * 256; },
          [=](int m, int n, float v) { QKVR[(size_t)m * 1024 + n] = (bf16_t)f2bf(v); }, lds);
}

__device__ __forceinline__ void phase_prep(CParams& p, int l, float* lds) {
    const int tid = tid_(), lane = tid & 63, wave = tid >> 6;
    const int gw = bid_() * NWAVES + wave, NGW = nblk_() * NWAVES;
    const bf16_t* ZS = (const bf16_t*)(p.ws + WS_R1 + R1_ZS); const bf16_t* QKVR = (const bf16_t*)(p.ws + WS_R1 + R1_QKVR);
    bf16_t* Qm = (bf16_t*)(p.ws + WS_C + C_QM); bf16_t* Km = (bf16_t*)(p.ws + WS_C + C_KM); bf16_t* Vm = (bf16_t*)(p.ws + WS_C + C_VM);
    bf16_t* QF = (bf16_t*)(p.ws + WS_E + E_QF); bf16_t* KF = (bf16_t*)(p.ws + WS_E + E_KF); const float* CFp = (const float*)(p.ws + WS_ROUTE + RT_CF);
    for (int m = gw; m < T; m += NGW) {
        const bf16_t* zr = ZS + (size_t)m * ZSW;
        float sq = 0.f, skv = 0.f;
#pragma unroll
        for (int j = 0; j < 4; ++j) { const float v = bf2f(zr[C_CQ + lane + 64 * j]); sq += v * v; }
#pragma unroll
        for (int j = 0; j < 2; ++j) { const float v = bf2f(zr[C_CKV + lane + 64 * j]); skv += v * v; }
        const float rq = rsqrtf(wave_sum(sq) * (1.f / 256.f) + EPS), rkv = rsqrtf(wave_sum(skv) * (1.f / 128.f) + EPS);
        const float posf = (float)p.pos[m];
        float cs = 1.f, sn = 0.f;
        { const float inv = exp2f(-(float)(lane & 15) * (13.287712379549449f / 16.f)); sincosf(posf * inv, &sn, &cs); }
        const bf16_t* qr = QKVR + (size_t)m * 1024; const bf16_t* kvr = qr + 512;
#pragma unroll
        for (int j = 0; j < 6; ++j) {
            const int idx = lane + 64 * j, h = idx / 96, d = idx % 96;
            float q, k;
            const int i = (d - 64) & 15, hf = (d - 64) >> 4;
            const float c = __shfl(cs, i), s = __shfl(sn, i);
            if (d < 64) { q = bf2f(qr[h * 96 + d]); k = bf2f(kvr[h * 128 + d]) * rkv; }
            else {
                const float q1 = bf2f(qr[h * 96 + 64 + i]), q2 = bf2f(qr[h * 96 + 80 + i]);
                const float k1 = bf2f(zr[C_KR + i]), k2 = bf2f(zr[C_KR + 16 + i]);
                q = hf == 0 ? q1 * c - q2 * s : q2 * c + q1 * s;
                k = hf == 0 ? k1 * c - k2 * s : k2 * c + k1 * s;
            }
            Qm[(size_t)m * 384 + idx] = (bf16_t)f2bf(q * rq * C2_M);
            Km[(size_t)m * 384 + idx] = (bf16_t)f2bf(k);
        }
#pragma unroll
        for (int j = 0; j < 4; ++j) { const int idx = lane + 64 * j, h = idx >> 6, d = idx & 63; Vm[(size_t)m * 256 + idx] = (bf16_t)f2bf(bf2f(kvr[h * 128 + 64 + d]) * rkv); }
        { const f32x4 c4 = *(const f32x4*)(CFp + (size_t)m * 4);
#pragma unroll
          for (int j = 0; j < 5; ++j) {
            const int idx = lane + 64 * j, h = idx / 80, d = idx % 80;
            const float bias = -c4[h] * LOG2E; const unsigned bh_ = f2bf(bias); const unsigned bl_ = f2bf(bias - bf2f(bh_));
            unsigned qv, kv;
            if (d < 64) { qv = zr[C_FXQ + h * 64 + d]; kv = zr[C_FXK + h * 64 + d]; }
            else { qv = d < 66 ? 0x3f80u : 0u; kv = d == 64 ? bh_ : (d == 65 ? bl_ : 0u); }
            QF[(size_t)m * 320 + idx] = (bf16_t)qv; KF[(size_t)m * 320 + idx] = (bf16_t)kv;
          } }
    }
    if (bid_() == 0 && tid == 0) *(unsigned*)(p.ws + WS_CTL + CTL_QUEUE) = 0u;
    __syncthreads();
    float* hs = lds;
    float* ys = lds + 62 * 256;
    bf16_t* YS = (bf16_t*)(p.ws + WS_D);
    const float* cw = p.conv_w + (size_t)l * 31 * 256; const float* cb = p.conv_b + l * 256; const float* lg = p.conv_g + l * 256; const float* lb = p.conv_bb + l * 256;
    for (int ch = bid_(); ch < T / 32; ch += nblk_()) {
        const int m0 = ch * 32, t0 = m0 & (SEQ - 1);
        for (int idx = tid; idx < 62 * 256; idx += NTHREADS) {
            const int r = idx >> 8, c = idx & 255, tt = t0 - 30 + r; float v = 0.f;
            if (tt >= 0) { const bf16_t* zr = ZS + (size_t)(m0 - 30 + r) * ZSW; v = bf2f(zr[C_CVA + c]) * sigmoidf_(bf2f(zr[C_CVG + c])); }
            hs[idx] = v;
        }
        __syncthreads();
        { const int c = tid & 255, half = tid >> 8; float w[31];
#pragma unroll
            for (int i = 0; i < 31; ++i) w[i] = cw[i * 256 + c];
            const float bias = cb[c];
            for (int i = half * 16; i < half * 16 + 16; ++i) { float a = bias;
#pragma unroll
                for (int k = 0; k < 31; ++k) a += hs[(i + k) * 256 + c] * w[k];
                ys[i * 256 + c] = a; } }
        __syncthreads();
#pragma unroll
        for (int q = 0; q < 4; ++q) {
            const int i = wave * 4 + q; const f32x4 v = *(const f32x4*)(ys + i * 256 + lane * 4);
            const float mean = wave_sum((v.x + v.y) + (v.z + v.w)) * (1.f / 256.f);
            const f32x4 dv = v - mean; const float var = wave_sum((dv.x * dv.x + dv.y * dv.y) + (dv.z * dv.z + dv.w * dv.w)) * (1.f / 256.f);
            const float rstd = rsqrtf(var + EPS);
            const f32x4 g = *(const f32x4*)(lg + lane * 4), bb = *(const f32x4*)(lb + lane * 4);
            f32x4 y = dv * rstd * g + bb;
            y.x = y.x * sigmoidf_(y.x); y.y = y.y * sigmoidf_(y.y); y.z = y.z * sigmoidf_(y.z); y.w = y.w * sigmoidf_(y.w);
            u32x2 o; o.x = pk2(y.x, y.y); o.y = pk2(y.z, y.w);
            *(u32x2*)(YS + (size_t)(m0 + i) * 1024 + 512 + lane * 4) = o;
        }
        __syncthreads();
    }
}

template <int MODE, int DQ>
__device__ __forceinline__ void attn_naive(const bf16_t* Q, int qp, const bf16_t* K, int kp, const bf16_t* V, int vp, const float* CF, bf16_t* Y, float* lds) {
    const int tid = tid_(), lane = tid & 63, wave = tid >> 6;
    const int gw = bid_() * NWAVES + wave, NGW = nblk_() * NWAVES;
    float* qs = lds + wave * 128;
    for (int row = gw; row < T * 4; row += NGW) {
        const int m = row >> 2, h = row & 3, b = m >> 12, t = m & (SEQ - 1);
        LDS_FENCE();
        for (int d = lane; d < DQ; d += 64) qs[d] = bf2f(Q[(size_t)m * qp + h * DQ + d]);
        LDS_FENCE();
        float acc = 0.f, mx = -INFINITY, l = 0.f, R = 0.f;
        const int last = MODE == 1 ? t - 1 : t;
        const int nch = last < 0 ? 0 : (last >> 6) + 1;
        for (int ci = 0; ci < nch; ++ci) {
            const int j0 = (MODE == 1 ? (nch - 1 - ci) : ci) * 64, j = j0 + lane;
            const bool valid = j <= last;
            const int jc = valid ? j : last;
            const bf16_t* kr = K + ((size_t)b * SEQ + jc) * kp + h * DQ;
            float s = 0.f;
#pragma unroll
            for (int c = 0; c < DQ / 8; ++c) { const u32x4 kv = *(const u32x4*)(kr + c * 8);
#pragma unroll
                for (int i = 0; i < 4; ++i) s += qs[c * 8 + 2 * i] * bf2f(kv[i] & 0xffffu) + qs[c * 8 + 2 * i + 1] * bf2f(kv[i] >> 16); }
            float pj;
            if (MODE == 1) {
                float L2 = valid ? -(fmaxf(s, 0.f) + log2f(1.f + exp2f(-fabsf(s)))) : 0.f;
                float suf = L2;
#pragma unroll
                for (int o = 1; o < 64; o <<= 1) { const float y = __shfl_down(suf, o); if (lane + o < 64) suf += y; }
                const float after = R + (suf - L2);
                pj = valid ? exp2f(s + L2 + after) : 0.f;
                R += __shfl(suf, 0);
            } else {
                if (MODE == 2) s -= CF[((size_t)b * SEQ + jc) * 4 + h] * LOG2E;
                if (!valid) s = -INFINITY;
                const float mn = fmaxf(mx, wave_max(s));
                const float f = exp2f(mx - mn);
                pj = exp2f(s - mn);
                l = l * f + wave_sum(pj); acc *= f; mx = mn;
            }
            const bf16_t* vb = V + ((size_t)b * SEQ + j0) * vp + h * 64 + lane;
            const int nv = last - j0 + 1 < 64 ? last - j0 + 1 : 64;
            for (int jj = 0; jj < nv; ++jj) acc += __shfl(pj, jj) * bf2f(vb[(size_t)jj * vp]);
        }
        if (MODE != 1) acc = nch ? acc / l : 0.f;
        Y[(size_t)m * 1024 + h * 64 + lane] = (bf16_t)f2bf(acc);
    }
}
__device__ __forceinline__ void phase_attn(CParams& p, float* lds) {
    const bf16_t* ZS = (const bf16_t*)(p.ws + WS_R1 + R1_ZS); bf16_t* YS = (bf16_t*)(p.ws + WS_D);
    const bf16_t* Qm = (const bf16_t*)(p.ws + WS_C + C_QM); const bf16_t* Km = (const bf16_t*)(p.ws + WS_C + C_KM); const bf16_t* Vm = (const bf16_t*)(p.ws + WS_C + C_VM);
    const float* CF = (const float*)(p.ws + WS_ROUTE + RT_CF);
    attn_naive<0, 96>(Qm, 384, Km, 384, Vm, 256, nullptr, YS, lds);
    attn_naive<1, 64>(ZS + C_SBQ, ZSW, ZS + C_SBK, ZSW, ZS + C_SBV, ZSW, nullptr, YS + 256, lds);
    attn_naive<2, 64>(ZS + C_FXQ, ZSW, ZS + C_FXK, ZSW, ZS + C_FXV, ZSW, CF, YS + 768, lds);
}

__device__ __forceinline__ void phase_pgemm(CParams& p, float* lds) {
    const bf16_t* YS = (const bf16_t*)(p.ws + WS_D); const bf16_t* Bt = (const bf16_t*)(p.ws + WS_W + W_BR); bf16_t* PB = (bf16_t*)(p.ws + WS_R1 + R1_PB);
    ngemm(T, 4096, 256, 1024, 256, [=](int m0, int n0) { return YS + (size_t)m0 * 1024 + (n0 >> 10) * 256; }, [=](int, int n0) { return Bt + (size_t)n0 * 256; },
          [=](int m, int n, float v) { PB[(size_t)m * 4096 + n] = (bf16_t)f2bf(v); }, lds);
}
__device__ __forceinline__ void phase_gate(CParams& p, int l, float* lds) {
    const bf16_t* XB = (const bf16_t*)(p.ws + WS_XB); const bf16_t* Bt = (const bf16_t*)(p.ws + WS_W + W_GATE); bf16_t* PB = (bf16_t*)(p.ws + WS_R1 + R1_PB);
    const float* bg = p.b_gate + (size_t)l * 4096;
    ngemm(T, 4096, 1024, 1024, 1024, [=](int m0, int) { return XB + (size_t)m0 * 1024; }, [=](int, int n0) { return Bt + (size_t)n0 * 1024; },
          [=](int m, int n, float v) { const size_t i = (size_t)m * 4096 + n; PB[i] = (bf16_t)f2bf(sigmoidf_(v + bg[n]) * bf2f(PB[i])); }, lds);
}
__device__ __forceinline__ void phase_combine(CParams& p) {
    const bf16_t* PB = (const bf16_t*)(p.ws + WS_R1 + R1_PB); bf16_t* MG = (bf16_t*)(p.ws + WS_C);
    for (size_t i = (size_t)bid_() * NTHREADS + tid_(); i < (size_t)T * 1024; i += (size_t)nblk_() * NTHREADS) {
        const size_t m = i >> 10, d = i & 1023; const bf16_t* r = PB + m * 4096 + d;
        MG[i] = (bf16_t)f2bf((bf2f(r[0]) + bf2f(r[1024])) + (bf2f(r[2048]) + bf2f(r[3072])));
    }
}
__device__ __forceinline__ void phase_wo(CParams& p, int l, float* lds) {
    const bf16_t* MG = (const bf16_t*)(p.ws + WS_C); const bf16_t* Bt = (const bf16_t*)(p.ws + WS_W + W_O);
    const float* xf = l == 0 ? p.x : p.out; float* out = p.out;
    ngemm(T, 1024, 1024, 1024, 1024, [=](int m0, int) { return MG + (size_t)m0 * 1024; }, [=](int, int n0) { return Bt + (size_t)n0 * 1024; },
          [=](int m, int n, float v) { const size_t i = (size_t)m * 1024 + n; out[i] = ALPHA * xf[i] + v; }, lds);
}

__device__ __forceinline__ void ln_row(f32x4 (&v)[4], const float* g, const float* b, int lane) {
    float s = 0.f;
#pragma unroll
    for (int j = 0; j < 4; ++j) s += (v[j].x + v[j].y) + (v[j].z + v[j].w);
    const float mean = wave_sum(s) * (1.f / 1024.f); float s2 = 0.f;
#pragma unroll
    for (int j = 0; j < 4; ++j) { v[j] = v[j] - mean; s2 += (v[j].x * v[j].x + v[j].y * v[j].y) + (v[j].z * v[j].z + v[j].w * v[j].w); }
    const float rstd = rsqrtf(wave_sum(s2) * (1.f / 1024.f) + EPS);
#pragma unroll
    for (int j = 0; j < 4; ++j) { const f32x4 gg = *(const f32x4*)(g + 256 * j + 4 * lane), bb = *(const f32x4*)(b + 256 * j + 4 * lane); v[j] = v[j] * rstd * gg + bb; }
}

__device__ __forceinline__ void phase_ln1route(CParams& p, int l, float* lds) {
    const int tid = tid_(), lane = tid & 63, wave = tid >> 6;
    int* cnt = (int*)lds; float* sl = lds + 64 + wave * 64; float* hrow = lds + 1024 + wave * 1024;
    int* tok_e = (int*)(p.ws + WS_ROUTE + RT_TOKE); float* tok_w = (float*)(p.ws + WS_ROUTE + RT_TOKW); int* tok_p = (int*)(p.ws + WS_ROUTE + RT_TOKP);
    int* hist = (int*)(p.ws + WS_CTL); bf16_t* HB = (bf16_t*)(p.ws + WS_C);
    const float* wrg = p.w_rg + (size_t)l * 1024 * 4; const float* wre = p.w_re + (size_t)l * 1024 * 32;
    for (int tb = bid_(); tb < 256; tb += nblk_()) {
        if (tid < 32) cnt[tid] = 0;
        __syncthreads();
        for (int q = 0; q < 8; ++q) {
            const int m = tb * 64 + wave * 8 + q;
            f32x4* orow = (f32x4*)(p.out + (size_t)m * D) + lane; f32x4 v[4];
#pragma unroll
            for (int j = 0; j < 4; ++j) v[j] = orow[64 * j];
            ln_row(v, p.ln1_g + l * D, p.ln1_b + l * D, lane);
            u32x2* hb = (u32x2*)(HB + (size_t)m * D) + lane;
#pragma unroll
            for (int j = 0; j < 4; ++j) { orow[64 * j] = v[j]; u32x2 w; w.x = pk2(v[j].x, v[j].y); w.y = pk2(v[j].z, v[j].w); hb[64 * j] = w; }
            float ag[4] = {0.f, 0.f, 0.f, 0.f}; float ae[32];
#pragma unroll
            for (int i = 0; i < 32; ++i) ae[i] = 0.f;
#pragma unroll
            for (int j = 0; j < 4; ++j) *(f32x4*)(hrow + 256 * j + 4 * lane) = v[j];
            LDS_FENCE();
#pragma unroll 2
            for (int kk = 0; kk < 16; ++kk) {
                const int k = kk * 64 + lane; const float hv = hrow[k];
                const f32x4 g4 = *(const f32x4*)(wrg + (size_t)k * 4);
                ag[0] += hv * g4.x; ag[1] += hv * g4.y; ag[2] += hv * g4.z; ag[3] += hv * g4.w;
#pragma unroll
                for (int e4 = 0; e4 < 8; ++e4) { const f32x4 w4 = *(const f32x4*)(wre + (size_t)k * 32 + e4 * 4);
                    ae[e4 * 4 + 0] += hv * w4.x; ae[e4 * 4 + 1] += hv * w4.y; ae[e4 * 4 + 2] += hv * w4.z; ae[e4 * 4 + 3] += hv * w4.w; }
            }
#pragma unroll
            for (int i = 0; i < 4; ++i) { const float r = wave_sum(ag[i]); if (lane == 0) sl[i] = r + p.b_rg[l * 4 + i]; }
#pragma unroll
            for (int i = 0; i < 32; ++i) { const float r = wave_sum(ae[i]); if (lane == 0) sl[4 + i] = r + p.b_re[l * 32 + i]; }
            LDS_FENCE();
            if (lane == 0) {
                int g = 0; float gm = sl[0];
                for (int i = 1; i < 4; ++i) if (sl[i] > gm) { gm = sl[i]; g = i; }
                float gs = 0.f; for (int i = 0; i < 4; ++i) gs += expf(sl[i] - gm);
                const float grp_p = 1.f / gs;
                const float* le = sl + 4 + g * 8;
                int i0 = 0; float m0 = le[0];
                for (int i = 1; i < 8; ++i) if (le[i] > m0) { m0 = le[i]; i0 = i; }
                int i1 = -1; float m1 = -INFINITY;
                for (int i = 0; i < 8; ++i) if (i != i0 && le[i] > m1) { m1 = le[i]; i1 = i; }
                const float e1 = expf(m1 - m0), den = 1.f + e1;
                const int x0 = g * 8 + i0, x1 = g * 8 + i1;
                tok_e[m * 2] = x0; tok_e[m * 2 + 1] = x1;
                tok_w[m * 2] = grp_p / den; tok_w[m * 2 + 1] = grp_p * e1 / den;
                tok_p[m * 2] = atomicAdd(&cnt[x0], 1); tok_p[m * 2 + 1] = atomicAdd(&cnt[x1], 1);
            }
            LDS_FENCE();
        }
        __syncthreads();
        if (tid < 32) hist[tb * 32 + tid] = cnt[tid];
        __syncthreads();
    }
}

__device__ __forceinline__ void phase_gather(CParams& p, float* lds) {
    const int tid = tid_(), lane = tid & 63, wave = tid >> 6;
    int* Li = (int*)lds;
    const int* tok_e = (const int*)(p.ws + WS_ROUTE + RT_TOKE); const float* tok_w = (const float*)(p.ws + WS_ROUTE + RT_TOKW); const int* tok_p = (const int*)(p.ws + WS_ROUTE + RT_TOKP);
    int* tok_s = (int*)(p.ws + WS_ROUTE + RT_TOKS); float* slot_w = (float*)(p.ws + WS_ROUTE + RT_SLOTW);
    const bf16_t* HB = (const bf16_t*)(p.ws + WS_C); bf16_t* XG = (bf16_t*)(p.ws + WS_R1 + R1_XG);
    for (int tb = bid_(); tb < 256; tb += nblk_()) {
        expert_offsets(p, tb, Li);
        for (int q = 0; q < 16; ++q) {
            const int a = tb * 128 + wave * 16 + q, m = a >> 1;
            const int e = tok_e[a]; const int slot = Li[32 + e] + Li[65 + e] + tok_p[a];
            const u32x4* src = (const u32x4*)(HB + (size_t)m * D) + lane; u32x4* dst = (u32x4*)(XG + (size_t)slot * D) + lane;
            dst[0] = src[0]; dst[64] = src[64];
            if (lane == 0) { tok_s[a] = slot; slot_w[slot] = tok_w[a]; }
        }
        __syncthreads();
    }
}
__device__ __forceinline__ void phase_moeup(CParams& p, float* lds) {
    int* Li = (int*)(lds + 16384);
    expert_offsets(p, 0, Li);
    const bf16_t* XG = (const bf16_t*)(p.ws + WS_R1 + R1_XG); const bf16_t* Bt = (const bf16_t*)(p.ws + WS_W + W_GU); bf16_t* GU = (bf16_t*)(p.ws + WS_C);
    ngemm(Li[64], 512, 1024, 1024, 1024, [=](int m0, int) { return XG + (size_t)m0 * 1024; }, [=](int m0, int n0) { return Bt + ((size_t)tile_expert(Li, m0) * 512 + n0) * 1024; },
          [=](int m, int n, float v) { GU[(size_t)m * 512 + n] = (bf16_t)f2bf(v); }, lds);
}
__device__ __forceinline__ void phase_swiglu(CParams& p, float* lds) {
    int* Li = (int*)(lds + 16384);
    expert_offsets(p, 0, Li);
    const size_t n = (size_t)Li[64] * 256;
    const bf16_t* GU = (const bf16_t*)(p.ws + WS_C); bf16_t* HID = (bf16_t*)(p.ws + WS_R1 + R1_HID);
    for (size_t i = (size_t)bid_() * NTHREADS + tid_(); i < n; i += (size_t)nblk_() * NTHREADS) {
        const size_t s = i >> 8; const int f = (int)(i & 255), j = f >> 7, rr = f & 127;
        const float g = bf2f(GU[s * 512 + j * 256 + rr]), u = bf2f(GU[s * 512 + j * 256 + 128 + rr]);
        HID[i] = (bf16_t)f2bf(g * sigmoidf_(g) * u);
    }
    __syncthreads();
}
__device__ __forceinline__ void phase_moedown(CParams& p, float* lds) {
    int* Li = (int*)(lds + 16384);
    expert_offsets(p, 0, Li);
    const bf16_t* HID = (const bf16_t*)(p.ws + WS_R1 + R1_HID); const bf16_t* Bt = (const bf16_t*)(p.ws + WS_W + W_D); bf16_t* YSL = (bf16_t*)(p.ws + WS_R1 + R1_YSL);
    ngemm(Li[64], 1024, 256, 256, 256, [=](int m0, int) { return HID + (size_t)m0 * 256; }, [=](int m0, int n0) { return Bt + ((size_t)tile_expert(Li, m0) * 1024 + n0) * 256; },
          [=](int m, int n, float v) { YSL[(size_t)m * 1024 + n] = (bf16_t)f2bf(v); }, lds);
}
__device__ __forceinline__ void phase_ln2(CParams& p, int l) {
    const int tid = tid_(), lane = tid & 63, wave = tid >> 6;
    const int gw = bid_() * NWAVES + wave, NGW = nblk_() * NWAVES;
    const int* tok_s = (const int*)(p.ws + WS_ROUTE + RT_TOKS); const bf16_t* YSL = (const bf16_t*)(p.ws + WS_R1 + R1_YSL); const float* tok_w = (const float*)(p.ws + WS_ROUTE + RT_TOKW);
    for (int m = gw; m < T; m += NGW) {
        f32x4* orow = (f32x4*)(p.out + (size_t)m * D) + lane; f32x4 v[4];
        const u32x2* y0 = (const u32x2*)(YSL + (size_t)tok_s[m * 2] * D) + lane; const u32x2* y1 = (const u32x2*)(YSL + (size_t)tok_s[m * 2 + 1] * D) + lane;
        const float w0 = tok_w[m * 2], w1 = tok_w[m * 2 + 1];
#pragma unroll
        for (int j = 0; j < 4; ++j) {
            const u32x2 a = y0[64 * j], b = y1[64 * j]; const f32x4 hv = orow[64 * j];
            v[j].x = ALPHA * hv.x + (w0 * bf2f(a.x & 0xffffu) + w1 * bf2f(b.x & 0xffffu)); v[j].y = ALPHA * hv.y + (w0 * bf2f(a.x >> 16) + w1 * bf2f(b.x >> 16));
            v[j].z = ALPHA * hv.z + (w0 * bf2f(a.y & 0xffffu) + w1 * bf2f(b.y & 0xffffu)); v[j].w = ALPHA * hv.w + (w0 * bf2f(a.y >> 16) + w1 * bf2f(b.y >> 16));
        }
        ln_row(v, p.ln2_g + l * D, p.ln2_b + l * D, lane);
#pragma unroll
        for (int j = 0; j < 4; ++j) orow[64 * j] = v[j];
        if (l == 0) emit_xrow(p, v, m, 1, lane);
    }
}


namespace att {
typedef short bf16x8 __attribute__((ext_vector_type(8)));
typedef short s16x4 __attribute__((ext_vector_type(4)));
typedef float f32x16 __attribute__((ext_vector_type(16)));
#define ALAS __attribute__((address_space(3)))
typedef ALAS unsigned char* lp_t;
constexpr float THR = 6.f;
__device__ __forceinline__ int crow(int r, int hi) { return (r & 3) + 8 * (r >> 2) + 4 * hi; }
__device__ __forceinline__ s16x4 vtr(lp_t p) { return __builtin_bit_cast(s16x4, __builtin_amdgcn_ds_read_tr16_b64_v4i16((ALAS s16x4*)p)); }
__device__ __forceinline__ bf16x8 pack8(const f32x16& p, int b) {
    u32x4 w; w.x = pg8::cvt_pk_bf16(p[b], p[b + 1]); w.y = pg8::cvt_pk_bf16(p[b + 2], p[b + 3]); w.z = pg8::cvt_pk_bf16(p[b + 4], p[b + 5]); w.w = pg8::cvt_pk_bf16(p[b + 6], p[b + 7]);
    return __builtin_bit_cast(bf16x8, w);
}
template <int MODE, int DQK>
__device__ __forceinline__ void attn_unit(const bf16_t* Q, int QP, const bf16_t* K, int KP, const bf16_t* V, int VP, const float* CF, bf16_t* Y, int b, int h, int qb, lp_t lds) {
    constexpr int ND = DQK / 16, NCH = DQK / 8, KSZ = NCH * 1024, VOFF = 2 * KSZ, WOFF = VOFF + 16384;
    const int tid = tid_(), lane = tid & 63, r32 = lane & 31, hi = lane >> 5, wid = __builtin_amdgcn_readfirstlane(tid >> 6);
    const int q0 = qb * 256; const long rowbase = (long)b * SEQ;
    const int qw0 = q0 + wid * 32, qrow = qw0 + r32;
    bf16x8 qf[ND];
    { const bf16_t* qp = Q + (size_t)(rowbase + qrow) * QP + h * DQK + hi * 8;
#pragma unroll
      for (int d0 = 0; d0 < ND; ++d0) qf[d0] = *(const bf16x8*)(qp + d0 * 16); }
    const int NT = (q0 + 256) / 64;
    float ct2 = 0.f; if (MODE == 2) ct2 = CF[(size_t)(rowbase + qrow) * 4 + h] * LOG2E;
    f32x16 o0, o1;
#pragma unroll
    for (int r = 0; r < 16; ++r) { o0[r] = 0.f; o1[r] = 0.f; }
    float mhat = 0.f, lsum = 0.f, R = 0.f;
    ALAS float* wsf = (ALAS float*)(lds + WOFF) + wid * 64;
    const bf16_t* kg = K + (size_t)(rowbase + lane) * KP + h * DQK;
    const bf16_t* vg = V + (size_t)(rowbase + 16 * (wid & 3) + (lane >> 2)) * VP + h * 64 + (wid >> 2) * 32 + (lane & 3) * 8;
#define ATT_DMA(tt, buf) do { \
        for (int c_ = wid; c_ < NCH; c_ += 8) __builtin_amdgcn_global_load_lds((const unsigned*)(kg + (size_t)(tt) * 64 * KP + c_ * 8), (ALAS unsigned*)(lds + (buf) * KSZ + c_ * 1024), 16, 0, 0); \
        __builtin_amdgcn_global_load_lds((const unsigned*)(vg + (size_t)(tt) * 64 * VP), (ALAS unsigned*)(lds + VOFF + (buf) * 8192 + wid * 1024), 16, 0, 0); } while (0)
    ATT_DMA(MODE == 1 ? NT - 1 : 0, 0);
    asm volatile("s_waitcnt vmcnt(0)" ::: "memory"); __syncthreads();
#pragma unroll 1
    for (int t = 0; t < NT; ++t) {
        const int tt = MODE == 1 ? NT - 1 - t : t, buf = t & 1;
        if (t + 1 < NT) ATT_DMA(MODE == 1 ? tt - 1 : tt + 1, buf ^ 1);
        const int k0 = 64 * tt;
        const bool active = MODE == 1 ? (k0 < qw0 + 31) : (k0 <= qw0 + 31);
        if (active) {
            const lp_t kb = lds + buf * KSZ + hi * 1024 + r32 * 16;
            f32x16 p0, p1;
            { const float base = MODE == 1 ? 0.f : ct2 - mhat;
#pragma unroll
              for (int r = 0; r < 16; ++r) { p0[r] = base; p1[r] = base; } }
#pragma unroll
            for (int d0 = 0; d0 < ND; ++d0) {
                const bf16x8 b0 = *(const ALAS bf16x8*)(kb + d0 * 2048), b1 = *(const ALAS bf16x8*)(kb + d0 * 2048 + 512);
                p0 = __builtin_amdgcn_mfma_f32_32x32x16_bf16(b0, qf[d0], p0, 0, 0, 0); p1 = __builtin_amdgcn_mfma_f32_32x32x16_bf16(b1, qf[d0], p1, 0, 0, 0);
            }
            const bool band = MODE == 1 ? (k0 + 63 >= qw0) : (k0 + 63 > qw0);
            if (MODE != 1) {
                if (band) {
#pragma unroll
                    for (int r = 0; r < 16; ++r) { const int kv = k0 + crow(r, hi); if (kv > qrow) p0[r] = -INFINITY; if (kv + 32 > qrow) p1[r] = -INFINITY; }
                }
                float rm = fmaxf(p0[0], p1[0]);
#pragma unroll
                for (int r = 1; r < 16; ++r) rm = fmaxf(rm, fmaxf(p0[r], p1[r]));
                rm = fmaxf(rm, __shfl_xor(rm, 32));
                const bool first = (t == 0);
                if (first || __any(rm > THR)) {
                    const float dl = first ? rm : fmaxf(rm, 0.f); const float f = first ? 1.f : __builtin_amdgcn_exp2f(-dl);
                    mhat += dl; lsum *= f;
#pragma unroll
                    for (int r = 0; r < 16; ++r) { p0[r] -= dl; p1[r] -= dl; }
                    if (!first) {
                        if (hi == 0) wsf[r32] = f;
                        asm volatile("s_waitcnt lgkmcnt(0)" ::: "memory");
#pragma unroll
                        for (int r = 0; r < 16; ++r) { const float fr = wsf[crow(r, hi)]; o0[r] *= fr; o1[r] *= fr; }
                        asm volatile("s_waitcnt lgkmcnt(0)" ::: "memory");
                    }
                }
                float sacc = 0.f;
#pragma unroll
                for (int r = 0; r < 16; ++r) { p0[r] = __builtin_amdgcn_exp2f(p0[r]); p1[r] = __builtin_amdgcn_exp2f(p1[r]); sacc += p0[r] + p1[r]; }
                lsum += sacc;
            } else {
                f32x16 L0, L1;
#pragma unroll
                for (int r = 0; r < 16; ++r) {
                    const float z0 = p0[r], z1 = p1[r];
                    L0[r] = -(fmaxf(z0, 0.f) + __builtin_amdgcn_logf(1.f + __builtin_amdgcn_exp2f(-fabsf(z0))));
                    L1[r] = -(fmaxf(z1, 0.f) + __builtin_amdgcn_logf(1.f + __builtin_amdgcn_exp2f(-fabsf(z1))));
                }
                if (band) {
#pragma unroll
                    for (int r = 0; r < 16; ++r) { const int kv = k0 + crow(r, hi); if (kv >= qrow) L0[r] = 0.f; if (kv + 32 >= qrow) L1[r] = 0.f; }
                }
                float G0[4], G1[4], P0[4], P1[4];
#pragma unroll
                for (int g = 0; g < 4; ++g) { G0[g] = (L0[4 * g] + L0[4 * g + 1]) + (L0[4 * g + 2] + L0[4 * g + 3]); G1[g] = (L1[4 * g] + L1[4 * g + 1]) + (L1[4 * g + 2] + L1[4 * g + 3]);
                    P0[g] = __shfl_xor(G0[g], 32); P1[g] = __shfl_xor(G1[g], 32); }
                float run = R;
#pragma unroll
                for (int g = 3; g >= 0; --g) { float s = run + (hi == 0 ? P1[g] : 0.f);
#pragma unroll
                    for (int i = 3; i >= 0; --i) { const float l = L1[4 * g + i]; p1[4 * g + i] = __builtin_amdgcn_exp2f(p1[4 * g + i] + l + s); s += l; }
                    run += G1[g] + P1[g]; }
#pragma unroll
                for (int g = 3; g >= 0; --g) { float s = run + (hi == 0 ? P0[g] : 0.f);
#pragma unroll
                    for (int i = 3; i >= 0; --i) { const float l = L0[4 * g + i]; p0[4 * g + i] = __builtin_amdgcn_exp2f(p0[4 * g + i] + l + s); s += l; }
                    run += G0[g] + P0[g]; }
                R = run;
                if (band) {
#pragma unroll
                    for (int r = 0; r < 16; ++r) { const int kv = k0 + crow(r, hi); if (kv >= qrow) p0[r] = 0.f; if (kv + 32 >= qrow) p1[r] = 0.f; }
                }
            }
            const bf16x8 pa0 = pack8(p0, 0), pa1 = pack8(p0, 8), pa2 = pack8(p1, 0), pa3 = pack8(p1, 8);
            const lp_t vb = lds + VOFF + buf * 8192 + ((lane >> 4) & 1) * 32 + (lane & 3) * 8 + (4 * hi + ((lane & 15) >> 2)) * 64;
#define ATT_PV(o, d0, ks, pa) do { const s16x4 lo_ = vtr(vb + (d0) * 4096 + (ks) * 1024), hi_ = vtr(vb + (d0) * 4096 + (ks) * 1024 + 512); \
                const bf16x8 vf_ = {lo_[0], lo_[1], lo_[2], lo_[3], hi_[0], hi_[1], hi_[2], hi_[3]}; o = __builtin_amdgcn_mfma_f32_32x32x16_bf16(pa, vf_, o, 0, 0, 0); } while (0)
            ATT_PV(o0, 0, 0, pa0); ATT_PV(o1, 1, 0, pa0); ATT_PV(o0, 0, 1, pa1); ATT_PV(o1, 1, 1, pa1);
            ATT_PV(o0, 0, 2, pa2); ATT_PV(o1, 1, 2, pa2); ATT_PV(o0, 0, 3, pa3); ATT_PV(o1, 1, 3, pa3);
#undef ATT_PV
        }
        asm volatile("s_waitcnt vmcnt(0) lgkmcnt(0)" ::: "memory"); __syncthreads();
    }
#undef ATT_DMA
    if (MODE != 1) {
        const float lt = lsum + __shfl_xor(lsum, 32);
        if (hi == 0) wsf[r32] = lt;
        asm volatile("s_waitcnt lgkmcnt(0)" ::: "memory");
#pragma unroll
        for (int r = 0; r < 16; ++r) { const float rl = 1.f / wsf[crow(r, hi)]; o0[r] *= rl; o1[r] *= rl; }
        asm volatile("s_waitcnt lgkmcnt(0)" ::: "memory");
    }
    bf16_t* yb = Y + (size_t)(rowbase + qw0) * 1024 + h * 64 + r32;
#pragma unroll
    for (int r = 0; r < 16; ++r) { bf16_t* yr = yb + (size_t)crow(r, hi) * 1024; yr[0] = (bf16_t)f2bf(o0[r]); yr[32] = (bf16_t)f2bf(o1[r]); }
}
}

typedef PG8_LAS unsigned char* ldsp_t;
constexpr int LI_OFF = 131072 + 1024;

__device__ __forceinline__ void fox_scan(CParams& p, int l, int bh, int lane) {
    const int b = bh >> 2, h = bh & 3; const float* F = (const float*)(p.ws + WS_ROUTE + RT_FXF); float* CF = (float*)(p.ws + WS_ROUTE + RT_CF);
    const float bf = p.b_forget[l * 4 + h];
    float run = 0.f;
    for (int j = 0; j < 64; ++j) run += logsigmoid_(F[((size_t)b * SEQ + lane * 64 + j) * 4 + h] + bf);
    float inc = run;
#pragma unroll
    for (int o = 1; o < 64; o <<= 1) { const float y = __shfl_up(inc, o); if (lane >= o) inc += y; }
    float c = inc - run;
    for (int j = 0; j < 64; ++j) { const size_t idx = ((size_t)b * SEQ + lane * 64 + j) * 4 + h; c += logsigmoid_(F[idx] + bf); CF[idx] = c; }
}
__device__ __forceinline__ void fphase_inproj(CParams& p, int l, ldsp_t lds) {
    pg8::Gemm g{(const bf16_t*)(p.ws + WS_XB), (const bf16_t*)(p.ws + WS_W + W_BT1), T, ZSW, 1024, 1024};
    pg8::StaticOrder S; S.init(T, ZSW, nblk_(), bid_());
    pg8::EpiBf16 E{(bf16_t*)(p.ws + WS_R1 + R1_ZS), ZSW};
    pg8::gemm_phase<pg8::EpiBf16, pg8::StaticOrder, 1024, 1024, true, true>(lds, g, S, E);
    const int tid = tid_(), bb = bid_(), nb = nblk_();
    const int first = nb >= 160 ? 128 : 0;
    for (int bh = bb - first; bh >= 0 && bh < 16; bh += nb) if ((tid >> 6) == 0) fox_scan(p, l, bh, tid & 63);
}
__device__ __forceinline__ void fphase_upproj(CParams& p, ldsp_t lds) {
    pg8::Gemm g{(const bf16_t*)(p.ws + WS_R1 + R1_ZS), (const bf16_t*)(p.ws + WS_W + W_UQ), T, 1024, 256, ZSW};
    pg8::BranchOrder S; S.s.init(T, 1024, nblk_(), bid_()); S.shift = 1;
    pg8::EpiBf16 E{(bf16_t*)(p.ws + WS_R1 + R1_QKVR), 1024};
    pg8::gemm_phase<pg8::EpiBf16, pg8::BranchOrder, 256, ZSW, true, true>(lds, g, S, E);
}
__device__ __forceinline__ void fphase_pgemm(CParams& p, ldsp_t lds) {
    pg8::Gemm g{(const bf16_t*)(p.ws + WS_D), (const bf16_t*)(p.ws + WS_W + W_BR), T, 4096, 256, 1024};
    pg8::BranchOrder S; S.s.init(T, 4096, nblk_(), bid_()); S.shift = 2;
    pg8::EpiBf16 E{(bf16_t*)(p.ws + WS_R1 + R1_PB), 4096};
    pg8::gemm_phase<pg8::EpiBf16, pg8::BranchOrder, 256, 1024, true, true>(lds, g, S, E);
}
__device__ __forceinline__ void fphase_gate(CParams& p, int l, ldsp_t lds) {
    pg8::Gemm g{(const bf16_t*)(p.ws + WS_XB), (const bf16_t*)(p.ws + WS_W + W_GATE), T, 4096, 1024, 1024};
    pg8::StaticOrder S; S.init(T, 4096, nblk_(), bid_());
    pg8::EpiGate E{(const bf16_t*)(p.ws + WS_R1 + R1_PB), (bf16_t*)(p.ws + WS_C), p.b_gate + (size_t)l * 4096};
    pg8::gemm_phase<pg8::EpiGate, pg8::StaticOrder, 1024, 1024, true, true>(lds, g, S, E);
}
__device__ __forceinline__ void fphase_wo(CParams& p, int l, ldsp_t lds) {
    pg8::Gemm g{(const bf16_t*)(p.ws + WS_C), (const bf16_t*)(p.ws + WS_W + W_O), T, 1024, 1024, 1024};
    pg8::StaticOrder S; S.init(T, 1024, nblk_(), bid_());
    pg8::EpiRes E{l == 0 ? p.x : p.out, p.out, ALPHA};
    pg8::gemm_phase<pg8::EpiRes, pg8::StaticOrder, 1024, 1024, true, true>(lds, g, S, E);
}
__device__ __forceinline__ void fphase_moeup(CParams& p, ldsp_t lds, float* ldsf) {
    int* Li = (int*)(ldsf + LI_OFF / 4);
    expert_offsets(p, 0, Li);
    pg8::Gemm g{(const bf16_t*)(p.ws + WS_R1 + R1_XG), (const bf16_t*)(p.ws + WS_W + W_GU), 0, 512, 1024, 1024};
    pg8::MoeOrder S{Li, 2, nblk_(), bid_(), (long)512 * 1024 * 2};
    pg8::EpiSwiglu E{(bf16_t*)(p.ws + WS_R1 + R1_HID)};
    pg8::gemm_phase<pg8::EpiSwiglu, pg8::MoeOrder, 1024, 1024, true, true>(lds, g, S, E);
}
__device__ __forceinline__ void fphase_moedown(CParams& p, ldsp_t lds, float* ldsf) {
    int* Li = (int*)(ldsf + LI_OFF / 4);
    expert_offsets(p, 0, Li);
    pg8::Gemm g{(const bf16_t*)(p.ws + WS_R1 + R1_HID), (const bf16_t*)(p.ws + WS_W + W_D), 0, 1024, 256, 256};
    pg8::MoeOrder S{Li, 4, nblk_(), bid_(), (long)1024 * 256 * 2};
    pg8::EpiBf16 E{(bf16_t*)(p.ws + WS_R1 + R1_YSL), 1024};
    pg8::gemm_phase<pg8::EpiBf16, pg8::MoeOrder, 256, 256, true, true>(lds, g, S, E);
}


__device__ __forceinline__ void fphase_attn(CParams& p, ldsp_t ldsp, float* ldsf) {
    const int tid = tid_();
    const bf16_t* ZS = (const bf16_t*)(p.ws + WS_R1 + R1_ZS); bf16_t* YS = (bf16_t*)(p.ws + WS_D);
    const bf16_t* Qm = (const bf16_t*)(p.ws + WS_C + C_QM); const bf16_t* Km = (const bf16_t*)(p.ws + WS_C + C_KM); const bf16_t* Vm = (const bf16_t*)(p.ws + WS_C + C_VM);
    const bf16_t* QF = (const bf16_t*)(p.ws + WS_E + E_QF); const bf16_t* KF = (const bf16_t*)(p.ws + WS_E + E_KF);
    const float* CF = (const float*)(p.ws + WS_ROUTE + RT_CF);
    unsigned* ctr = (unsigned*)(p.ws + WS_CTL + CTL_QUEUE);
    volatile int* su = (volatile int*)(ldsf + 131072 / 4);
    for (;;) {
        __syncthreads();
        if (tid == 0) su[0] = (int)atomicAdd(ctr, 1u);
        __syncthreads();
        const int k = su[0];
        if (k >= 768) break;
        const int cls = k >> 4, bh = k & 15, qb = 15 - cls / 3, v = cls % 3, b = bh >> 2, h = bh & 3;
        if (v == 0) { if constexpr ((FAST & F_ASB) != 0) att::attn_unit<1, 64>(ZS + C_SBQ, ZSW, ZS + C_SBK, ZSW, ZS + C_SBV, ZSW, nullptr, YS + 256, b, h, qb, ldsp); }
        else if (v == 1) { if constexpr ((FAST & F_AMLA) != 0) att::attn_unit<0, 96>(Qm, 384, Km, 384, Vm, 256, nullptr, YS, b, h, qb, ldsp); }
        else { if constexpr ((FAST & F_AFOX) != 0) att::attn_unit<2, 80>(QF, 320, KF, 320, ZS + C_FXV, ZSW, CF, YS + 768, b, h, qb, ldsp); }
    }
    __syncthreads();
    if constexpr ((FAST & F_AMLA) == 0) attn_naive<0, 96>(Qm, 384, Km, 384, Vm, 256, nullptr, YS, ldsf);
    if constexpr ((FAST & F_ASB) == 0) attn_naive<1, 64>(ZS + C_SBQ, ZSW, ZS + C_SBK, ZSW, ZS + C_SBV, ZSW, nullptr, YS + 256, ldsf);
    if constexpr ((FAST & F_AFOX) == 0) attn_naive<2, 64>(ZS + C_FXQ, ZSW, ZS + C_FXK, ZSW, ZS + C_FXV, ZSW, CF, YS + 768, ldsf);
}


#define LAS __attribute__((address_space(3)))
#define XB_TMO      128
#define XB_XCNT(j)  (256  + 64 * (j))
#define XB_XSUB(j)  (1280 + 64 * (j))
#define XB_XGEN(j)  (2304 + 64 * (j))
#define XB_TOP      3328
#define XB_TOPGEN   3392
#define XCD_BAR_WORDS 3456
#define XB_SPIN_CAP (1u << 18)

__device__ __forceinline__ unsigned xb_ld(unsigned* p)              { return __hip_atomic_load(p, __ATOMIC_RELAXED, __HIP_MEMORY_SCOPE_AGENT); }
__device__ __forceinline__ unsigned xb_add(unsigned* p, unsigned v) { return __hip_atomic_fetch_add(p, v, __ATOMIC_RELAXED, __HIP_MEMORY_SCOPE_AGENT); }
__device__ __forceinline__ unsigned xb_xcc_id() { return (unsigned)__builtin_amdgcn_s_getreg((3 << 11) | 20) & 0xFu; }
#define XB_SPIN(cond, bar) do { unsigned _sp = 0; while (cond) { __builtin_amdgcn_s_sleep(1); \
    if ((++_sp & 255u) == 0u) { if (xb_ld(&(bar)[XB_TMO])) break; if (_sp > XB_SPIN_CAP) { atomicAdd(&(bar)[XB_TMO], 1u); break; } } } } while (0)

struct XcdBarrier {
    unsigned* bar; unsigned x;
    volatile LAS unsigned* st;
};

__device__ __forceinline__ XcdBarrier xcd_barrier_post(unsigned* bar, volatile LAS unsigned* st) {
    XcdBarrier b; b.bar = bar; b.x = xb_xcc_id(); b.st = st;
    if (threadIdx.x == 0) (void)xb_add(&bar[XB_XCNT(b.x)], 1u);
    return b;
}
__device__ __forceinline__ void xcd_barrier_complete(unsigned* bar, unsigned x, unsigned& nloc, unsigned& nx) {
    const unsigned G = gridDim.x * gridDim.y * gridDim.z;
    unsigned sum, cnt, mine, sp = 0u;
    for (;;) {
        sum = 0u; cnt = 0u; mine = 0u;
#pragma unroll
        for (unsigned j = 0; j < 16; ++j) { const unsigned c = xb_ld(&bar[XB_XCNT(j)]); sum += c; cnt += (c > 0u) ? 1u : 0u; mine = (j == x) ? c : mine; }
        if (sum == G) break;
        __builtin_amdgcn_s_sleep(1);
        if ((++sp & 255u) == 0u) { if (xb_ld(&bar[XB_TMO])) break; if (sp > XB_SPIN_CAP) { atomicAdd(&bar[XB_TMO], 1u); break; } }
    }
    nloc = mine > 0u ? mine : 1u; nx = cnt > 0u ? cnt : 1u;
}

__device__ __forceinline__ void xcd_barrier(const XcdBarrier& b) {
    asm volatile("s_waitcnt vmcnt(0)" ::: "memory");
    __syncthreads();
    if (threadIdx.x == 0) {
        unsigned* bar = b.bar;
        __builtin_amdgcn_s_waitcnt(0);
        unsigned nloc = b.st[0], nx = b.st[1];
        if (nloc == 0u) { xcd_barrier_complete(bar, b.x, nloc, nx); b.st[0] = nloc; b.st[1] = nx; }
        const unsigned old = xb_add(&bar[XB_XSUB(b.x)], 1u);
        const unsigned gen = old / nloc;
        if (old + 1u == (gen + 1u) * nloc) {
            __builtin_amdgcn_fence(__ATOMIC_RELEASE, "agent");
            asm volatile("s_waitcnt vmcnt(0)" ::: "memory");
            const unsigned og = xb_add(&bar[XB_TOP], 1u);
            const unsigned tg = og / nx;
            if (og + 1u == (tg + 1u) * nx) xb_add(&bar[XB_TOPGEN], 1u);
            else XB_SPIN(xb_ld(&bar[XB_TOPGEN]) == tg, bar);
            __builtin_amdgcn_fence(__ATOMIC_ACQUIRE, "agent");
            xb_add(&bar[XB_XGEN(b.x)], 1u);
            asm volatile("s_waitcnt vmcnt(0)" ::: "memory");
        } else {
            XB_SPIN(xb_ld(&bar[XB_XGEN(b.x)]) == gen, bar);
            __builtin_amdgcn_fence(__ATOMIC_ACQUIRE, "agent");
            asm volatile("s_waitcnt vmcnt(0)" ::: "memory");
        }
    }
    __syncthreads();
}

enum { PH_CONVW = 0, PH_INPROJ, PH_UPPROJ, PH_PREP, PH_ATTN, PH_PGEMM, PH_GATE, PH_COMBINE, PH_WO, PH_LN1, PH_GATHER, PH_MOEUP, PH_SWIGLU, PH_MOEDOWN, PH_LN2, PH_N };
__device__ __forceinline__ void run_phase(CParams& p, int ph, int l, float* lds, ldsp_t ldsp) {
    switch (ph) {
        case PH_CONVW: phase_convw(p, l, lds); if (l == 0) phase_convx(p); break;
        case PH_INPROJ: if constexpr ((FAST & F_INPROJ) != 0) fphase_inproj(p, l, ldsp); else phase_inproj(p, lds); break;
        case PH_UPPROJ:
            if constexpr ((FAST & F_INPROJ) == 0) { const int tid = tid_(); for (int bh = bid_(); bh < 16; bh += nblk_()) if ((tid >> 6) == 0) fox_scan(p, l, bh, tid & 63); }
            if constexpr ((FAST & F_UPPROJ) != 0) fphase_upproj(p, ldsp); else phase_upproj(p, l, lds); break;
        case PH_PREP: phase_prep(p, l, lds); break;
        case PH_ATTN: if constexpr ((FAST & (F_AMLA | F_ASB | F_AFOX)) != 0) fphase_attn(p, ldsp, lds); else phase_attn(p, lds); break;
        case PH_PGEMM: if constexpr ((FAST & F_PGEMM) != 0) fphase_pgemm(p, ldsp); else phase_pgemm(p, lds); break;
        case PH_GATE: if constexpr ((FAST & F_GATE) != 0) fphase_gate(p, l, ldsp); else phase_gate(p, l, lds); break;
        case PH_COMBINE: if constexpr ((FAST & F_GATE) == 0) phase_combine(p); break;
        case PH_WO: if constexpr ((FAST & F_WO) != 0) fphase_wo(p, l, ldsp); else phase_wo(p, l, lds); break;
        case PH_LN1: phase_ln1route(p, l, lds); break;
        case PH_GATHER: phase_gather(p, lds); break;
        case PH_MOEUP: if constexpr ((FAST & F_MOEUP) != 0) fphase_moeup(p, ldsp, lds); else phase_moeup(p, lds); break;
        case PH_SWIGLU: if constexpr ((FAST & F_MOEUP) == 0) phase_swiglu(p, lds); break;
        case PH_MOEDOWN: if constexpr ((FAST & F_MOEDOWN) != 0) fphase_moedown(p, ldsp, lds); else phase_moedown(p, lds); break;
        case PH_LN2: phase_ln2(p, l); break;
    }
}
__global__ void __launch_bounds__(NTHREADS, 2) mega(Params p) {
    extern __shared__ __attribute__((aligned(16))) unsigned char lds_raw[];
    cg::grid_group grid = cg::this_grid();
    volatile LAS unsigned* st = (volatile LAS unsigned*)((LAS unsigned char*)lds_raw + (LDS_BYTES - 256));
    if (threadIdx.x < 16) st[threadIdx.x] = 0u;
    __syncthreads();
    const XcdBarrier bar = xcd_barrier_post((unsigned*)(p.ws + WS_CTL + CTL_BAR), st);
    bool first_seam = true;
#pragma unroll 1
    for (int l = 0; l < 2; ++l) {
#pragma unroll 1
        for (int ph = 0; ph < PH_N; ++ph) {
            if ((ph == PH_COMBINE && (FAST & F_GATE) != 0) || (ph == PH_SWIGLU && (FAST & F_MOEUP) != 0)) continue;
            CParams* pp = (CParams*)__builtin_amdgcn_kernarg_segment_ptr();
            asm volatile("" : "+s"(pp));
            run_phase(*pp, ph, l, (float*)lds_raw, (ldsp_t)lds_raw);
            if (l == 1 && ph == PH_N - 1) break;
            if (first_seam) { grid.sync(); first_seam = false; }
            else xcd_barrier(bar);
        }
    }
}

extern "C" void kernel_launch(void* const* d_in, const int* in_sizes, int n_in, void* d_out, int out_size, void* d_ws, size_t ws_size, hipStream_t stream) {
    static int grid = 0;
    if (grid == 0) {
        if (n_in != 26 || out_size != T * D || ws_size < WS_END) { fprintf(stderr, "kernel_launch: unexpected shapes (n_in %d out %d ws %zu, need %zu)\n", n_in, out_size, ws_size, (size_t)WS_END); grid = -1; return; }
        int dev = 0, cus = 0, per_cu = 0;
        (void)hipGetDevice(&dev); (void)hipDeviceGetAttribute(&cus, hipDeviceAttributeMultiprocessorCount, dev);
        (void)hipFuncSetAttribute((const void*)mega, hipFuncAttributeMaxDynamicSharedMemorySize, LDS_BYTES);
        if (hipOccupancyMaxActiveBlocksPerMultiprocessor(&per_cu, (const void*)mega, NTHREADS, LDS_BYTES) != hipSuccess || per_cu < 1) { fprintf(stderr, "kernel_launch: occupancy query says %d\n", per_cu); grid = -1; return; }
        grid = cus;
    }
    if (grid < 0) return;
    Params p{};
    const float** pf = (const float**)&p;
    p.x = (const float*)d_in[0]; p.pos = (const int*)d_in[1];
    for (int i = 2; i < 26; ++i) pf[i] = (const float*)d_in[i];
    p.out = (float*)d_out; p.ws = (unsigned char*)d_ws;
    if (hipMemsetAsync((unsigned char*)d_ws + WS_CTL + CTL_BAR, 0, CTL_BAR_BYTES, stream) != hipSuccess) { fprintf(stderr, "kernel_launch: memset of the barrier words failed\n"); return; }
    void* args[] = {&p};
    hipError_t e = hipLaunchCooperativeKernel((const void*)mega, dim3(grid), dim3(NTHREADS), args, LDS_BYTES, stream);
    if (e != hipSuccess) fprintf(stderr, "cooperative launch failed: %s (grid %d)\n", hipGetErrorString(e), grid);
}
```

```cpp
#include <hip/hip_runtime.h>
#include <hip/hip_cooperative_groups.h>
#include <cstdio>
#include <cstdint>
namespace cg = cooperative_groups;

typedef unsigned short bf16_t;
typedef float f32x4 __attribute__((ext_vector_type(4)));
typedef unsigned u32x4 __attribute__((ext_vector_type(4)));
typedef unsigned u32x2 __attribute__((ext_vector_type(2)));

constexpr int NB = 4, SEQ = 4096, T = NB * SEQ, D = 1024, NIN = 6564, ZSW = 2816;
constexpr int NEXP = 32, EFF = 256, MAXSLOT = 40960;
constexpr int C_CQ = 0, C_CKV = 256, C_KR = 384, C_SBQ = 416, C_SBK = 672, C_SBV = 928, C_CVA = 1184, C_CVG = 1440,
              C_FXQ = 1696, C_FXK = 2016, C_FXV = 2336, C_ZEND = 2592;
constexpr int S_FXQ = 1696, S_FXK = 1952, S_FXV = 2208, S_FXF = 2464, S_GATE = 2468;
constexpr float LOG2E = 1.4426950408889634f;
constexpr float C2_64 = 0.125f * LOG2E;
constexpr float C2_M = 0.10206207261596575f * LOG2E;
constexpr float ALPHA = 1.4142135623730951f;
constexpr float EPS = 1e-5f;
constexpr int NTHREADS = 512, NWAVES = 8;
constexpr unsigned F_INPROJ = 1, F_UPPROJ = 2, F_PGEMM = 4, F_GATE = 8, F_WO = 16, F_MOEUP = 32, F_MOEDOWN = 64, F_AMLA = 128, F_ASB = 256, F_AFOX = 512;
#ifndef FAST_MASK
#define FAST_MASK 1023
#endif
constexpr unsigned FAST = FAST_MASK;
constexpr int LDS_BYTES = 147456;

constexpr size_t MiB = 1u << 20;
constexpr size_t WS_CTL = 0;
constexpr size_t WS_ROUTE = 1 * MiB;
constexpr size_t RT_TOKE = 0, RT_TOKW = 131072, RT_TOKP = 262144, RT_TOKS = 393216, RT_SLOTW = 524288, RT_FXF = 786432, RT_CF = 1048576, RT_WT = 1310720;
constexpr size_t WS_W = 3 * MiB;
constexpr size_t W_BT1 = 0, W_GATE = 6 * MiB, W_UQ = 14 * MiB, W_UKV = W_UQ + 262144, W_BR = W_UKV + 262144, W_O = W_BR + 2 * MiB, W_GU = W_O + 2 * MiB, W_D = W_GU + 32 * MiB;
static_assert(W_D + 16 * MiB <= 67 * MiB && (size_t)ZSW * 1024 * 2 <= W_GATE, "weights");
constexpr size_t WS_XB = 70 * MiB;
constexpr size_t WS_R1 = 102 * MiB;
constexpr size_t R1_ZS = 0, R1_QKVR = 88 * MiB, R1_PB = 0, R1_XG = 0, R1_HID = 80 * MiB, R1_YSL = 0;
constexpr size_t WS_C = 230 * MiB;
constexpr size_t C_QM = 0, C_KM = 12 * MiB, C_VM = 24 * MiB;
constexpr size_t WS_D = 262 * MiB;
constexpr size_t WS_E = 294 * MiB;
constexpr size_t WS_END = 296 * MiB;
constexpr size_t CTL_BAR = 131072, CTL_BAR_BYTES = 16384;
constexpr size_t CTL_QUEUE = 65536;

struct Params {
    const float* x; const int* pos; const float* w_in; const float* b_gate; const float* b_forget;
    const float* q_norm; const float* kv_norm; const float* w_uq; const float* w_ukv;
    const float* conv_w; const float* conv_b; const float* conv_g; const float* conv_bb;
    const float* w_branch; const float* w_o; const float* ln1_g; const float* ln1_b;
    const float* w_rg; const float* b_rg; const float* w_re; const float* b_re;
    const float* w_eg; const float* w_eu; const float* w_ed; const float* ln2_g; const float* ln2_b;
    float* out; unsigned char* ws; int phase; int layer;
};
typedef const __attribute__((address_space(4))) Params CParams;

__device__ __forceinline__ unsigned f2bf(float f) { unsigned u = __float_as_uint(f); return (u + 0x7fffu + ((u >> 16) & 1u)) >> 16; }
__device__ __forceinline__ float bf2f(unsigned b) { return __uint_as_float(b << 16); }
__device__ __forceinline__ unsigned pk2(float lo, float hi) { return f2bf(lo) | (f2bf(hi) << 16); }
__device__ __forceinline__ float wave_sum(float v) {
#pragma unroll
    for (int o = 1; o < 64; o <<= 1) v += __shfl_xor(v, o);
    return v;
}
__device__ __forceinline__ float wave_max(float v) {
#pragma unroll
    for (int o = 1; o < 64; o <<= 1) v = fmaxf(v, __shfl_xor(v, o));
    return v;
}
__device__ __forceinline__ float sigmoidf_(float x) { return 1.f / (1.f + __expf(-x)); }
#define LDS_FENCE() asm volatile("s_waitcnt lgkmcnt(0)" ::: "memory")
__device__ __forceinline__ int tid_() { int t = threadIdx.x; asm volatile("" : "+v"(t)); return t; }
__device__ __forceinline__ int bid_() { int t = blockIdx.x; asm volatile("" : "+s"(t)); return t; }
__device__ __forceinline__ int nblk_() { int t = gridDim.x; asm volatile("" : "+s"(t)); return t; }

template <class F>
__device__ __forceinline__ void tr_item(const float* W, int ldw, bf16_t* out, int Kd, int r0, int k0, const float* ks, F f, float* scr, int lane) {
    const int n4 = (lane & 15) * 4, kr = lane >> 4, r = r0 + n4, c = f.col(r); const float s = f.rs(r);
    f32x4 v[16];
#pragma unroll
    for (int i = 0; i < 16; ++i) { const int kk = 4 * i + kr; v[i] = (f32x4){0.f, 0.f, 0.f, 0.f}; if (c >= 0) { v[i] = *(const f32x4*)(W + (size_t)(k0 + kk) * ldw + c) * s; if (ks) v[i] = v[i] * ks[k0 + kk]; } }
#pragma unroll
    for (int i = 0; i < 16; ++i) { float* d = scr + (4 * i + kr) * 65 + n4; d[0] = v[i].x; d[1] = v[i].y; d[2] = v[i].z; d[3] = v[i].w; }
    LDS_FENCE();
    const int cc = lane & 7;
#pragma unroll
    for (int j = 0; j < 8; ++j) {
        const int n = (lane >> 3) + 8 * j; const float* s8 = scr + (8 * cc) * 65 + n;
        u32x4 o; o.x = pk2(s8[0], s8[65]); o.y = pk2(s8[130], s8[195]); o.z = pk2(s8[260], s8[325]); o.w = pk2(s8[390], s8[455]);
        *(u32x4*)(out + (size_t)(r0 + n) * Kd + k0 + 8 * cc) = o;
    }
    LDS_FENCE();
}
struct MapBt1 {
    __device__ int col(int r) const {
        if (r < C_FXQ) return r;
        if (r < C_FXK) { const int q = r - C_FXQ, h = q / 80, d = q % 80; return d < 64 ? S_FXQ + h * 64 + d : -1; }
        if (r < C_FXV) { const int q = r - C_FXK, h = q / 80, d = q % 80; return d < 64 ? S_FXK + h * 64 + d : -1; }
        if (r < C_ZEND) return S_FXV + (r - C_FXV);
        return -1; }
    __device__ float rs(int r) const { return ((r >= C_SBQ && r < C_SBK) || (r >= C_FXQ && r < C_FXK)) ? C2_64 : 1.f; } };
struct MapGate { __device__ int col(int r) const { return S_GATE + r; } __device__ float rs(int) const { return 1.f; } };
struct MapGateP { __device__ int col(int r) const { const int pn = r >> 8, cl = r & 255; return S_GATE + (2 * (cl >> 7) + ((cl >> 4) & 1)) * 1024 + pn * 64 + 16 * ((cl >> 5) & 3) + (cl & 15); } __device__ float rs(int) const { return 1.f; } };
struct MapLim { int lim; __device__ int col(int r) const { return r < lim ? r : -1; } __device__ float rs(int) const { return 1.f; } };
struct MapGU { __device__ int col(int r) const { return ((r >> 8) << 7) + (r & 127); } __device__ float rs(int) const { return 1.f; } };

__device__ __forceinline__ void phase_convw(CParams& p, int l, float* lds) {
    const int tid = tid_(), lane = tid & 63, wave = tid >> 6;
    float* scr = lds + wave * (64 * 65);
    unsigned char* W = p.ws + WS_W;
    const int gw = bid_() * NWAVES + wave, NGW = nblk_() * NWAVES;
    constexpr int I_A = (ZSW / 64) * 16, I_B = 64 * 16, I_C = 8 * 4, I_Dd = 8 * 4, I_E = 4 * 64, I_F = 16 * 16, I_G = 32 * 128, I_H = 32 * 64;
    constexpr int NIT = I_A + I_B + I_C + I_Dd + I_E + I_F + I_G + I_H;
    for (int it = gw; it < NIT; it += NGW) {
        int r = it;
        if (r < I_A) { tr_item(p.w_in + (size_t)l * D * NIN, NIN, (bf16_t*)(W + W_BT1), 1024, (r >> 4) * 64, (r & 15) * 64, nullptr, MapBt1{}, scr, lane); continue; } r -= I_A;
        if (r < I_B) { if constexpr ((FAST & F_GATE) != 0) tr_item(p.w_in + (size_t)l * D * NIN, NIN, (bf16_t*)(W + W_GATE), 1024, (r >> 4) * 64, (r & 15) * 64, nullptr, MapGateP{}, scr, lane);
                       else tr_item(p.w_in + (size_t)l * D * NIN, NIN, (bf16_t*)(W + W_GATE), 1024, (r >> 4) * 64, (r & 15) * 64, nullptr, MapGate{}, scr, lane); continue; } r -= I_B;
        if (r < I_C) { tr_item(p.w_uq + (size_t)l * 256 * 384, 384, (bf16_t*)(W + W_UQ), 256, (r >> 2) * 64, (r & 3) * 64, p.q_norm + l * 256, MapLim{384}, scr, lane); continue; } r -= I_C;
        if (r < I_Dd) { const int kb = r & 3; if (kb < 2) tr_item(p.w_ukv + (size_t)l * 128 * 512, 512, (bf16_t*)(W + W_UKV), 256, (r >> 2) * 64, kb * 64, p.kv_norm + l * 128, MapLim{512}, scr, lane);
            else tr_item(p.w_ukv, 512, (bf16_t*)(W + W_UKV), 256, (r >> 2) * 64, kb * 64, nullptr, MapLim{0}, scr, lane); continue; } r -= I_Dd;
        if (r < I_E) { const int n = r >> 6, q = r & 63; tr_item(p.w_branch + ((size_t)l * 4 + n) * 256 * 1024, 1024, (bf16_t*)(W + W_BR) + (size_t)n * 1024 * 256, 256, (q >> 2) * 64, (q & 3) * 64, nullptr, MapLim{1024}, scr, lane); continue; } r -= I_E;
        if (r < I_F) { tr_item(p.w_o + (size_t)l * 1024 * 1024, 1024, (bf16_t*)(W + W_O), 1024, (r >> 4) * 64, (r & 15) * 64, nullptr, MapLim{1024}, scr, lane); continue; } r -= I_F;
        if (r < I_G) { const int e = r >> 7, q = r & 127, rb = q >> 4, kb = q & 15; const int r0 = rb * 64; const bool up = (r0 >> 7) & 1;
            const float* src = (up ? p.w_eu : p.w_eg) + ((size_t)l * NEXP + e) * 1024 * 256;
            tr_item(src, 256, (bf16_t*)(W + W_GU) + (size_t)e * 512 * 1024, 1024, r0, kb * 64, nullptr, MapGU{}, scr, lane); continue; } r -= I_G;
        { const int e = r >> 6, q = r & 63; tr_item(p.w_ed + ((size_t)l * NEXP + e) * 256 * 1024, 1024, (bf16_t*)(W + W_D) + (size_t)e * 1024 * 256, 256, (q >> 2) * 64, (q & 3) * 64, nullptr, MapLim{1024}, scr, lane); }
    }
    float* wT = (float*)(p.ws + WS_ROUTE + RT_WT);
    for (int jr = NGW - 1 - gw; jr < 36; jr += NGW) {
        const float* src = jr < 4 ? p.w_rg + (size_t)l * 1024 * 4 + jr : p.w_re + (size_t)l * 1024 * 32 + (jr - 4); const int ld = jr < 4 ? 4 : 32;
        for (int i = 0; i < 16; ++i) wT[jr * 1024 + i * 64 + lane] = src[(size_t)(i * 64 + lane) * ld];
        if (lane == 0) wT[36 * 1024 + jr] = jr < 4 ? p.b_rg[l * 4 + jr] : p.b_re[l * 32 + jr - 4];
    }
}

__device__ __forceinline__ void emit_xrow(CParams& p, const f32x4 (&v)[4], int m, int l, int lane) {
    u32x2* o8 = (u32x2*)((bf16_t*)(p.ws + WS_XB) + (size_t)m * D) + lane;
    f32x4 acc = {0.f, 0.f, 0.f, 0.f};
    const float* wf = p.w_in + (size_t)l * D * NIN + S_FXF;
#pragma unroll
    for (int j = 0; j < 4; ++j) {
        u32x2 w; w.x = pk2(v[j].x, v[j].y); w.y = pk2(v[j].z, v[j].w); o8[64 * j] = w;
        const int k = 256 * j + 4 * lane;
        acc += v[j].x * *(const f32x4*)(wf + (size_t)(k + 0) * NIN);
        acc += v[j].y * *(const f32x4*)(wf + (size_t)(k + 1) * NIN);
        acc += v[j].z * *(const f32x4*)(wf + (size_t)(k + 2) * NIN);
        acc += v[j].w * *(const f32x4*)(wf + (size_t)(k + 3) * NIN);
    }
    acc.x = wave_sum(acc.x); acc.y = wave_sum(acc.y); acc.z = wave_sum(acc.z); acc.w = wave_sum(acc.w);
    if (lane == 0) *(f32x4*)((float*)(p.ws + WS_ROUTE + RT_FXF) + (size_t)m * 4) = acc;
}
__device__ __forceinline__ void phase_convx(CParams& p) {
    const int tid = tid_(), lane = tid & 63, wave = tid >> 6;
    const int gw = bid_() * NWAVES + wave, NGW = nblk_() * NWAVES;
    for (int m = gw; m < T; m += NGW) {
        const f32x4* xr = (const f32x4*)(p.x + (size_t)m * D) + lane; f32x4 v[4];
#pragma unroll
        for (int j = 0; j < 4; ++j) v[j] = xr[64 * j];
        emit_xrow(p, v, m, 0, lane);
        if (lane < 16) { float sn, cs; const float inv = exp2f(-(float)lane * (13.287712379549449f / 16.f)); sincosf((float)p.pos[m] * inv, &sn, &cs);
            float* rp = (float*)(p.ws + WS_E) + (size_t)m * 32; rp[lane] = cs; rp[16 + lane] = sn; }
    }
}

namespace pg8 {
#define PG8_LAS __attribute__((address_space(3)))
typedef unsigned short bf16_t;
typedef short bf16x8 __attribute__((ext_vector_type(8)));
typedef float f32x4 __attribute__((ext_vector_type(4)));
typedef unsigned u32x4 __attribute__((ext_vector_type(4)));
constexpr int BM = 256, BK = 64, HALF = 128, HTB = HALF * BK * 2  , STAGE_BYTES = 8 * HTB, NXCD = 8, WGM = 8;

__host__ __device__ __forceinline__ int lds_byte(int r, int c) { const int st = (r >> 4) * 2 + (c >> 5), rr = r & 15, cc = c & 31, ob = rr * 64 + cc * 2; return st * 1024 + (ob ^ (((ob >> 9) & 1) << 5)); }
__host__ __device__ __forceinline__ void stage_rc(int b, int& R, int& C) { const int st = b / 1024, sb = b % 1024, swz = sb ^ (((sb >> 9) & 1) << 5); R = (st >> 1) * 16 + swz / 64; C = (st & 1) * 32 + (swz % 64) / 2; }
__host__ __device__ __forceinline__ int perm32(int rho) { const int n = rho >> 4, i = rho & 15; return 8 * (i >> 2) + 4 * n + (i & 3); }

struct Unit { int pm, pn; long aoff, boff; };
struct Gemm { const bf16_t* A; const bf16_t* Bt; int M, N, K, lda; };

struct StaticOrder {
    int nM, nN, nwg, G, c;
    __host__ __device__ void init(int M, int N, int G_, int c_) { nM = M / BM; nN = N / BM; nwg = nM * nN; G = G_; c = c_; }
    __host__ __device__ bool next(int i, Unit& u) const {
        const long L = (long)i * G + c; if (L >= nwg) return false;
        int wgid = (int)L; { const int q = nwg / NXCD, r = nwg % NXCD, xcd = wgid % NXCD, off = wgid / NXCD; wgid = (xcd < r ? xcd * (q + 1) : r * (q + 1) + (xcd - r) * q) + off; }
        const int nig = WGM * nN, gid = wgid / nig, fm = gid * WGM, gsz = (nM - fm) < WGM ? (nM - fm) : WGM;
        u.pm = fm + ((wgid % nig) % gsz); u.pn = (wgid % nig) / gsz; u.aoff = 0; u.boff = 0; return true;
    }
    __device__ __forceinline__ void a_ready(const Unit&) const {}
    __device__ __forceinline__ void done(const Unit&) const {}
};


__device__ __forceinline__ unsigned cvt_pk_bf16(float lo, float hi) { unsigned r; asm volatile("v_cvt_pk_bf16_f32 %0, %1, %2" : "=v"(r) : "v"(lo), "v"(hi)); return r; }
__device__ __forceinline__ float sig_(float x) { return __builtin_amdgcn_rcpf(1.f + __builtin_amdgcn_exp2f(-1.4426950408889634f * x)); }
struct EpiBf16 {
    static constexpr bool PERM = true, AFTER_DRAIN = false;
    bf16_t* O; int ldc;
    __device__ __forceinline__ void operator()(const f32x4 (&acc)[2][2][4][2], const Unit& u, int wr, int wc, int fr, int fq) const {
        const int row0 = u.pm * BM + wr * 64 + fr, col0 = u.pn * BM + wc * 32 + 8 * fq;
#pragma unroll
        for (int ai = 0; ai < 2; ++ai)
#pragma unroll
            for (int m = 0; m < 4; ++m) { const int row = row0 + ai * HALF + m * 16; bf16_t* rowp = O + (size_t)row * ldc + col0;
#pragma unroll
                for (int bj = 0; bj < 2; ++bj) { const f32x4 v0 = acc[ai][bj][m][0], v1 = acc[ai][bj][m][1];
                    u32x4 w; w.x = cvt_pk_bf16(v0[0], v0[1]); w.y = cvt_pk_bf16(v0[2], v0[3]); w.z = cvt_pk_bf16(v1[0], v1[1]); w.w = cvt_pk_bf16(v1[2], v1[3]);
                    *(u32x4*)(rowp + bj * HALF) = w; } }
    }
};
struct EpiGate {
    static constexpr bool PERM = false, AFTER_DRAIN = false;
    const bf16_t* PB; bf16_t* MG; const float* bg;
    __device__ __forceinline__ void operator()(const f32x4 (&acc)[2][2][4][2], const Unit& u, int wr, int wc, int fr, int fq) const {
        typedef unsigned u32x2_t __attribute__((ext_vector_type(2)));
        const int row0 = u.pm * BM + wr * 64 + fr, d0 = u.pn * 64 + wc * 16 + fq * 4;
        f32x4 bv[2][2];
#pragma unroll
        for (int bj = 0; bj < 2; ++bj)
#pragma unroll
            for (int n = 0; n < 2; ++n) bv[bj][n] = *(const f32x4*)(bg + (2 * bj + n) * 1024 + d0);
#pragma unroll
        for (int ai = 0; ai < 2; ++ai)
#pragma unroll
            for (int m = 0; m < 4; ++m) { const int row = row0 + ai * HALF + m * 16; const bf16_t* pr = PB + (size_t)row * 4096 + d0; f32x4 s = {0.f, 0.f, 0.f, 0.f};
#pragma unroll
                for (int bj = 0; bj < 2; ++bj)
#pragma unroll
                    for (int n = 0; n < 2; ++n) { const u32x2_t pv = *(const u32x2_t*)(pr + (2 * bj + n) * 1024); const f32x4 a = acc[ai][bj][m][n] + bv[bj][n];
                        s[0] += sig_(a[0]) * __uint_as_float(pv.x << 16); s[1] += sig_(a[1]) * __uint_as_float(pv.x & 0xffff0000u);
                        s[2] += sig_(a[2]) * __uint_as_float(pv.y << 16); s[3] += sig_(a[3]) * __uint_as_float(pv.y & 0xffff0000u); }
                u32x2_t w; w.x = cvt_pk_bf16(s[0], s[1]); w.y = cvt_pk_bf16(s[2], s[3]); *(u32x2_t*)(MG + (size_t)row * 1024 + d0) = w; }
    }
};
struct EpiRes {
    static constexpr bool PERM = false, AFTER_DRAIN = false;
    const float* base; float* out; float alpha;
    __device__ __forceinline__ void operator()(const f32x4 (&acc)[2][2][4][2], const Unit& u, int wr, int wc, int fr, int fq) const {
        const int row0 = u.pm * BM + wr * 64 + fr, col0 = u.pn * BM + wc * 32 + 4 * fq;
#pragma unroll
        for (int ai = 0; ai < 2; ++ai)
#pragma unroll
            for (int m = 0; m < 4; ++m) { const size_t off = (size_t)(row0 + ai * HALF + m * 16) * 1024 + col0;
#pragma unroll
                for (int bj = 0; bj < 2; ++bj)
#pragma unroll
                    for (int n = 0; n < 2; ++n) { const f32x4 b = *(const f32x4*)(base + off + bj * HALF + n * 16); *(f32x4*)(out + off + bj * HALF + n * 16) = b * alpha + acc[ai][bj][m][n]; } }
    }
};
struct EpiSwiglu {
    static constexpr bool PERM = true, AFTER_DRAIN = false;
    bf16_t* HID;
    __device__ __forceinline__ void operator()(const f32x4 (&acc)[2][2][4][2], const Unit& u, int wr, int wc, int fr, int fq) const {
        const int row0 = u.pm * BM + wr * 64 + fr, col0 = u.pn * HALF + wc * 32 + 8 * fq;
#pragma unroll
        for (int ai = 0; ai < 2; ++ai)
#pragma unroll
            for (int m = 0; m < 4; ++m) { const int row = row0 + ai * HALF + m * 16; float h[8];
#pragma unroll
                for (int n = 0; n < 2; ++n)
#pragma unroll
                    for (int i = 0; i < 4; ++i) { const float g = acc[ai][0][m][n][i], uu = acc[ai][1][m][n][i]; h[n * 4 + i] = g * sig_(g) * uu; }
                u32x4 w; w.x = cvt_pk_bf16(h[0], h[1]); w.y = cvt_pk_bf16(h[2], h[3]); w.z = cvt_pk_bf16(h[4], h[5]); w.w = cvt_pk_bf16(h[6], h[7]);
                *(u32x4*)(HID + (size_t)row * 256 + col0) = w; }
    }
};
struct BranchOrder {
    StaticOrder s; int shift;
    __device__ bool next(int i, Unit& u) const { if (!s.next(i, u)) return false; u.aoff = (long)(u.pn >> shift) * 512; return true; }
    __device__ __forceinline__ void a_ready(const Unit&) const {}
    __device__ __forceinline__ void done(const Unit&) const {}
};
struct MoeOrder {
    const int* Li; int nN, G, c; long bstride;
    __device__ bool next(int i, Unit& u) const {
        const int L = i * G + c, ntile = Li[64] >> 8; if (L >= ntile * nN) return false;
        u.pm = L / nN; u.pn = L % nN; const int m0 = u.pm << 8; int e = 0;
        for (int k = 0; k < 32; ++k) if (m0 >= Li[32 + k] && m0 < Li[33 + k]) e = k;
        u.aoff = 0; u.boff = (long)e * bstride; return true;
    }
    __device__ __forceinline__ void a_ready(const Unit&) const {}
    __device__ __forceinline__ void done(const Unit&) const {}
};
template <class Epi, class Sched, int KK, int LDA, bool ALIGN_EPI = false, bool SP2 = false>
__device__ __forceinline__ void gemm_phase(PG8_LAS unsigned char* lds, const Gemm g, const Sched& S, const Epi& E) {
    const int tid = tid_(), wid = __builtin_amdgcn_readfirstlane(tid >> 6), lane = tid & 63, wr = wid >> 2, wc = wid & 3, fr = lane & 15, fq = lane >> 4;
    constexpr int K = KK, nt = K / BK;
    unsigned voffA[2], voffB[2];
#pragma unroll
    for (int i = 0; i < 2; ++i) { int R, C; stage_rc(tid * 16 + i * 8192, R, C); const int Rb = Epi::PERM ? ((R & ~31) + perm32(R & 31)) : R;
        voffA[i] = (unsigned)(R * LDA + C) * 2u; voffB[i] = (unsigned)(Rb * K + C) * 2u; }
    constexpr size_t kstep = (size_t)(BK * 2);
    constexpr size_t hstepA = (size_t)HALF * LDA * 2, hstepB = (size_t)HALF * K * 2;
    constexpr size_t tstepA = 2 * hstepA, tstepB = 2 * hstepB;
    const unsigned ldsw = (unsigned)wid * 1024u;
    const int aoff = lds_byte(wr * 64 + fr, fq * 8), boff = lds_byte(wc * 32 + fr, fq * 8);
#define PG8_SA(b, h) (((b) * 2 + (h)) * HTB)
#define PG8_SB(b, h) ((4 + (b) * 2 + (h)) * HTB)
#define PG8_STAGE(bufoff, gbase, voff) do { _Pragma("unroll") for (int _i = 0; _i < 2; ++_i) \
        __builtin_amdgcn_global_load_lds((const unsigned*)((const char*)(gbase) + (voff)[_i]), (PG8_LAS unsigned*)(lds + (bufoff) + ldsw + _i * 8192), 16, 0, 0); } while (0)
#define PG8_LDA(dst, b, h) do { _Pragma("unroll") for (int m = 0; m < 4; ++m) _Pragma("unroll") for (int k = 0; k < 2; ++k) dst[m][k] = *(const PG8_LAS bf16x8*)(lds + PG8_SA(b, h) + aoff + m * 2048 + k * 1024); } while (0)
#define PG8_LDB(dst, b, h) do { _Pragma("unroll") for (int n = 0; n < 2; ++n) _Pragma("unroll") for (int k = 0; k < 2; ++k) dst[n][k] = *(const PG8_LAS bf16x8*)(lds + PG8_SB(b, h) + boff + n * 2048 + k * 1024); } while (0)
#define PG8_MMA(ai, bj, At, Bt) do { __builtin_amdgcn_s_setprio(1); _Pragma("unroll") for (int m = 0; m < 4; ++m) _Pragma("unroll") for (int n = 0; n < 2; ++n) _Pragma("unroll") for (int k = 0; k < 2; ++k) \
        acc[ai][bj][m][n] = __builtin_amdgcn_mfma_f32_16x16x32_bf16(Bt[n][k], At[m][k], acc[ai][bj][m][n], 0, 0, 0); __builtin_amdgcn_s_setprio(0); } while (0)
#define PG8_WAIT_V(n) asm volatile("s_waitcnt vmcnt(" #n ")" ::: "memory")
#define PG8_WAIT_L(n) asm volatile("s_waitcnt lgkmcnt(" #n ")" ::: "memory")
#define PG8_BAR __builtin_amdgcn_s_barrier()
#define PG8_SCHED __builtin_amdgcn_sched_barrier(0)
    Unit cur, nxt; int ui = 0;
    if (!S.next(0, cur)) return;
    f32x4 acc[2][2][4][2];
#pragma unroll
    for (int a = 0; a < 2; ++a)
#pragma unroll
        for (int b = 0; b < 2; ++b)
#pragma unroll
            for (int m = 0; m < 4; ++m)
#pragma unroll
                for (int n = 0; n < 2; ++n) acc[a][b][m][n] = (f32x4){0.f, 0.f, 0.f, 0.f};
    bf16x8 At[4][2], B0[2][2], B1[2][2];
    const char* cA = (const char*)g.A + (size_t)cur.pm * tstepA + cur.aoff; const char* cB = (const char*)g.Bt + (size_t)cur.pn * tstepB + cur.boff;
    S.a_ready(cur);
    if constexpr (SP2) {
        PG8_STAGE(PG8_SB(0, 0), cB, voffB); PG8_STAGE(PG8_SB(0, 1), cB + hstepB, voffB); PG8_STAGE(PG8_SA(0, 0), cA, voffA); PG8_STAGE(PG8_SA(0, 1), cA + hstepA, voffA);
        if (wr == 1) PG8_BAR;
        PG8_WAIT_V(2); PG8_BAR;
        PG8_STAGE(PG8_SB(1, 0), cB + kstep, voffB); PG8_STAGE(PG8_SA(1, 0), cA + kstep, voffA); PG8_STAGE(PG8_SB(1, 1), cB + hstepB + kstep, voffB);
        PG8_WAIT_V(6); PG8_BAR;
    } else {
        PG8_STAGE(PG8_SB(0, 0), cB, voffB); PG8_STAGE(PG8_SA(0, 0), cA, voffA); PG8_STAGE(PG8_SB(0, 1), cB + hstepB, voffB); PG8_STAGE(PG8_SA(0, 1), cA + hstepA, voffA);
        if (wr == 1) PG8_BAR;
        PG8_WAIT_V(4); PG8_BAR;
        PG8_STAGE(PG8_SB(1, 0), cB + kstep, voffB); PG8_STAGE(PG8_SA(1, 0), cA + kstep, voffA); PG8_STAGE(PG8_SB(1, 1), cB + hstepB + kstep, voffB);
        PG8_WAIT_V(6); PG8_BAR;
    }
    for (;;) {
        const bool has_next = S.next(ui + 1, nxt);
        const char* nA = has_next ? (const char*)g.A + (size_t)nxt.pm * tstepA + nxt.aoff : cA; const char* nB = has_next ? (const char*)g.Bt + (size_t)nxt.pn * tstepB + nxt.boff : cB;
#pragma unroll 1
        for (int t = 0; t < nt; t += 2) {
            const bool last = (t == nt - 2);
            const char* a1 = cA + (size_t)(t + 1) * kstep;
            const char* a2 = last ? nA : cA + (size_t)(t + 2) * kstep; const char* b2 = last ? nB : cB + (size_t)(t + 2) * kstep;
            const char* a3 = a2 + kstep; const char* b3 = b2 + kstep;
            if (last && has_next) S.a_ready(nxt);
            if constexpr (SP2) {
            PG8_LDB(B0, 0, 0); PG8_LDB(B1, 0, 1); PG8_SCHED; PG8_LDA(At, 0, 0); PG8_STAGE(PG8_SA(1, 1), a1 + hstepA, voffA);
            PG8_WAIT_V(8); PG8_WAIT_L(0); PG8_BAR; PG8_MMA(0, 0, At, B0); PG8_MMA(0, 1, At, B1); PG8_BAR; PG8_SCHED;
            PG8_LDA(At, 0, 1); PG8_STAGE(PG8_SB(0, 0), b2, voffB); PG8_STAGE(PG8_SB(0, 1), b2 + hstepB, voffB); PG8_STAGE(PG8_SA(0, 0), a2, voffA);
            PG8_WAIT_V(8); PG8_WAIT_L(0); PG8_BAR; PG8_MMA(1, 0, At, B0); PG8_MMA(1, 1, At, B1); PG8_BAR; PG8_SCHED;
            PG8_LDB(B0, 1, 0); PG8_LDB(B1, 1, 1); PG8_SCHED; PG8_LDA(At, 1, 0); PG8_STAGE(PG8_SA(0, 1), a2 + hstepA, voffA);
            PG8_WAIT_V(8); PG8_WAIT_L(0); PG8_BAR; PG8_MMA(0, 0, At, B0); PG8_MMA(0, 1, At, B1); PG8_BAR; PG8_SCHED;
            PG8_LDA(At, 1, 1); PG8_STAGE(PG8_SB(1, 0), b3, voffB); PG8_STAGE(PG8_SB(1, 1), b3 + hstepB, voffB); PG8_STAGE(PG8_SA(1, 0), a3, voffA);
            PG8_WAIT_V(8); PG8_WAIT_L(0); PG8_BAR; PG8_MMA(1, 0, At, B0); PG8_MMA(1, 1, At, B1); PG8_BAR; PG8_SCHED;
            } else {
            PG8_LDB(B0, 0, 0); PG8_SCHED; PG8_LDA(At, 0, 0); PG8_STAGE(PG8_SA(1, 1), a1 + hstepA, voffA);
            PG8_WAIT_L(8); PG8_BAR; PG8_WAIT_L(0); PG8_MMA(0, 0, At, B0); PG8_BAR; PG8_SCHED;
            PG8_LDB(B1, 0, 1); PG8_STAGE(PG8_SB(0, 0), b2, voffB);
            PG8_BAR; PG8_WAIT_L(0); PG8_MMA(0, 1, At, B1); PG8_BAR;
            PG8_LDA(At, 0, 1); PG8_STAGE(PG8_SA(0, 0), a2, voffA);
            PG8_BAR; PG8_WAIT_L(0); PG8_MMA(1, 0, At, B0); PG8_BAR; PG8_SCHED;
            PG8_STAGE(PG8_SB(0, 1), b2 + hstepB, voffB);
            PG8_WAIT_V(6); PG8_BAR; PG8_MMA(1, 1, At, B1); PG8_BAR;
            PG8_LDB(B0, 1, 0); PG8_SCHED; PG8_LDA(At, 1, 0); PG8_STAGE(PG8_SA(0, 1), a2 + hstepA, voffA);
            PG8_WAIT_L(8); PG8_BAR; PG8_WAIT_L(0); PG8_MMA(0, 0, At, B0); PG8_BAR; PG8_SCHED;
            PG8_LDB(B1, 1, 1); PG8_STAGE(PG8_SB(1, 0), b3, voffB);
            PG8_BAR; PG8_WAIT_L(0); PG8_MMA(0, 1, At, B1); PG8_BAR;
            PG8_LDA(At, 1, 1); PG8_STAGE(PG8_SA(1, 0), a3, voffA);
            PG8_BAR; PG8_WAIT_L(0); PG8_MMA(1, 0, At, B0); PG8_BAR; PG8_SCHED;
            PG8_STAGE(PG8_SB(1, 1), b3 + hstepB, voffB);
            PG8_WAIT_V(6); PG8_BAR; PG8_MMA(1, 1, At, B1); PG8_BAR;
            }
        }
        if constexpr (ALIGN_EPI) { if (wr == 0) PG8_BAR; }
        if constexpr (!Epi::AFTER_DRAIN) { E(acc, cur, wr, wc, fr, fq); S.done(cur); }
        if (!has_next) break;
#pragma unroll
        for (int a = 0; a < 2; ++a)
#pragma unroll
            for (int b = 0; b < 2; ++b)
#pragma unroll
                for (int m = 0; m < 4; ++m)
#pragma unroll
                    for (int n = 0; n < 2; ++n) acc[a][b][m][n] = (f32x4){0.f, 0.f, 0.f, 0.f};
        cur = nxt; cA = nA; cB = nB; ++ui;
        if constexpr (ALIGN_EPI) { if (wr == 1) PG8_BAR; }
    }
    PG8_WAIT_V(0);
    if constexpr (!ALIGN_EPI) { if (wr == 0) PG8_BAR; }
    PG8_BAR;
    if constexpr (Epi::AFTER_DRAIN) { E.fused(acc, cur, wr, wc, fr, fq, lds, wid, lane); S.done(cur); }
#undef PG8_SA
#undef PG8_SB
#undef PG8_STAGE
#undef PG8_LDA
#undef PG8_LDB
#undef PG8_MMA
#undef PG8_WAIT_V
#undef PG8_WAIT_L
#undef PG8_BAR
#undef PG8_SCHED
}
}

template <class AP, class BP, class Epi>
__device__ __forceinline__ void ngemm(int M, int N, int K, int lda, int ldb, AP ap, BP bp, Epi epi, float* lds) {
    const int tid = tid_(), ty = tid >> 4, tx = tid & 15;
    float* As = lds; float* Bs = lds + 32 * 128;
    const int ntm = M / 128, ntn = N / 128;
    const int lrow = tid >> 2, lkc = (tid & 3) * 8;
    for (int tile = bid_(); tile < ntm * ntn; tile += nblk_()) {
        const int tm = tile / ntn, tn = tile % ntn, m0 = tm * 128, n0 = tn * 128;
        const bf16_t* Ab = ap(m0, n0) + (size_t)lrow * lda + lkc; const bf16_t* Bb = bp(m0, n0) + (size_t)lrow * ldb + lkc;
        float acc[4][8];
#pragma unroll
        for (int i = 0; i < 4; ++i)
#pragma unroll
            for (int j = 0; j < 8; ++j) acc[i][j] = 0.f;
        for (int k0 = 0; k0 < K; k0 += 32) {
            const u32x4 va = *(const u32x4*)(Ab + k0); const u32x4 vb = *(const u32x4*)(Bb + k0);
            __syncthreads();
#pragma unroll
            for (int i = 0; i < 4; ++i) {
                As[(lkc + 2 * i) * 128 + lrow] = bf2f(va[i] & 0xffffu); As[(lkc + 2 * i + 1) * 128 + lrow] = bf2f(va[i] >> 16);
                Bs[(lkc + 2 * i) * 128 + lrow] = bf2f(vb[i] & 0xffffu); Bs[(lkc + 2 * i + 1) * 128 + lrow] = bf2f(vb[i] >> 16);
            }
            __syncthreads();
#pragma unroll 8
            for (int kk = 0; kk < 32; ++kk) {
                const f32x4 a = *(const f32x4*)(As + kk * 128 + ty * 4);
                const f32x4 b0 = *(const f32x4*)(Bs + kk * 128 + tx * 8), b1 = *(const f32x4*)(Bs + kk * 128 + tx * 8 + 4);
#pragma unroll
                for (int i = 0; i < 4; ++i) {
                    acc[i][0] += a[i] * b0.x; acc[i][1] += a[i] * b0.y; acc[i][2] += a[i] * b0.z; acc[i][3] += a[i] * b0.w;
                    acc[i][4] += a[i] * b1.x; acc[i][5] += a[i] * b1.y; acc[i][6] += a[i] * b1.z; acc[i][7] += a[i] * b1.w;
                }
            }
        }
#pragma unroll
        for (int i = 0; i < 4; ++i)
#pragma unroll
            for (int j = 0; j < 8; ++j) epi(m0 + ty * 4 + i, n0 + tx * 8 + j, acc[i][j]);
    }
    __syncthreads();
}

__device__ __forceinline__ void expert_offsets(CParams& p, int tb, int* Li) {
    const int tid = tid_(); const int* hist = (const int*)(p.ws + WS_CTL);
    int* tmp = Li + 128;
    const int e = tid & 31, part = tid >> 5;
    int s = 0, pre = 0;
    for (int i = 0; i < 16; ++i) { const int b = part * 16 + i; const int h = hist[b * 32 + e]; s += h; if (b < tb) pre += h; }
    tmp[part * 32 + e] = s; tmp[512 + part * 32 + e] = pre;
    __syncthreads();
    if (tid < 32) { int a = 0, b = 0; for (int i = 0; i < 16; ++i) { a += tmp[i * 32 + tid]; b += tmp[512 + i * 32 + tid]; } Li[tid] = a; Li[65 + tid] = b; }
    __syncthreads();
    if (tid == 0) { int ps = 0; for (int i = 0; i < 32; ++i) { Li[32 + i] = ps; ps += (Li[i] + 255) / 256 * 256; } Li[64] = ps; }
    __syncthreads();
}
__device__ __forceinline__ int tile_expert(const int* Li, int m0) { int e = 0; for (int i = 0; i < 32; ++i) if (m0 >= Li[32 + i] && m0 < Li[33 + i]) e = i; return e; }

__device__ __forceinline__ void phase_inproj(CParams& p, float* lds) {
    const bf16_t* XB = (const bf16_t*)(p.ws + WS_XB); const bf16_t* Bt = (const bf16_t*)(p.ws + WS_W + W_BT1); bf16_t* ZS = (bf16_t*)(p.ws + WS_R1 + R1_ZS);
    ngemm(T, ZSW, 1024, 1024, 1024, [=](int m0, int) { return XB + (size_t)m0 * 1024; }, [=](int, int n0) { return Bt + (size_t)n0 * 1024; },
          [=](int m, int n, float v) { ZS[(size_t)m * ZSW + n] = (bf16_t)f2bf(v); }, lds);
}
__device__ __forceinline__ float logsigmoid_(float x) { return -(fmaxf(-x, 0.f) + log1pf(expf(-fabsf(x)))); }
__device__ __forceinline__ void phase_upproj(CParams& p, int l, float* lds) {
    const int tid = tid_(), lane = tid & 63, wave = tid >> 6;
    const bf16_t* ZS = (const bf16_t*)(p.ws + WS_R1 + R1_ZS);
    const bf16_t* Bup = (const bf16_t*)(p.ws + WS_W + W_UQ); bf16_t* QKVR = (bf16_t*)(p.ws + WS_R1 + R1_QKVR);
    ngemm(T, 1024, 256, ZSW, 256, [=](int m0, int n0) { return ZS + (size_t)m0 * ZSW + (n0 >> 9) * 256; }, [=](int, int n0) { return Bup + (size_t)n0 * 256; },
          [=](int m, int n, float v) { QKVR[(size_t)m * 1024 + n] = (bf16_t)f2bf(v); }, lds);
}

__device__ __forceinline__ void unpack8(const u32x4 w, float (&x)[8]) {
#pragma unroll
    for (int i = 0; i < 4; ++i) { x[2 * i] = bf2f(w[i] & 0xffffu); x[2 * i + 1] = bf2f(w[i] >> 16); }
}
__device__ __forceinline__ u32x4 pack8f(const float (&x)[8]) { u32x4 w; w.x = pk2(x[0], x[1]); w.y = pk2(x[2], x[3]); w.z = pk2(x[4], x[5]); w.w = pk2(x[6], x[7]); return w; }
__device__ __forceinline__ u32x4 mla_chunk(int c, const bf16_t* nope, float nscale, const bf16_t* x1p, const bf16_t* x2p, float rscale, const float* rp) {
    float o[8];
    if (c < 8) { float x[8]; unpack8(*(const u32x4*)(nope + 8 * c), x);
#pragma unroll
        for (int i = 0; i < 8; ++i) o[i] = x[i] * nscale; }
    else { const int rr = c - 8, half = rr >> 1, i0 = 8 * (rr & 1); float x1[8], x2[8]; unpack8(*(const u32x4*)(x1p + i0), x1); unpack8(*(const u32x4*)(x2p + i0), x2);
        const f32x4 c0 = *(const f32x4*)(rp + i0), c1 = *(const f32x4*)(rp + i0 + 4), s0 = *(const f32x4*)(rp + 16 + i0), s1 = *(const f32x4*)(rp + 16 + i0 + 4);
#pragma unroll
        for (int i = 0; i < 8; ++i) { const float cs = i < 4 ? c0[i] : c1[i - 4], sn = i < 4 ? s0[i] : s1[i - 4]; o[i] = (half == 0 ? x1[i] * cs - x2[i] * sn : x2[i] * cs + x1[i] * sn) * rscale; } }
    return pack8f(o);
}
__device__ __forceinline__ void phase_prep(CParams& p, int l, float* lds) {
    const int tid = tid_(), lane = tid & 63, wave = tid >> 6;
    const int gw = bid_() * NWAVES + wave, NGW = nblk_() * NWAVES;
    bf16_t* ZS = (bf16_t*)(p.ws + WS_R1 + R1_ZS); const bf16_t* QKVR = (const bf16_t*)(p.ws + WS_R1 + R1_QKVR);
    bf16_t* Qm = (bf16_t*)(p.ws + WS_C + C_QM); bf16_t* Km = (bf16_t*)(p.ws + WS_C + C_KM); bf16_t* Vm = (bf16_t*)(p.ws + WS_C + C_VM);
    const float* CFp = (const float*)(p.ws + WS_ROUTE + RT_CF); const float* ROPE = (const float*)(p.ws + WS_E);
    for (int m = gw; m < T; m += NGW) {
        bf16_t* zr = ZS + (size_t)m * ZSW; const bf16_t* qk = QKVR + (size_t)m * 1024; const float* rp = ROPE + (size_t)m * 32;
        float sq, skv = 0.f;
        { const u32x2 a = *(const u32x2*)(zr + C_CQ + 4 * lane); const float x0 = bf2f(a.x & 0xffffu), x1 = bf2f(a.x >> 16), x2 = bf2f(a.y & 0xffffu), x3 = bf2f(a.y >> 16); sq = (x0 * x0 + x1 * x1) + (x2 * x2 + x3 * x3); }
        if (lane < 32) { const u32x2 a = *(const u32x2*)(zr + C_CKV + 4 * lane); const float x0 = bf2f(a.x & 0xffffu), x1 = bf2f(a.x >> 16), x2 = bf2f(a.y & 0xffffu), x3 = bf2f(a.y >> 16); skv = (x0 * x0 + x1 * x1) + (x2 * x2 + x3 * x3); }
        const float rq = rsqrtf(wave_sum(sq) * (1.f / 256.f) + EPS), rkv = rsqrtf(wave_sum(skv) * (1.f / 128.f) + EPS);
        if (lane < 48) {
            const int h = lane / 12, c = lane % 12;
            const bf16_t* qh = qk + h * 96; const bf16_t* kh = qk + 512 + h * 128;
            *(u32x4*)(Qm + (size_t)m * 384 + h * 96 + 8 * c) = mla_chunk(c, qh, rq * C2_M, qh + 64, qh + 80, rq * C2_M, rp);
            *(u32x4*)(Km + (size_t)m * 384 + h * 96 + 8 * c) = mla_chunk(c, kh, rkv, zr + C_KR, zr + C_KR + 16, 1.f, rp);
        } else {
#pragma unroll
            for (int q = 0; q < 2; ++q) { const int j = (lane - 48) + 16 * q, h = j >> 3, c = j & 7; float x[8]; unpack8(*(const u32x4*)(qk + 512 + h * 128 + 64 + 8 * c), x);
#pragma unroll
                for (int i = 0; i < 8; ++i) x[i] *= rkv;
                *(u32x4*)(Vm + (size_t)m * 256 + h * 64 + 8 * c) = pack8f(x); }
        }
        if (lane < 8) { const int h = lane >> 1;
            if (lane & 1) { const float bias = -CFp[(size_t)m * 4 + h] * LOG2E; const unsigned bh_ = f2bf(bias), bl_ = f2bf(bias - bf2f(bh_)); *(unsigned*)(zr + C_FXK + h * 80 + 64) = bh_ | (bl_ << 16); }
            else *(unsigned*)(zr + C_FXQ + h * 80 + 64) = 0x3f803f80u; }
    }
    if (bid_() == 0 && tid == 0) *(unsigned*)(p.ws + WS_CTL + CTL_QUEUE) = 0u;
    __syncthreads();
    float* hs = lds;
    float* ys = lds + 62 * 256;
    bf16_t* YS = (bf16_t*)(p.ws + WS_D);
    const float* cw = p.conv_w + (size_t)l * 31 * 256; const float* cb = p.conv_b + l * 256; const float* lg = p.conv_g + l * 256; const float* lb = p.conv_bb + l * 256;
    for (int ch = bid_(); ch < T / 32; ch += nblk_()) {
        const int m0 = ch * 32, t0 = m0 & (SEQ - 1);
#pragma unroll
        for (int it = 0; it < 4; ++it) { const int idx = tid + NTHREADS * it;
            if (idx < 62 * 32) { const int r = idx >> 5, c8 = (idx & 31) * 8, tt = t0 - 30 + r; float a[8], g[8];
                if (tt >= 0) { const bf16_t* zr = ZS + (size_t)(m0 - 30 + r) * ZSW; unpack8(*(const u32x4*)(zr + C_CVA + c8), a); unpack8(*(const u32x4*)(zr + C_CVG + c8), g);
#pragma unroll
                    for (int i = 0; i < 8; ++i) a[i] *= sigmoidf_(g[i]); }
                else {
#pragma unroll
                    for (int i = 0; i < 8; ++i) a[i] = 0.f; }
                *(f32x4*)(hs + r * 256 + c8) = (f32x4){a[0], a[1], a[2], a[3]}; *(f32x4*)(hs + r * 256 + c8 + 4) = (f32x4){a[4], a[5], a[6], a[7]}; } }
        __syncthreads();
        { const int c = tid & 255, half = tid >> 8; float w[31], hv[46];
#pragma unroll
            for (int i = 0; i < 31; ++i) w[i] = cw[i * 256 + c];
#pragma unroll
            for (int i = 0; i < 46; ++i) hv[i] = hs[(half * 16 + i) * 256 + c];
            const float bias = cb[c];
#pragma unroll
            for (int i = 0; i < 16; ++i) { float a = bias;
#pragma unroll
                for (int k = 0; k < 31; ++k) a += hv[i + k] * w[k];
                ys[(half * 16 + i) * 256 + c] = a; } }
        __syncthreads();
#pragma unroll
        for (int q = 0; q < 4; ++q) {
            const int i = wave * 4 + q; const f32x4 v = *(const f32x4*)(ys + i * 256 + lane * 4);
            const float mean = wave_sum((v.x + v.y) + (v.z + v.w)) * (1.f / 256.f);
            const f32x4 dv = v - mean; const float var = wave_sum((dv.x * dv.x + dv.y * dv.y) + (dv.z * dv.z + dv.w * dv.w)) * (1.f / 256.f);
            const float rstd = rsqrtf(var + EPS);
            const f32x4 g = *(const f32x4*)(lg + lane * 4), bb = *(const f32x4*)(lb + lane * 4);
            f32x4 y = dv * rstd * g + bb;
            y.x = y.x * sigmoidf_(y.x); y.y = y.y * sigmoidf_(y.y); y.z = y.z * sigmoidf_(y.z); y.w = y.w * sigmoidf_(y.w);
            u32x2 o; o.x = pk2(y.x, y.y); o.y = pk2(y.z, y.w);
            *(u32x2*)(YS + (size_t)(m0 + i) * 1024 + 512 + lane * 4) = o;
        }
        __syncthreads();
    }
}

template <int MODE, int DQ>
__device__ __forceinline__ void attn_naive(const bf16_t* Q, int qp, const bf16_t* K, int kp, const bf16_t* V, int vp, const float* CF, bf16_t* Y, float* lds) {
    const int tid = tid_(), lane = tid & 63, wave = tid >> 6;
    const int gw = bid_() * NWAVES + wave, NGW = nblk_() * NWAVES;
    float* qs = lds + wave * 128;
    for (int row = gw; row < T * 4; row += NGW) {
        const int m = row >> 2, h = row & 3, b = m >> 12, t = m & (SEQ - 1);
        LDS_FENCE();
        for (int d = lane; d < DQ; d += 64) qs[d] = bf2f(Q[(size_t)m * qp + h * DQ + d]);
        LDS_FENCE();
        float acc = 0.f, mx = -INFINITY, l = 0.f, R = 0.f;
        const int last = MODE == 1 ? t - 1 : t;
        const int nch = last < 0 ? 0 : (last >> 6) + 1;
        for (int ci = 0; ci < nch; ++ci) {
            const int j0 = (MODE == 1 ? (nch - 1 - ci) : ci) * 64, j = j0 + lane;
            const bool valid = j <= last;
            const int jc = valid ? j : last;
            const bf16_t* kr = K + ((size_t)b * SEQ + jc) * kp + h * DQ;
            float s = 0.f;
#pragma unroll
            for (int c = 0; c < DQ / 8; ++c) { const u32x4 kv = *(const u32x4*)(kr + c * 8);
#pragma unroll
                for (int i = 0; i < 4; ++i) s += qs[c * 8 + 2 * i] * bf2f(kv[i] & 0xffffu) + qs[c * 8 + 2 * i + 1] * bf2f(kv[i] >> 16); }
            float pj;
            if (MODE == 1) {
                float L2 = valid ? -(fmaxf(s, 0.f) + log2f(1.f + exp2f(-fabsf(s)))) : 0.f;
                float suf = L2;
#pragma unroll
                for (int o = 1; o < 64; o <<= 1) { const float y = __shfl_down(suf, o); if (lane + o < 64) suf += y; }
                const float after = R + (suf - L2);
                pj = valid ? exp2f(s + L2 + after) : 0.f;
                R += __shfl(suf, 0);
            } else {
                if (MODE == 2) s -= CF[((size_t)b * SEQ + jc) * 4 + h] * LOG2E;
                if (!valid) s = -INFINITY;
                const float mn = fmaxf(mx, wave_max(s));
                const float f = exp2f(mx - mn);
                pj = exp2f(s - mn);
                l = l * f + wave_sum(pj); acc *= f; mx = mn;
            }
            const bf16_t* vb = V + ((size_t)b * SEQ + j0) * vp + h * 64 + lane;
            const int nv = last - j0 + 1 < 64 ? last - j0 + 1 : 64;
            for (int jj = 0; jj < nv; ++jj) acc += __shfl(pj, jj) * bf2f(vb[(size_t)jj * vp]);
        }
        if (MODE != 1) acc = nch ? acc / l : 0.f;
        Y[(size_t)m * 1024 + h * 64 + lane] = (bf16_t)f2bf(acc);
    }
}
__device__ __forceinline__ void phase_attn(CParams& p, float* lds) {
    const bf16_t* ZS = (const bf16_t*)(p.ws + WS_R1 + R1_ZS); bf16_t* YS = (bf16_t*)(p.ws + WS_D);
    const bf16_t* Qm = (const bf16_t*)(p.ws + WS_C + C_QM); const bf16_t* Km = (const bf16_t*)(p.ws + WS_C + C_KM); const bf16_t* Vm = (const bf16_t*)(p.ws + WS_C + C_VM);
    const float* CF = (const float*)(p.ws + WS_ROUTE + RT_CF);
    attn_naive<0, 96>(Qm, 384, Km, 384, Vm, 256, nullptr, YS, lds);
    attn_naive<1, 64>(ZS + C_SBQ, ZSW, ZS + C_SBK, ZSW, ZS + C_SBV, ZSW, nullptr, YS + 256, lds);
}

__device__ __forceinline__ void phase_pgemm(CParams& p, float* lds) {
    const bf16_t* YS = (const bf16_t*)(p.ws + WS_D); const bf16_t* Bt = (const bf16_t*)(p.ws + WS_W + W_BR); bf16_t* PB = (bf16_t*)(p.ws + WS_R1 + R1_PB);
    ngemm(T, 4096, 256, 1024, 256, [=](int m0, int n0) { return YS + (size_t)m0 * 1024 + (n0 >> 10) * 256; }, [=](int, int n0) { return Bt + (size_t)n0 * 256; },
          [=](int m, int n, float v) { PB[(size_t)m * 4096 + n] = (bf16_t)f2bf(v); }, lds);
}
__device__ __forceinline__ void phase_gate(CParams& p, int l, float* lds) {
    const bf16_t* XB = (const bf16_t*)(p.ws + WS_XB); const bf16_t* Bt = (const bf16_t*)(p.ws + WS_W + W_GATE); bf16_t* PB = (bf16_t*)(p.ws + WS_R1 + R1_PB);
    const float* bg = p.b_gate + (size_t)l * 4096;
    ngemm(T, 4096, 1024, 1024, 1024, [=](int m0, int) { return XB + (size_t)m0 * 1024; }, [=](int, int n0) { return Bt + (size_t)n0 * 1024; },
          [=](int m, int n, float v) { const size_t i = (size_t)m * 4096 + n; PB[i] = (bf16_t)f2bf(sigmoidf_(v + bg[n]) * bf2f(PB[i])); }, lds);
}
__device__ __forceinline__ void phase_combine(CParams& p) {
    const bf16_t* PB = (const bf16_t*)(p.ws + WS_R1 + R1_PB); bf16_t* MG = (bf16_t*)(p.ws + WS_C);
    for (size_t i = (size_t)bid_() * NTHREADS + tid_(); i < (size_t)T * 1024; i += (size_t)nblk_() * NTHREADS) {
        const size_t m = i >> 10, d = i & 1023; const bf16_t* r = PB + m * 4096 + d;
        MG[i] = (bf16_t)f2bf((bf2f(r[0]) + bf2f(r[1024])) + (bf2f(r[2048]) + bf2f(r[3072])));
    }
}
__device__ __forceinline__ void phase_wo(CParams& p, int l, float* lds) {
    const bf16_t* MG = (const bf16_t*)(p.ws + WS_C); const bf16_t* Bt = (const bf16_t*)(p.ws + WS_W + W_O);
    const float* xf = l == 0 ? p.x : p.out; float* out = p.out;
    ngemm(T, 1024, 1024, 1024, 1024, [=](int m0, int) { return MG + (size_t)m0 * 1024; }, [=](int, int n0) { return Bt + (size_t)n0 * 1024; },
          [=](int m, int n, float v) { const size_t i = (size_t)m * 1024 + n; out[i] = ALPHA * xf[i] + v; }, lds);
}

__device__ __forceinline__ void ln_row(f32x4 (&v)[4], const float* g, const float* b, int lane) {
    float s = 0.f;
#pragma unroll
    for (int j = 0; j < 4; ++j) s += (v[j].x + v[j].y) + (v[j].z + v[j].w);
    const float mean = wave_sum(s) * (1.f / 1024.f); float s2 = 0.f;
#pragma unroll
    for (int j = 0; j < 4; ++j) { v[j] = v[j] - mean; s2 += (v[j].x * v[j].x + v[j].y * v[j].y) + (v[j].z * v[j].z + v[j].w * v[j].w); }
    const float rstd = rsqrtf(wave_sum(s2) * (1.f / 1024.f) + EPS);
#pragma unroll
    for (int j = 0; j < 4; ++j) { const f32x4 gg = *(const f32x4*)(g + 256 * j + 4 * lane), bb = *(const f32x4*)(b + 256 * j + 4 * lane); v[j] = v[j] * rstd * gg + bb; }
}

__device__ __forceinline__ float treduce8(const float (&x)[8], int lane) {
    const bool b0 = lane & 1, b1 = lane & 2, b2 = lane & 4;
    float y[4], z[2];
#pragma unroll
    for (int i = 0; i < 4; ++i) { const float snd = b0 ? x[i] : x[i + 4], kep = b0 ? x[i + 4] : x[i]; y[i] = kep + __shfl_xor(snd, 1); }
#pragma unroll
    for (int i = 0; i < 2; ++i) { const float snd = b1 ? y[i] : y[i + 2], kep = b1 ? y[i + 2] : y[i]; z[i] = kep + __shfl_xor(snd, 2); }
    float w; { const float snd = b2 ? z[0] : z[1], kep = b2 ? z[1] : z[0]; w = kep + __shfl_xor(snd, 4); }
    w += __shfl_xor(w, 8); w += __shfl_xor(w, 16); w += __shfl_xor(w, 32);
    return w;
}
__device__ __forceinline__ int tr8_lane(int t) { return ((t & 1) << 2) | (t & 2) | ((t >> 2) & 1); }

__device__ __forceinline__ void phase_ln1route(CParams& p, int l, float* lds) {
    const int tid = tid_(), lane = tid & 63, wave = tid >> 6;
    int* cnt = (int*)lds; float* sl = lds + 64 + wave * 320;
    int* tok_e = (int*)(p.ws + WS_ROUTE + RT_TOKE); float* tok_w = (float*)(p.ws + WS_ROUTE + RT_TOKW); int* tok_p = (int*)(p.ws + WS_ROUTE + RT_TOKP);
    int* hist = (int*)(p.ws + WS_CTL); bf16_t* HB = (bf16_t*)(p.ws + WS_C);
    const float* wT = (const float*)(p.ws + WS_ROUTE + RT_WT);
    const float* g1 = p.ln1_g + l * D; const float* b1 = p.ln1_b + l * D;
    const int myt = 4 * (lane & 1) + 2 * ((lane >> 1) & 1) + ((lane >> 2) & 1);
    for (int tb = bid_(); tb < 256; tb += nblk_()) {
        if (tid < 32) cnt[tid] = 0;
        __syncthreads();
        const int m0 = tb * 64 + wave * 8;
        f32x4 v[8][4];
#pragma unroll
        for (int t = 0; t < 8; ++t) { const f32x4* orow = (const f32x4*)(p.out + (size_t)(m0 + t) * D) + lane;
#pragma unroll
            for (int j = 0; j < 4; ++j) v[t][j] = orow[64 * j]; }
        float sx[8];
#pragma unroll
        for (int t = 0; t < 8; ++t) { float s = 0.f;
#pragma unroll
            for (int j = 0; j < 4; ++j) s += (v[t][j].x + v[t][j].y) + (v[t][j].z + v[t][j].w);
            sx[t] = s; }
        const float msum = treduce8(sx, lane);
#pragma unroll
        for (int t = 0; t < 8; ++t) { const float mean = __shfl(msum, tr8_lane(t)) * (1.f / 1024.f); float s2 = 0.f;
#pragma unroll
            for (int j = 0; j < 4; ++j) { v[t][j] = v[t][j] - mean; s2 += (v[t][j].x * v[t][j].x + v[t][j].y * v[t][j].y) + (v[t][j].z * v[t][j].z + v[t][j].w * v[t][j].w); }
            sx[t] = s2; }
        const float vsum = treduce8(sx, lane);
#pragma unroll
        for (int j = 0; j < 4; ++j) { const f32x4 gg = *(const f32x4*)(g1 + 256 * j + 4 * lane), bb = *(const f32x4*)(b1 + 256 * j + 4 * lane);
#pragma unroll
            for (int t = 0; t < 8; ++t) { const float rstd = rsqrtf(__shfl(vsum, tr8_lane(t)) * (1.f / 1024.f) + EPS); v[t][j] = v[t][j] * rstd * gg + bb; } }
#pragma unroll
        for (int t = 0; t < 8; ++t) { f32x4* orow = (f32x4*)(p.out + (size_t)(m0 + t) * D) + lane; u32x2* hb = (u32x2*)(HB + (size_t)(m0 + t) * D) + lane;
#pragma unroll
            for (int j = 0; j < 4; ++j) { orow[64 * j] = v[t][j]; u32x2 w; w.x = pk2(v[t][j].x, v[t][j].y); w.y = pk2(v[t][j].z, v[t][j].w); hb[64 * j] = w; } }
#pragma unroll 1
        for (int jr = 0; jr < 36; ++jr) {
            const f32x4* wr = (const f32x4*)(wT + (size_t)jr * 1024) + lane; float part[8];
            const f32x4 w0 = wr[0], w1 = wr[64], w2 = wr[128], w3 = wr[192];
#pragma unroll
            for (int t = 0; t < 8; ++t) {
                const f32x4 a = v[t][0] * w0 + v[t][1] * w1 + v[t][2] * w2 + v[t][3] * w3;
                part[t] = (a.x + a.y) + (a.z + a.w);
            }
            const float tot = treduce8(part, lane);
            if (lane < 8) sl[myt * 40 + jr] = tot + wT[36 * 1024 + jr];
        }
        LDS_FENCE();
        if (lane < 8) {
            const int m = m0 + lane; const float* s = sl + lane * 40;
            int g = 0; float gm = s[0];
            for (int i = 1; i < 4; ++i) if (s[i] > gm) { gm = s[i]; g = i; }
            float gs = 0.f; for (int i = 0; i < 4; ++i) gs += expf(s[i] - gm);
            const float grp_p = 1.f / gs;
            const float* le = s + 4 + g * 8;
            int i0 = 0; float mx0 = le[0];
            for (int i = 1; i < 8; ++i) if (le[i] > mx0) { mx0 = le[i]; i0 = i; }
            int i1 = -1; float mx1 = -INFINITY;
            for (int i = 0; i < 8; ++i) if (i != i0 && le[i] > mx1) { mx1 = le[i]; i1 = i; }
            const float e1 = expf(mx1 - mx0), den = 1.f + e1;
            const int x0 = g * 8 + i0, x1 = g * 8 + i1;
            tok_e[m * 2] = x0; tok_e[m * 2 + 1] = x1;
            tok_w[m * 2] = grp_p / den; tok_w[m * 2 + 1] = grp_p * e1 / den;
            tok_p[m * 2] = atomicAdd(&cnt[x0], 1); tok_p[m * 2 + 1] = atomicAdd(&cnt[x1], 1);
        }
        LDS_FENCE();
        __syncthreads();
        if (tid < 32) hist[tb * 32 + tid] = cnt[tid];
        __syncthreads();
    }
}

__device__ __forceinline__ void phase_gather(CParams& p, float* lds) {
    const int tid = tid_(), lane = tid & 63, wave = tid >> 6;
    int* Li = (int*)lds;
    const int* tok_e = (const int*)(p.ws + WS_ROUTE + RT_TOKE); const float* tok_w = (const float*)(p.ws + WS_ROUTE + RT_TOKW); const int* tok_p = (const int*)(p.ws + WS_ROUTE + RT_TOKP);
    int* tok_s = (int*)(p.ws + WS_ROUTE + RT_TOKS); float* slot_w = (float*)(p.ws + WS_ROUTE + RT_SLOTW);
    const bf16_t* HB = (const bf16_t*)(p.ws + WS_C); bf16_t* XG = (bf16_t*)(p.ws + WS_R1 + R1_XG);
    for (int tb = bid_(); tb < 256; tb += nblk_()) {
        expert_offsets(p, tb, Li);
        for (int q = 0; q < 16; ++q) {
            const int a = tb * 128 + wave * 16 + q, m = a >> 1;
            const int e = tok_e[a]; const int slot = Li[32 + e] + Li[65 + e] + tok_p[a];
            const u32x4* src = (const u32x4*)(HB + (size_t)m * D) + lane; u32x4* dst = (u32x4*)(XG + (size_t)slot * D) + lane;
            dst[0] = src[0]; dst[64] = src[64];
            if (lane == 0) { tok_s[a] = slot; slot_w[slot] = tok_w[a]; }
        }
        __syncthreads();
    }
}
__device__ __forceinline__ void phase_moeup(CParams& p, float* lds) {
    int* Li = (int*)(lds + 16384);
    expert_offsets(p, 0, Li);
    const bf16_t* XG = (const bf16_t*)(p.ws + WS_R1 + R1_XG); const bf16_t* Bt = (const bf16_t*)(p.ws + WS_W + W_GU); bf16_t* GU = (bf16_t*)(p.ws + WS_C);
    ngemm(Li[64], 512, 1024, 1024, 1024, [=](int m0, int) { return XG + (size_t)m0 * 1024; }, [=](int m0, int n0) { return Bt + ((size_t)tile_expert(Li, m0) * 512 + n0) * 1024; },
          [=](int m, int n, float v) { GU[(size_t)m * 512 + n] = (bf16_t)f2bf(v); }, lds);
}
__device__ __forceinline__ void phase_swiglu(CParams& p, float* lds) {
    int* Li = (int*)(lds + 16384);
    expert_offsets(p, 0, Li);
    const size_t n = (size_t)Li[64] * 256;
    const bf16_t* GU = (const bf16_t*)(p.ws + WS_C); bf16_t* HID = (bf16_t*)(p.ws + WS_R1 + R1_HID);
    for (size_t i = (size_t)bid_() * NTHREADS + tid_(); i < n; i += (size_t)nblk_() * NTHREADS) {
        const size_t s = i >> 8; const int f = (int)(i & 255), j = f >> 7, rr = f & 127;
        const float g = bf2f(GU[s * 512 + j * 256 + rr]), u = bf2f(GU[s * 512 + j * 256 + 128 + rr]);
        HID[i] = (bf16_t)f2bf(g * sigmoidf_(g) * u);
    }
    __syncthreads();
}
__device__ __forceinline__ void phase_moedown(CParams& p, float* lds) {
    int* Li = (int*)(lds + 16384);
    expert_offsets(p, 0, Li);
    const bf16_t* HID = (const bf16_t*)(p.ws + WS_R1 + R1_HID); const bf16_t* Bt = (const bf16_t*)(p.ws + WS_W + W_D); bf16_t* YSL = (bf16_t*)(p.ws + WS_R1 + R1_YSL);
    ngemm(Li[64], 1024, 256, 256, 256, [=](int m0, int) { return HID + (size_t)m0 * 256; }, [=](int m0, int n0) { return Bt + ((size_t)tile_expert(Li, m0) * 1024 + n0) * 256; },
          [=](int m, int n, float v) { YSL[(size_t)m * 1024 + n] = (bf16_t)f2bf(v); }, lds);
}
__device__ __forceinline__ void phase_ln2(CParams& p, int l) {
    const int tid = tid_(), lane = tid & 63, wave = tid >> 6;
    const int gw = bid_() * NWAVES + wave, NGW = nblk_() * NWAVES;
    const int* tok_s = (const int*)(p.ws + WS_ROUTE + RT_TOKS); const bf16_t* YSL = (const bf16_t*)(p.ws + WS_R1 + R1_YSL); const float* tok_w = (const float*)(p.ws + WS_ROUTE + RT_TOKW);
    for (int m = gw; m < T; m += NGW) {
        f32x4* orow = (f32x4*)(p.out + (size_t)m * D) + lane; f32x4 v[4];
        const u32x2* y0 = (const u32x2*)(YSL + (size_t)tok_s[m * 2] * D) + lane; const u32x2* y1 = (const u32x2*)(YSL + (size_t)tok_s[m * 2 + 1] * D) + lane;
        const float w0 = tok_w[m * 2], w1 = tok_w[m * 2 + 1];
#pragma unroll
        for (int j = 0; j < 4; ++j) {
            const u32x2 a = y0[64 * j], b = y1[64 * j]; const f32x4 hv = orow[64 * j];
            v[j].x = ALPHA * hv.x + (w0 * bf2f(a.x & 0xffffu) + w1 * bf2f(b.x & 0xffffu)); v[j].y = ALPHA * hv.y + (w0 * bf2f(a.x >> 16) + w1 * bf2f(b.x >> 16));
            v[j].z = ALPHA * hv.z + (w0 * bf2f(a.y & 0xffffu) + w1 * bf2f(b.y & 0xffffu)); v[j].w = ALPHA * hv.w + (w0 * bf2f(a.y >> 16) + w1 * bf2f(b.y >> 16));
        }
        ln_row(v, p.ln2_g + l * D, p.ln2_b + l * D, lane);
#pragma unroll
        for (int j = 0; j < 4; ++j) orow[64 * j] = v[j];
        if (l == 0) emit_xrow(p, v, m, 1, lane);
    }
}


namespace att {
typedef short bf16x8 __attribute__((ext_vector_type(8)));
typedef short s16x4 __attribute__((ext_vector_type(4)));
typedef float f32x16 __attribute__((ext_vector_type(16)));
#define ALAS __attribute__((address_space(3)))
typedef ALAS unsigned char* lp_t;
constexpr float THR = 6.f;
__device__ __forceinline__ int crow(int r, int hi) { return (r & 3) + 8 * (r >> 2) + 4 * hi; }
__device__ __forceinline__ s16x4 vtr(lp_t p) { return __builtin_bit_cast(s16x4, __builtin_amdgcn_ds_read_tr16_b64_v4i16((ALAS s16x4*)p)); }
__device__ __forceinline__ bf16x8 pack8(const f32x16& p, int b) {
    u32x4 w; w.x = pg8::cvt_pk_bf16(p[b], p[b + 1]); w.y = pg8::cvt_pk_bf16(p[b + 2], p[b + 3]); w.z = pg8::cvt_pk_bf16(p[b + 4], p[b + 5]); w.w = pg8::cvt_pk_bf16(p[b + 6], p[b + 7]);
    return __builtin_bit_cast(bf16x8, w);
}
template <int MODE, int DQK>
__device__ __forceinline__ void attn_unit(const bf16_t* Q, int QP, const bf16_t* K, int KP, const bf16_t* V, int VP, const float* CF, bf16_t* Y, int b, int h, int qb, lp_t lds) {
    constexpr int ND = DQK / 16, NCH = DQK / 8, KSZ = NCH * 1024, VOFF = 2 * KSZ, WOFF = VOFF + 16384;
    const int tid = tid_(), lane = tid & 63, r32 = lane & 31, hi = lane >> 5, wid = __builtin_amdgcn_readfirstlane(tid >> 6);
    const int q0 = qb * 256; const long rowbase = (long)b * SEQ;
    const int qw0 = q0 + wid * 32, qrow = qw0 + r32;
    bf16x8 qf[ND];
    { const bf16_t* qp = Q + (size_t)(rowbase + qrow) * QP + h * DQK + hi * 8;
#pragma unroll
      for (int d0 = 0; d0 < ND; ++d0) qf[d0] = *(const bf16x8*)(qp + d0 * 16); }
    const int NT = (q0 + 256) / 64;
    float ct2 = 0.f; if (MODE == 2) ct2 = CF[(size_t)(rowbase + qrow) * 4 + h] * LOG2E;
    f32x16 o0, o1;
#pragma unroll
    for (int r = 0; r < 16; ++r) { o0[r] = 0.f; o1[r] = 0.f; }
    float mhat = 0.f, lsum = 0.f, R = 0.f;
    ALAS float* wsf = (ALAS float*)(lds + WOFF) + wid * 64;
    const bf16_t* kg = K + (size_t)(rowbase + lane) * KP + h * DQK;
    const bf16_t* vg = V + (size_t)(rowbase + 16 * (wid & 3) + (lane >> 2)) * VP + h * 64 + (wid >> 2) * 32 + (lane & 3) * 8;
#define ATT_DMA(tt, buf) do { \
        for (int c_ = wid; c_ < NCH; c_ += 8) __builtin_amdgcn_global_load_lds((const unsigned*)(kg + (size_t)(tt) * 64 * KP + c_ * 8), (ALAS unsigned*)(lds + (buf) * KSZ + c_ * 1024), 16, 0, 0); \
        __builtin_amdgcn_global_load_lds((const unsigned*)(vg + (size_t)(tt) * 64 * VP), (ALAS unsigned*)(lds + VOFF + (buf) * 8192 + wid * 1024), 16, 0, 0); } while (0)
    ATT_DMA(MODE == 1 ? NT - 1 : 0, 0);
    asm volatile("s_waitcnt vmcnt(0)" ::: "memory"); __syncthreads();
#pragma unroll 1
    for (int t = 0; t < NT; ++t) {
        const int tt = MODE == 1 ? NT - 1 - t : t, buf = t & 1;
        if (t + 1 < NT) ATT_DMA(MODE == 1 ? tt - 1 : tt + 1, buf ^ 1);
        const int k0 = 64 * tt;
        const bool active = MODE == 1 ? (k0 < qw0 + 31) : (k0 <= qw0 + 31);
        if (active) {
            const lp_t kb = lds + buf * KSZ + hi * 1024 + r32 * 16;
            f32x16 p0, p1;
            { const float base = MODE == 1 ? 0.f : ct2 - mhat;
#pragma unroll
              for (int r = 0; r < 16; ++r) { p0[r] = base; p1[r] = base; } }
#pragma unroll
            for (int d0 = 0; d0 < ND; ++d0) {
                const bf16x8 b0 = *(const ALAS bf16x8*)(kb + d0 * 2048), b1 = *(const ALAS bf16x8*)(kb + d0 * 2048 + 512);
                p0 = __builtin_amdgcn_mfma_f32_32x32x16_bf16(b0, qf[d0], p0, 0, 0, 0); p1 = __builtin_amdgcn_mfma_f32_32x32x16_bf16(b1, qf[d0], p1, 0, 0, 0);
            }
            const bool band = MODE == 1 ? (k0 + 63 >= qw0) : (k0 + 63 > qw0);
            if (MODE != 1) {
                if (band) {
#pragma unroll
                    for (int r = 0; r < 16; ++r) { const int kv = k0 + crow(r, hi); if (kv > qrow) p0[r] = -INFINITY; if (kv + 32 > qrow) p1[r] = -INFINITY; }
                }
                float rm = fmaxf(p0[0], p1[0]);
#pragma unroll
                for (int r = 1; r < 16; ++r) rm = fmaxf(rm, fmaxf(p0[r], p1[r]));
                rm = fmaxf(rm, __shfl_xor(rm, 32));
                const bool first = (t == 0);
                if (first || __any(rm > THR)) {
                    const float dl = first ? rm : fmaxf(rm, 0.f); const float f = first ? 1.f : __builtin_amdgcn_exp2f(-dl);
                    mhat += dl; lsum *= f;
#pragma unroll
                    for (int r = 0; r < 16; ++r) { p0[r] -= dl; p1[r] -= dl; }
                    if (!first) {
                        if (hi == 0) wsf[r32] = f;
                        asm volatile("s_waitcnt lgkmcnt(0)" ::: "memory");
#pragma unroll
                        for (int r = 0; r < 16; ++r) { const float fr = wsf[crow(r, hi)]; o0[r] *= fr; o1[r] *= fr; }
                        asm volatile("s_waitcnt lgkmcnt(0)" ::: "memory");
                    }
                }
                float sacc = 0.f;
#pragma unroll
                for (int r = 0; r < 16; ++r) { p0[r] = __builtin_amdgcn_exp2f(p0[r]); p1[r] = __builtin_amdgcn_exp2f(p1[r]); sacc += p0[r] + p1[r]; }
                lsum += sacc;
            } else {
                f32x16 L0, L1;
#pragma unroll
                for (int r = 0; r < 16; ++r) {
                    const float z0 = p0[r], z1 = p1[r];
                    L0[r] = -(fmaxf(z0, 0.f) + __builtin_amdgcn_logf(1.f + __builtin_amdgcn_exp2f(-fabsf(z0))));
                    L1[r] = -(fmaxf(z1, 0.f) + __builtin_amdgcn_logf(1.f + __builtin_amdgcn_exp2f(-fabsf(z1))));
                }
                if (band) {
#pragma unroll
                    for (int r = 0; r < 16; ++r) { const int kv = k0 + crow(r, hi); if (kv >= qrow) L0[r] = 0.f; if (kv + 32 >= qrow) L1[r] = 0.f; }
                }
                float G0[4], G1[4], P0[4], P1[4];
#pragma unroll
                for (int g = 0; g < 4; ++g) { G0[g] = (L0[4 * g] + L0[4 * g + 1]) + (L0[4 * g + 2] + L0[4 * g + 3]); G1[g] = (L1[4 * g] + L1[4 * g + 1]) + (L1[4 * g + 2] + L1[4 * g + 3]);
                    P0[g] = __shfl_xor(G0[g], 32); P1[g] = __shfl_xor(G1[g], 32); }
                float run = R;
#pragma unroll
                for (int g = 3; g >= 0; --g) { float s = run + (hi == 0 ? P1[g] : 0.f);
#pragma unroll
                    for (int i = 3; i >= 0; --i) { const float l = L1[4 * g + i]; p1[4 * g + i] = __builtin_amdgcn_exp2f(p1[4 * g + i] + l + s); s += l; }
                    run += G1[g] + P1[g]; }
#pragma unroll
                for (int g = 3; g >= 0; --g) { float s = run + (hi == 0 ? P0[g] : 0.f);
#pragma unroll
                    for (int i = 3; i >= 0; --i) { const float l = L0[4 * g + i]; p0[4 * g + i] = __builtin_amdgcn_exp2f(p0[4 * g + i] + l + s); s += l; }
                    run += G0[g] + P0[g]; }
                R = run;
                if (band) {
#pragma unroll
                    for (int r = 0; r < 16; ++r) { const int kv = k0 + crow(r, hi); if (kv >= qrow) p0[r] = 0.f; if (kv + 32 >= qrow) p1[r] = 0.f; }
                }
            }
            const bf16x8 pa0 = pack8(p0, 0), pa1 = pack8(p0, 8), pa2 = pack8(p1, 0), pa3 = pack8(p1, 8);
            const lp_t vb = lds + VOFF + buf * 8192 + ((lane >> 4) & 1) * 32 + (lane & 3) * 8 + (4 * hi + ((lane & 15) >> 2)) * 64;
#define ATT_PV(o, d0, ks, pa) do { const s16x4 lo_ = vtr(vb + (d0) * 4096 + (ks) * 1024), hi_ = vtr(vb + (d0) * 4096 + (ks) * 1024 + 512); \
                const bf16x8 vf_ = {lo_[0], lo_[1], lo_[2], lo_[3], hi_[0], hi_[1], hi_[2], hi_[3]}; o = __builtin_amdgcn_mfma_f32_32x32x16_bf16(pa, vf_, o, 0, 0, 0); } while (0)
            ATT_PV(o0, 0, 0, pa0); ATT_PV(o1, 1, 0, pa0); ATT_PV(o0, 0, 1, pa1); ATT_PV(o1, 1, 1, pa1);
            ATT_PV(o0, 0, 2, pa2); ATT_PV(o1, 1, 2, pa2); ATT_PV(o0, 0, 3, pa3); ATT_PV(o1, 1, 3, pa3);
#undef ATT_PV
        }
        asm volatile("s_waitcnt vmcnt(0) lgkmcnt(0)" ::: "memory"); __syncthreads();
    }
#undef ATT_DMA
    if (MODE != 1) {
        const float lt = lsum + __shfl_xor(lsum, 32);
        if (hi == 0) wsf[r32] = lt;
        asm volatile("s_waitcnt lgkmcnt(0)" ::: "memory");
#pragma unroll
        for (int r = 0; r < 16; ++r) { const float rl = 1.f / wsf[crow(r, hi)]; o0[r] *= rl; o1[r] *= rl; }
        asm volatile("s_waitcnt lgkmcnt(0)" ::: "memory");
    }
    bf16_t* yb = Y + (size_t)(rowbase + qw0) * 1024 + h * 64 + r32;
#pragma unroll
    for (int r = 0; r < 16; ++r) { bf16_t* yr = yb + (size_t)crow(r, hi) * 1024; yr[0] = (bf16_t)f2bf(o0[r]); yr[32] = (bf16_t)f2bf(o1[r]); }
}
}

typedef PG8_LAS unsigned char* ldsp_t;
constexpr int LI_OFF = 131072 + 1024;

__device__ __forceinline__ void fox_scan(CParams& p, int l, int bh, int lane) {
    const int b = bh >> 2, h = bh & 3; const float* F = (const float*)(p.ws + WS_ROUTE + RT_FXF); float* CF = (float*)(p.ws + WS_ROUTE + RT_CF);
    const float bf = p.b_forget[l * 4 + h];
    float run = 0.f;
    for (int j = 0; j < 64; ++j) run += logsigmoid_(F[((size_t)b * SEQ + lane * 64 + j) * 4 + h] + bf);
    float inc = run;
#pragma unroll
    for (int o = 1; o < 64; o <<= 1) { const float y = __shfl_up(inc, o); if (lane >= o) inc += y; }
    float c = inc - run;
    for (int j = 0; j < 64; ++j) { const size_t idx = ((size_t)b * SEQ + lane * 64 + j) * 4 + h; c += logsigmoid_(F[idx] + bf); CF[idx] = c; }
}
__device__ __forceinline__ void fox_scan_block(CParams& p, int l, int b, float* lds) {
    const int tid = tid_(), lane = tid & 63, wave = tid >> 6;
    const f32x4* F = (const f32x4*)(p.ws + WS_ROUTE + RT_FXF) + (size_t)b * SEQ + tid * 8; f32x4* C = (f32x4*)(p.ws + WS_ROUTE + RT_CF) + (size_t)b * SEQ + tid * 8;
    const f32x4 bf = *(const f32x4*)(p.b_forget + l * 4);
    f32x4 v[8];
#pragma unroll
    for (int i = 0; i < 8; ++i) v[i] = F[i] + bf;
#pragma unroll
    for (int i = 0; i < 8; ++i) { v[i].x = logsigmoid_(v[i].x); v[i].y = logsigmoid_(v[i].y); v[i].z = logsigmoid_(v[i].z); v[i].w = logsigmoid_(v[i].w); if (i) v[i] += v[i - 1]; }
    f32x4 inc = v[7];
#pragma unroll
    for (int o = 1; o < 64; o <<= 1) { f32x4 y; y.x = __shfl_up(inc.x, o); y.y = __shfl_up(inc.y, o); y.z = __shfl_up(inc.z, o); y.w = __shfl_up(inc.w, o); if (lane >= o) inc += y; }
    f32x4* wt = (f32x4*)lds;
    __syncthreads();
    if (lane == 63) wt[wave] = inc;
    __syncthreads();
    f32x4 off = inc - v[7];
    for (int w = 0; w < wave; ++w) off += wt[w];
#pragma unroll
    for (int i = 0; i < 8; ++i) C[i] = v[i] + off;
    __syncthreads();
}
__device__ __forceinline__ void fphase_inproj(CParams& p, int l, ldsp_t lds) {
    pg8::Gemm g{(const bf16_t*)(p.ws + WS_XB), (const bf16_t*)(p.ws + WS_W + W_BT1), T, ZSW, 1024, 1024};
    pg8::StaticOrder S; S.init(T, ZSW, nblk_(), bid_());
    pg8::EpiBf16 E{(bf16_t*)(p.ws + WS_R1 + R1_ZS), ZSW};
    pg8::gemm_phase<pg8::EpiBf16, pg8::StaticOrder, 1024, 1024, true, true>(lds, g, S, E);
    const int bb = bid_(), nb = nblk_();
    const int first = nb >= 196 ? 192 : 0;
    for (int b = bb - first; b >= 0 && b < NB; b += nb) fox_scan_block(p, l, b, (float*)lds);
}
__device__ __forceinline__ void fphase_upproj(CParams& p, ldsp_t lds) {
    pg8::Gemm g{(const bf16_t*)(p.ws + WS_R1 + R1_ZS), (const bf16_t*)(p.ws + WS_W + W_UQ), T, 1024, 256, ZSW};
    pg8::BranchOrder S; S.s.init(T, 1024, nblk_(), bid_()); S.shift = 1;
    pg8::EpiBf16 E{(bf16_t*)(p.ws + WS_R1 + R1_QKVR), 1024};
    pg8::gemm_phase<pg8::EpiBf16, pg8::BranchOrder, 256, ZSW, true, true>(lds, g, S, E);
}
__device__ __forceinline__ void fphase_pgemm(CParams& p, ldsp_t lds) {
    pg8::Gemm g{(const bf16_t*)(p.ws + WS_D), (const bf16_t*)(p.ws + WS_W + W_BR), T, 4096, 256, 1024};
    pg8::BranchOrder S; S.s.init(T, 4096, nblk_(), bid_()); S.shift = 2;
    pg8::EpiBf16 E{(bf16_t*)(p.ws + WS_R1 + R1_PB), 4096};
    pg8::gemm_phase<pg8::EpiBf16, pg8::BranchOrder, 256, 1024, true, true>(lds, g, S, E);
}
__device__ __forceinline__ void fphase_gate(CParams& p, int l, ldsp_t lds) {
    pg8::Gemm g{(const bf16_t*)(p.ws + WS_XB), (const bf16_t*)(p.ws + WS_W + W_GATE), T, 4096, 1024, 1024};
    pg8::StaticOrder S; S.init(T, 4096, nblk_(), bid_());
    pg8::EpiGate E{(const bf16_t*)(p.ws + WS_R1 + R1_PB), (bf16_t*)(p.ws + WS_C), p.b_gate + (size_t)l * 4096};
    pg8::gemm_phase<pg8::EpiGate, pg8::StaticOrder, 1024, 1024, true, true>(lds, g, S, E);
}
__device__ __forceinline__ void fphase_wo(CParams& p, int l, ldsp_t lds) {
    pg8::Gemm g{(const bf16_t*)(p.ws + WS_C), (const bf16_t*)(p.ws + WS_W + W_O), T, 1024, 1024, 1024};
    pg8::StaticOrder S; S.init(T, 1024, nblk_(), bid_());
    pg8::EpiRes E{l == 0 ? p.x : p.out, p.out, ALPHA};
    pg8::gemm_phase<pg8::EpiRes, pg8::StaticOrder, 1024, 1024, true, true>(lds, g, S, E);
}
__device__ __forceinline__ void fphase_moeup(CParams& p, ldsp_t lds, float* ldsf) {
    int* Li = (int*)(ldsf + LI_OFF / 4);
    expert_offsets(p, 0, Li);
    pg8::Gemm g{(const bf16_t*)(p.ws + WS_R1 + R1_XG), (const bf16_t*)(p.ws + WS_W + W_GU), 0, 512, 1024, 1024};
    pg8::MoeOrder S{Li, 2, nblk_(), bid_(), (long)512 * 1024 * 2};
    pg8::EpiSwiglu E{(bf16_t*)(p.ws + WS_R1 + R1_HID)};
    pg8::gemm_phase<pg8::EpiSwiglu, pg8::MoeOrder, 1024, 1024, true, true>(lds, g, S, E);
}
__device__ __forceinline__ void fphase_moedown(CParams& p, ldsp_t lds, float* ldsf) {
    int* Li = (int*)(ldsf + LI_OFF / 4);
    expert_offsets(p, 0, Li);
    pg8::Gemm g{(const bf16_t*)(p.ws + WS_R1 + R1_HID), (const bf16_t*)(p.ws + WS_W + W_D), 0, 1024, 256, 256};
    pg8::MoeOrder S{Li, 4, nblk_(), bid_(), (long)1024 * 256 * 2};
    pg8::EpiBf16 E{(bf16_t*)(p.ws + WS_R1 + R1_YSL), 1024};
    pg8::gemm_phase<pg8::EpiBf16, pg8::MoeOrder, 256, 256, true, true>(lds, g, S, E);
}


__device__ __forceinline__ void fphase_attn(CParams& p, ldsp_t ldsp, float* ldsf) {
    const int tid = tid_();
    const bf16_t* ZS = (const bf16_t*)(p.ws + WS_R1 + R1_ZS); bf16_t* YS = (bf16_t*)(p.ws + WS_D);
    const bf16_t* Qm = (const bf16_t*)(p.ws + WS_C + C_QM); const bf16_t* Km = (const bf16_t*)(p.ws + WS_C + C_KM); const bf16_t* Vm = (const bf16_t*)(p.ws + WS_C + C_VM);
    const float* CF = (const float*)(p.ws + WS_ROUTE + RT_CF);
    unsigned* ctr = (unsigned*)(p.ws + WS_CTL + CTL_QUEUE);
    volatile int* su = (volatile int*)(ldsf + 131072 / 4);
    for (;;) {
        __syncthreads();
        if (tid == 0) su[0] = (int)atomicAdd(ctr, 1u);
        __syncthreads();
        const int k = su[0];
        if (k >= 768) break;
        const int cls = k >> 4, bh = k & 15, qb = 15 - cls / 3, v = cls % 3, b = bh >> 2, h = bh & 3;
        if (v == 0) { if constexpr ((FAST & F_ASB) != 0) att::attn_unit<1, 64>(ZS + C_SBQ, ZSW, ZS + C_SBK, ZSW, ZS + C_SBV, ZSW, nullptr, YS + 256, b, h, qb, ldsp); }
        else if (v == 1) { if constexpr ((FAST & F_AMLA) != 0) att::attn_unit<0, 96>(Qm, 384, Km, 384, Vm, 256, nullptr, YS, b, h, qb, ldsp); }
        else { if constexpr ((FAST & F_AFOX) != 0) att::attn_unit<2, 80>(ZS + C_FXQ, ZSW, ZS + C_FXK, ZSW, ZS + C_FXV, ZSW, CF, YS + 768, b, h, qb, ldsp); }
    }
    __syncthreads();
    if constexpr ((FAST & F_AMLA) == 0) attn_naive<0, 96>(Qm, 384, Km, 384, Vm, 256, nullptr, YS, ldsf);
    if constexpr ((FAST & F_ASB) == 0) attn_naive<1, 64>(ZS + C_SBQ, ZSW, ZS + C_SBK, ZSW, ZS + C_SBV, ZSW, nullptr, YS + 256, ldsf);
    static_assert((FAST & F_AFOX) != 0, "the naive FoX fallback does not know the 80-wide head layout");
}


#define LAS __attribute__((address_space(3)))
#define XB_TMO      128
#define XB_XCNT(j)  (256  + 64 * (j))
#define XB_XSUB(j)  (1280 + 64 * (j))
#define XB_XGEN(j)  (2304 + 64 * (j))
#define XB_TOP      3328
#define XB_TOPGEN   3392
#define XCD_BAR_WORDS 3456
#define XB_SPIN_CAP (1u << 18)

__device__ __forceinline__ unsigned xb_ld(unsigned* p)              { return __hip_atomic_load(p, __ATOMIC_RELAXED, __HIP_MEMORY_SCOPE_AGENT); }
__device__ __forceinline__ unsigned xb_add(unsigned* p, unsigned v) { return __hip_atomic_fetch_add(p, v, __ATOMIC_RELAXED, __HIP_MEMORY_SCOPE_AGENT); }
__device__ __forceinline__ unsigned xb_xcc_id() { return (unsigned)__builtin_amdgcn_s_getreg((3 << 11) | 20) & 0xFu; }
#define XB_SPIN(cond, bar) do { unsigned _sp = 0; while (cond) { __builtin_amdgcn_s_sleep(1); \
    if ((++_sp & 255u) == 0u) { if (xb_ld(&(bar)[XB_TMO])) break; if (_sp > XB_SPIN_CAP) { atomicAdd(&(bar)[XB_TMO], 1u); break; } } } } while (0)

struct XcdBarrier {
    unsigned* bar; unsigned x;
    volatile LAS unsigned* st;
};

__device__ __forceinline__ XcdBarrier xcd_barrier_post(unsigned* bar, volatile LAS unsigned* st) {
    XcdBarrier b; b.bar = bar; b.x = xb_xcc_id(); b.st = st;
    if (threadIdx.x == 0) (void)xb_add(&bar[XB_XCNT(b.x)], 1u);
    return b;
}
__device__ __forceinline__ void xcd_barrier_complete(unsigned* bar, unsigned x, unsigned& nloc, unsigned& nx) {
    const unsigned G = gridDim.x * gridDim.y * gridDim.z;
    unsigned sum, cnt, mine, sp = 0u;
    for (;;) {
        sum = 0u; cnt = 0u; mine = 0u;
#pragma unroll
        for (unsigned j = 0; j < 16; ++j) { const unsigned c = xb_ld(&bar[XB_XCNT(j)]); sum += c; cnt += (c > 0u) ? 1u : 0u; mine = (j == x) ? c : mine; }
        if (sum == G) break;
        __builtin_amdgcn_s_sleep(1);
        if ((++sp & 255u) == 0u) { if (xb_ld(&bar[XB_TMO])) break; if (sp > XB_SPIN_CAP) { atomicAdd(&bar[XB_TMO], 1u); break; } }
    }
    nloc = mine > 0u ? mine : 1u; nx = cnt > 0u ? cnt : 1u;
}

__device__ __forceinline__ void xcd_barrier(const XcdBarrier& b) {
    asm volatile("s_waitcnt vmcnt(0)" ::: "memory");
    __syncthreads();
    if (threadIdx.x == 0) {
        unsigned* bar = b.bar;
        __builtin_amdgcn_s_waitcnt(0);
        unsigned nloc = b.st[0], nx = b.st[1];
        if (nloc == 0u) { xcd_barrier_complete(bar, b.x, nloc, nx); b.st[0] = nloc; b.st[1] = nx; }
        const unsigned old = xb_add(&bar[XB_XSUB(b.x)], 1u);
        const unsigned gen = old / nloc;
        if (old + 1u == (gen + 1u) * nloc) {
            __builtin_amdgcn_fence(__ATOMIC_RELEASE, "agent");
            asm volatile("s_waitcnt vmcnt(0)" ::: "memory");
            const unsigned og = xb_add(&bar[XB_TOP], 1u);
            const unsigned tg = og / nx;
            if (og + 1u == (tg + 1u) * nx) xb_add(&bar[XB_TOPGEN], 1u);
            else XB_SPIN(xb_ld(&bar[XB_TOPGEN]) == tg, bar);
            __builtin_amdgcn_fence(__ATOMIC_ACQUIRE, "agent");
            xb_add(&bar[XB_XGEN(b.x)], 1u);
            asm volatile("s_waitcnt vmcnt(0)" ::: "memory");
        } else {
            XB_SPIN(xb_ld(&bar[XB_XGEN(b.x)]) == gen, bar);
            __builtin_amdgcn_fence(__ATOMIC_ACQUIRE, "agent");
            asm volatile("s_waitcnt vmcnt(0)" ::: "memory");
        }
    }
    __syncthreads();
}

enum { PH_CONVW = 0, PH_INPROJ, PH_UPPROJ, PH_PREP, PH_ATTN, PH_PGEMM, PH_GATE, PH_COMBINE, PH_WO, PH_LN1, PH_GATHER, PH_MOEUP, PH_SWIGLU, PH_MOEDOWN, PH_LN2, PH_N };
__device__ __forceinline__ void run_phase(CParams& p, int ph, int l, float* lds, ldsp_t ldsp) {
    switch (ph) {
        case PH_CONVW: phase_convw(p, l, lds); if (l == 0) phase_convx(p); break;
        case PH_INPROJ: if constexpr ((FAST & F_INPROJ) != 0) fphase_inproj(p, l, ldsp); else phase_inproj(p, lds); break;
        case PH_UPPROJ:
            if constexpr ((FAST & F_INPROJ) == 0) { const int tid = tid_(); for (int bh = bid_(); bh < 16; bh += nblk_()) if ((tid >> 6) == 0) fox_scan(p, l, bh, tid & 63); }
            if constexpr ((FAST & F_UPPROJ) != 0) fphase_upproj(p, ldsp); else phase_upproj(p, l, lds); break;
        case PH_PREP: phase_prep(p, l, lds); break;
        case PH_ATTN: if constexpr ((FAST & (F_AMLA | F_ASB | F_AFOX)) != 0) fphase_attn(p, ldsp, lds); else phase_attn(p, lds); break;
        case PH_PGEMM: if constexpr ((FAST & F_PGEMM) != 0) fphase_pgemm(p, ldsp); else phase_pgemm(p, lds); break;
        case PH_GATE: if constexpr ((FAST & F_GATE) != 0) fphase_gate(p, l, ldsp); else phase_gate(p, l, lds); break;
        case PH_COMBINE: if constexpr ((FAST & F_GATE) == 0) phase_combine(p); break;
        case PH_WO: if constexpr ((FAST & F_WO) != 0) fphase_wo(p, l, ldsp); else phase_wo(p, l, lds); break;
        case PH_LN1: phase_ln1route(p, l, lds); break;
        case PH_GATHER: phase_gather(p, lds); break;
        case PH_MOEUP: if constexpr ((FAST & F_MOEUP) != 0) fphase_moeup(p, ldsp, lds); else phase_moeup(p, lds); break;
        case PH_SWIGLU: if constexpr ((FAST & F_MOEUP) == 0) phase_swiglu(p, lds); break;
        case PH_MOEDOWN: if constexpr ((FAST & F_MOEDOWN) != 0) fphase_moedown(p, ldsp, lds); else phase_moedown(p, lds); break;
        case PH_LN2: phase_ln2(p, l); break;
    }
}
__global__ void __launch_bounds__(NTHREADS, 2) mega(Params p) {
    extern __shared__ __attribute__((aligned(16))) unsigned char lds_raw[];
    cg::grid_group grid = cg::this_grid();
    volatile LAS unsigned* st = (volatile LAS unsigned*)((LAS unsigned char*)lds_raw + (LDS_BYTES - 256));
    if (threadIdx.x < 16) st[threadIdx.x] = 0u;
    __syncthreads();
    const XcdBarrier bar = xcd_barrier_post((unsigned*)(p.ws + WS_CTL + CTL_BAR), st);
    bool first_seam = true;
#pragma unroll 1
    for (int l = 0; l < 2; ++l) {
#pragma unroll 1
        for (int ph = 0; ph < PH_N; ++ph) {
            if ((ph == PH_COMBINE && (FAST & F_GATE) != 0) || (ph == PH_SWIGLU && (FAST & F_MOEUP) != 0)) continue;
            CParams* pp = (CParams*)__builtin_amdgcn_kernarg_segment_ptr();
            asm volatile("" : "+s"(pp));
            run_phase(*pp, ph, l, (float*)lds_raw, (ldsp_t)lds_raw);
#if defined(PROBE_DUP)
            if (ph == PROBE_DUP) {
                xcd_barrier(bar);
                if (ph == PH_ATTN) { if (blockIdx.x == 0 && threadIdx.x == 0) *(unsigned*)(pp->ws + WS_CTL + CTL_QUEUE) = 0u; xcd_barrier(bar); }
                run_phase(*pp, ph, l, (float*)lds_raw, (ldsp_t)lds_raw);
            }
#endif
            if (l == 1 && ph == PH_N - 1) break;
            if (first_seam) { grid.sync(); first_seam = false; }
            else xcd_barrier(bar);
        }
    }
}

extern "C" void kernel_launch(void* const* d_in, const int* in_sizes, int n_in, void* d_out, int out_size, void* d_ws, size_t ws_size, hipStream_t stream) {
    static int grid = 0;
    if (grid == 0) {
        if (n_in != 26 || out_size != T * D || ws_size < WS_END) { fprintf(stderr, "kernel_launch: unexpected shapes (n_in %d out %d ws %zu, need %zu)\n", n_in, out_size, ws_size, (size_t)WS_END); grid = -1; return; }
        int dev = 0, cus = 0, per_cu = 0;
        (void)hipGetDevice(&dev); (void)hipDeviceGetAttribute(&cus, hipDeviceAttributeMultiprocessorCount, dev);
        (void)hipFuncSetAttribute((const void*)mega, hipFuncAttributeMaxDynamicSharedMemorySize, LDS_BYTES);
        if (hipOccupancyMaxActiveBlocksPerMultiprocessor(&per_cu, (const void*)mega, NTHREADS, LDS_BYTES) != hipSuccess || per_cu < 1) { fprintf(stderr, "kernel_launch: occupancy query says %d\n", per_cu); grid = -1; return; }
        grid = cus;
    }
    if (grid < 0) return;
    Params p{};
    const float** pf = (const float**)&p;
    p.x = (const float*)d_in[0]; p.pos = (const int*)d_in[1];
    for (int i = 2; i < 26; ++i) pf[i] = (const float*)d_in[i];
    p.out = (float*)d_out; p.ws = (unsigned char*)d_ws;
    if (hipMemsetAsync((unsigned char*)d_ws + WS_CTL + CTL_BAR, 0, CTL_BAR_BYTES, stream) != hipSuccess) { fprintf(stderr, "kernel_launch: memset of the barrier words failed\n"); return; }
    void* args[] = {&p};
    hipError_t e = hipLaunchCooperativeKernel((const void*)mega, dim3(grid), dim3(NTHREADS), args, LDS_BYTES, stream);
    if (e != hipSuccess) fprintf(stderr, "cooperative launch failed: %s (grid %d)\n", hipGetErrorString(e), grid);
}
```
